# Optimizing an MI355X kernel written in HIP

```python
import jax, jax.numpy as jnp
from jax import lax
import numpy as np

D_MODEL = 1024
BATCH = 16
SEQ = 2048
DEPTH = 4

RET_HEADS = 4
RET_QK_DIM = 128
RET_V_DIM = 256
RET_CHUNK = 128
SB_HEADS = 8
SB_HEAD_DIM = 128
SB_BLOCK = 128
D_FF = 4 * D_MODEL

ROPE_BASE = 10000.0
NORM_EPS = 1e-6
GN_EPS = 1e-5

RET_QK = RET_HEADS * RET_QK_DIM
RET_V = RET_HEADS * RET_V_DIM
SB_W = SB_HEADS * SB_HEAD_DIM
IN_SIZES = (RET_QK, RET_QK, RET_V, RET_V, SB_W, SB_W, SB_W, D_MODEL, D_MODEL)
D_IN = RET_QK * 2 + RET_V * 2 + SB_W * 3 + D_MODEL * 2

kernel_name = 'hybrid_retention_stickbreaking_gated'


def rmsnorm(x, gain):
    xf = x.astype(jnp.float32)
    y = xf * lax.rsqrt(jnp.mean(xf * xf, axis=-1, keepdims=True) + NORM_EPS)
    return (y * gain.astype(jnp.float32)).astype(x.dtype)


def rotary(t, pos):
    half = t.shape[-1] // 2
    inv_freq = ROPE_BASE ** (-jnp.arange(half, dtype=jnp.float32) / half)
    ang = pos.astype(jnp.float32)[:, None] * inv_freq[None, :]
    cos = jnp.cos(ang)[None, :, None, :]
    sin = jnp.sin(ang)[None, :, None, :]
    t1, t2 = t[..., :half], t[..., half:]
    return jnp.concatenate([t1 * cos - t2 * sin, t1 * sin + t2 * cos], axis=-1)


def retention(q, k, v, log_gamma):
    B, S, H, _ = q.shape
    C = RET_CHUNK
    N = S // C
    idx = jnp.arange(C, dtype=jnp.float32)
    diff = idx[:, None] - idx[None, :]
    decay = jnp.where(diff[None] >= 0,
                      jnp.exp(log_gamma[:, None, None] * jnp.maximum(diff, 0.0)[None]), 0.0)
    q_decay = jnp.exp(log_gamma[None, :] * (idx[:, None] + 1.0))
    k_decay = jnp.exp(log_gamma[None, :] * (C - 1.0 - idx[:, None]))
    chunk_decay = jnp.exp(log_gamma * C)

    def to_chunks(t):
        return t.reshape(B, N, C, H, t.shape[-1]).transpose(1, 0, 2, 3, 4)

    def step(state, qkv):
        qc, kc, vc = qkv
        scores = jnp.einsum('bchd,bshd->bhcs', qc, kc) * decay[None]
        inner = jnp.einsum('bhcs,bshe->bche', scores, vc)
        cross = jnp.einsum('bchd,bhde->bche', qc, state) * q_decay[None, :, :, None]
        state = state * chunk_decay[None, :, None, None] + jnp.einsum(
            'bshd,bshe->bhde', kc * k_decay[None, :, :, None], vc)
        return state, inner + cross

    init = jnp.zeros((B, H, q.shape[-1], v.shape[-1]), jnp.float32)
    _, out = lax.scan(step, init, (to_chunks(q), to_chunks(k), to_chunks(v)))
    return out.transpose(1, 0, 2, 3, 4).reshape(B, S, H, v.shape[-1])


def head_group_norm(y):
    mu = jnp.mean(y, axis=-1, keepdims=True)
    var = jnp.mean(jnp.square(y - mu), axis=-1, keepdims=True)
    return (y - mu) * lax.rsqrt(var + GN_EPS)


def stick_breaking(q, k, v):
    S = q.shape[1]
    scale = q.shape[-1] ** -0.5
    outs = []
    for start in range(0, S, SB_BLOCK):
        end = start + SB_BLOCK
        qb = q[:, start:end]
        kb = k[:, :end]
        vb = v[:, :end]
        z = jnp.einsum('bthd,bshd->bhts', qb, kb) * scale
        t_idx = start + jnp.arange(SB_BLOCK)
        s_idx = jnp.arange(end)
        causal = (s_idx[None, :] < t_idx[:, None])[None, None]
        log_beta = jax.nn.log_sigmoid(z)
        log_1m_beta = jnp.where(causal, log_beta - z, 0.0)
        after = lax.cumsum(log_1m_beta, axis=3, reverse=True) - log_1m_beta
        weights = jnp.where(causal, jnp.exp(log_beta + after), 0.0)
        outs.append(jnp.einsum('bhts,bshe->bthe', weights, vb))
    return jnp.concatenate(outs, axis=1)


def setup_inputs(seed: int = 0) -> dict:
    key = jax.random.key(seed)
    ks = jax.random.split(key, 10)
    f32 = jnp.float32
    x = jax.random.normal(ks[0], (BATCH, SEQ, D_MODEL), f32)
    w_in = jax.random.normal(ks[1], (DEPTH, D_MODEL, D_IN), f32) * D_MODEL ** -0.5
    p_ret = jax.random.normal(ks[2], (DEPTH, RET_V, D_MODEL), f32) * RET_V ** -0.5
    p_sb = jax.random.normal(ks[3], (DEPTH, SB_W, D_MODEL), f32) * SB_W ** -0.5
    w_out = jax.random.normal(ks[4], (DEPTH, D_MODEL, D_MODEL), f32) * D_MODEL ** -0.5
    w_up = jax.random.normal(ks[5], (DEPTH, D_MODEL, D_FF), f32) * D_MODEL ** -0.5
    w_down = jax.random.normal(ks[6], (DEPTH, D_FF, D_MODEL), f32) * D_FF ** -0.5
    g_mix = 1.0 + 0.02 * jax.random.normal(ks[7], (DEPTH, D_MODEL), f32)
    g_mlp = 1.0 + 0.02 * jax.random.normal(ks[8], (DEPTH, D_MODEL), f32)
    g_final = 1.0 + 0.02 * jax.random.normal(ks[9], (D_MODEL,), f32)
    return {'x': x, 'w_in': w_in, 'p_ret': p_ret, 'p_sb': p_sb, 'w_out': w_out,
            'w_up': w_up, 'w_down': w_down, 'g_mix': g_mix, 'g_mlp': g_mlp,
            'g_final': g_final}


def reference(x, w_in, p_ret, p_sb, w_out, w_up, w_down, g_mix, g_mlp, g_final):
    B, S, _ = x.shape
    dt = x.dtype
    pos = jnp.arange(S, dtype=jnp.int32)
    log_gamma = jnp.log1p(-(2.0 ** (-5.0 - jnp.arange(RET_HEADS, dtype=jnp.float32))))
    splits = [int(v) for v in np.cumsum(IN_SIZES)[:-1]]
    for l in range(DEPTH):
        h = rmsnorm(x, g_mix[l])
        proj = jnp.matmul(h, w_in[l]).astype(jnp.float32)
        q_r, k_r, v_r, g_r, q_s, k_s, v_s, gate_a, gate_b = jnp.split(proj, splits, axis=-1)
        q_r = rotary(q_r.reshape(B, S, RET_HEADS, RET_QK_DIM), pos)
        k_r = rotary(k_r.reshape(B, S, RET_HEADS, RET_QK_DIM), pos) * (RET_QK_DIM ** -0.5)
        ret = retention(q_r, k_r, v_r.reshape(B, S, RET_HEADS, RET_V_DIM), log_gamma)
        ret = head_group_norm(ret).reshape(B, S, RET_V) * jax.nn.silu(g_r)
        sb = stick_breaking(q_s.reshape(B, S, SB_HEADS, SB_HEAD_DIM),
                            k_s.reshape(B, S, SB_HEADS, SB_HEAD_DIM),
                            v_s.reshape(B, S, SB_HEADS, SB_HEAD_DIM)).reshape(B, S, SB_W)
        branch_a = jnp.matmul(ret.astype(dt), p_ret[l]).astype(jnp.float32)
        branch_b = jnp.matmul(sb.astype(dt), p_sb[l]).astype(jnp.float32)
        merged = jax.nn.sigmoid(gate_a) * branch_a + jax.nn.sigmoid(gate_b) * branch_b
        x = x + jnp.matmul(merged.astype(dt), w_out[l]).astype(dt)
        h = rmsnorm(x, g_mlp[l])
        up = jnp.square(jax.nn.relu(jnp.matmul(h, w_up[l])))
        x = x + jnp.matmul(up, w_down[l]).astype(dt)
    return rmsnorm(x, g_final)
```

```cpp
#include <hip/hip_runtime.h>
#include <cstdio>
#include <cstdint>

constexpr int D = 1024, BATCH = 16, SEQ = 2048, DEPTH = 4, M = BATCH * SEQ;
constexpr int DIN = 8192, DFF = 4096;
constexpr int NGRP = 2, BG = BATCH / NGRP, MG = BG * SEQ;
constexpr float NORM_EPS = 1e-6f, GN_EPS = 1e-5f;
constexpr float LOG2E = 1.4426950408889634f, LN2 = 0.6931471805599453f;
constexpr float QS_SCALE = 0.08838834764831845f * LOG2E;
constexpr float KR_SCALE = 0.08838834764831845f;

typedef unsigned short bf16;
constexpr size_t MiB = 1u << 20;
constexpr size_t WS_CTL = 0;
constexpr size_t WS_ROPE = 1 * MiB;
constexpr size_t WS_SSQ = 2 * MiB;
constexpr size_t WS_XB = 4 * MiB;
constexpr size_t WS_W = 68 * MiB;
constexpr size_t WS_ACT = 220 * MiB;
constexpr size_t WS_TMP = 476 * MiB;
constexpr size_t WS_END = 508 * MiB;
constexpr size_t A_RQK = 0, A_RV = 32 * MiB, A_GS = 64 * MiB, A_SK = 128 * MiB, A_SV = 160 * MiB, A_GA = 192 * MiB, A_GB = 224 * MiB;
constexpr size_t A_MERGED = 0, A_UP = 0;

__device__ __forceinline__ unsigned f2bf(float f) { unsigned u = __builtin_bit_cast(unsigned, f); return (u + 0x7fffu + ((u >> 16) & 1u)) >> 16; }
__device__ __forceinline__ float bf2f(unsigned h) { return __builtin_bit_cast(float, h << 16); }

__global__ __launch_bounds__(256) void k_prologue(const float* __restrict__ x, float* __restrict__ out, bf16* __restrict__ xb, float* __restrict__ ssq,
                                                  float* __restrict__ rope) {
    const int lane = threadIdx.x & 63, gw = (blockIdx.x * 256 + threadIdx.x) >> 6, nw = gridDim.x * 4;
    for (int r = gw; r < M; r += nw) {
        float s = 0.f;
        for (int j = 0; j < 4; ++j) {
            const int c = j * 256 + lane * 4;
            const float4 v = *(const float4*)(x + (size_t)r * D + c);
            *(float4*)(out + (size_t)r * D + c) = v;
            s += v.x * v.x + v.y * v.y + v.z * v.z + v.w * v.w;
            uint2 w; w.x = f2bf(v.x) | (f2bf(v.y) << 16); w.y = f2bf(v.z) | (f2bf(v.w) << 16);
            *(uint2*)(xb + (size_t)r * D + c) = w;
        }
        for (int o = 1; o < 64; o <<= 1) s += __shfl_xor(s, o);
        if (lane < 16) ssq[(size_t)r * 16 + lane] = (lane == 0) ? s : 0.f;
    }
    for (int i = blockIdx.x * 256 + threadIdx.x; i < SEQ * 64; i += gridDim.x * 256) {
        const int pos = i >> 6, j = i & 63;
        const float inv = powf(10000.0f, -(float)j / 64.0f);
        const float ang = (float)pos * inv;
        rope[i] = cosf(ang); rope[SEQ * 64 + i] = sinf(ang);
    }
}
__global__ __launch_bounds__(256) void k_rowstats(const float* __restrict__ out, float* __restrict__ ssq, int row0, int nrows) {
    const int lane = threadIdx.x & 63, gw = (blockIdx.x * 256 + threadIdx.x) >> 6, nw = gridDim.x * 4;
    for (int rr = gw; rr < nrows; rr += nw) {
        const int r = row0 + rr; float s = 0.f;
        for (int j = 0; j < 4; ++j) { const float4 v = *(const float4*)(out + (size_t)r * D + j * 256 + lane * 4); s += v.x * v.x + v.y * v.y + v.z * v.z + v.w * v.w; }
        for (int o = 1; o < 64; o <<= 1) s += __shfl_xor(s, o);
        if (lane < 16) ssq[(size_t)r * 16 + lane] = (lane == 0) ? s : 0.f;
    }
}
__global__ __launch_bounds__(256) void k_final_norm(float* __restrict__ out, const float* __restrict__ g) {
    const int lane = threadIdx.x & 63, gw = (blockIdx.x * 256 + threadIdx.x) >> 6, nw = gridDim.x * 4;
    for (int r = gw; r < M; r += nw) {
        float4 v[4]; float s = 0.f;
        for (int j = 0; j < 4; ++j) { v[j] = *(const float4*)(out + (size_t)r * D + j * 256 + lane * 4); s += v[j].x * v[j].x + v[j].y * v[j].y + v[j].z * v[j].z + v[j].w * v[j].w; }
        for (int o = 1; o < 64; o <<= 1) s += __shfl_xor(s, o);
        const float rs = rsqrtf(s * (1.0f / D) + NORM_EPS);
        for (int j = 0; j < 4; ++j) { const float4 gg = *(const float4*)(g + j * 256 + lane * 4);
            float4 o; o.x = v[j].x * rs * gg.x; o.y = v[j].y * rs * gg.y; o.z = v[j].z * rs * gg.z; o.w = v[j].w * rs * gg.w;
            *(float4*)(out + (size_t)r * D + j * 256 + lane * 4) = o; }
    }
}

enum { MODE_P1 = 1, MODE_P3 = 3, MODE_P4 = 4, MODE_P5 = 5, MODE_P6 = 6 };
struct NGP {
    const bf16* A0; const bf16* A1; int lda0, lda1;
    const float* W0; const float* W1; int ldw0, ldw1;
    const float* gain;
    int K, rows, mode, nct;
    int grow0;
    unsigned char* act;
    const float* ssq; const float* rope;
    float* xout; bf16* xb;
};
__device__ __forceinline__ float rstd_of(const float* ssq, int R) {
    float s = 0.f;
    for (int i = 0; i < 16; ++i) s += ssq[(size_t)R * 16 + i];
    return rsqrtf(s * (1.0f / D) + NORM_EPS);
}
__device__ __forceinline__ void tile_cols(int mode, int tc, int& c0, int& c1) {
    if (mode == MODE_P1) { if (tc < 48) { c0 = 128 * tc; c1 = c0 + 64; } else { c0 = 6144 + 64 * (tc - 48); c1 = c0 + 1024; } }
    else if (mode == MODE_P3) { c0 = 64 * tc; c1 = c0; }
    else { c0 = 128 * tc; c1 = c0 + 64; }
}
__device__ __forceinline__ float sigm(float v) { return 1.0f / (1.0f + __expf(-v)); }
__device__ __forceinline__ void epi_pair(const NGP& p, int r, int i, int c0, int c1, float v0, float v1) {
    const int R = p.grow0 + r;
    if (p.mode == MODE_P1) {
        const float rs = rstd_of(p.ssq, R); v0 *= rs; v1 *= rs;
        const int ca = c0 + i, cb = c1 + i;
        if (c0 < 1024) {
            const int pos = R % SEQ; const float cs = p.rope[pos * 64 + i], sn = p.rope[SEQ * 64 + pos * 64 + i];
            float o0 = v0 * cs - v1 * sn, o1 = v0 * sn + v1 * cs;
            if (c0 >= 512) { o0 *= KR_SCALE; o1 *= KR_SCALE; }
            bf16* q = (bf16*)(p.act + A_RQK) + (size_t)r * 1024;
            q[ca] = (bf16)f2bf(o0); q[cb] = (bf16)f2bf(o1);
        } else if (c0 < 2048) { bf16* q = (bf16*)(p.act + A_RV) + (size_t)r * 1024; q[ca - 1024] = (bf16)f2bf(v0); q[cb - 1024] = (bf16)f2bf(v1); }
        else if (c0 < 3072) { bf16* q = (bf16*)(p.act + A_GS) + (size_t)r * 2048; q[ca - 2048] = (bf16)f2bf(v0 * sigm(v0)); q[cb - 2048] = (bf16)f2bf(v1 * sigm(v1)); }
        else if (c0 < 4096) { bf16* q = (bf16*)(p.act + A_GS) + (size_t)r * 2048 + 1024; q[ca - 3072] = (bf16)f2bf(v0 * QS_SCALE); q[cb - 3072] = (bf16)f2bf(v1 * QS_SCALE); }
        else if (c0 < 5120) { bf16* q = (bf16*)(p.act + A_SK) + (size_t)r * 1024; q[ca - 4096] = (bf16)f2bf(v0); q[cb - 4096] = (bf16)f2bf(v1); }
        else if (c0 < 6144) { bf16* q = (bf16*)(p.act + A_SV) + (size_t)r * 1024; q[ca - 5120] = (bf16)f2bf(v0); q[cb - 5120] = (bf16)f2bf(v1); }
        else {
            const int ch = ca - 6144; const float sa = sigm(v0), sb = sigm(v1);
            ((bf16*)(p.act + A_GA))[(size_t)r * 1024 + ch] = (bf16)f2bf(sa / sb);
            ((bf16*)(p.act + A_GB))[(size_t)r * 1024 + ch] = (bf16)f2bf(sb);
        }
    } else if (p.mode == MODE_P3) {
        const int n = c0 + i;
        const float ra = bf2f(((const bf16*)(p.act + A_GA))[(size_t)r * 1024 + n]), sb = bf2f(((const bf16*)(p.act + A_GB))[(size_t)r * 1024 + n]);
        ((bf16*)(p.act + WS_TMP - WS_ACT))[(size_t)r * 1024 + n] = (bf16)f2bf(sb * (ra * v0 + v1));
    } else if (p.mode == MODE_P4 || p.mode == MODE_P6) {
        float* xo = p.xout + (size_t)R * D; bf16* xb = p.xb + (size_t)R * D;
        const float n0 = xo[c0 + i] + v0, n1 = xo[c1 + i] + v1;
        xo[c0 + i] = n0; xo[c1 + i] = n1; xb[c0 + i] = (bf16)f2bf(n0); xb[c1 + i] = (bf16)f2bf(n1);
    } else if (p.mode == MODE_P5) {
        const float rs = rstd_of(p.ssq, R);
        float a = fmaxf(v0 * rs, 0.f), b = fmaxf(v1 * rs, 0.f);
        bf16* u = (bf16*)(p.act + A_UP) + (size_t)r * DFF;
        u[c0 + i] = (bf16)f2bf(a * a); u[c1 + i] = (bf16)f2bf(b * b);
    }
}
__global__ __launch_bounds__(512) void k_naive_gemm(NGP p) {
    __shared__ float As0[32][129], As1[32][129], Bs0[32][64], Bs1[32][64];
    const int tid = threadIdx.x, ty = tid >> 5, tx = tid & 31;
    const bool twoA = (p.A1 != p.A0) || (p.lda1 != p.lda0);
    const int ntr = p.rows / 128, ntiles = ntr * p.nct;
    for (int tile = blockIdx.x; tile < ntiles; tile += gridDim.x) {
        const int tr = tile / p.nct, tc = tile % p.nct, row0 = tr * 128;
        int c0, c1; tile_cols(p.mode, tc, c0, c1);
        float acc[8][2][2];
        for (int a = 0; a < 8; ++a) for (int b = 0; b < 2; ++b) { acc[a][b][0] = 0.f; acc[a][b][1] = 0.f; }
        for (int k0 = 0; k0 < p.K; k0 += 32) {
            {
                const int row = tid >> 2, kk = (tid & 3) * 8;
                const uint4 a = *(const uint4*)(p.A0 + (size_t)(row0 + row) * p.lda0 + k0 + kk);
                const unsigned w[4] = {a.x, a.y, a.z, a.w};
                for (int j = 0; j < 4; ++j) { float g0 = 1.f, g1 = 1.f; if (p.gain) { g0 = p.gain[k0 + kk + 2 * j]; g1 = p.gain[k0 + kk + 2 * j + 1]; }
                    As0[kk + 2 * j][row] = bf2f(w[j] & 0xffffu) * g0; As0[kk + 2 * j + 1][row] = bf2f(w[j] >> 16) * g1; }
                if (twoA) {
                    const uint4 b = *(const uint4*)(p.A1 + (size_t)(row0 + row) * p.lda1 + k0 + kk);
                    const unsigned u[4] = {b.x, b.y, b.z, b.w};
                    for (int j = 0; j < 4; ++j) { As1[kk + 2 * j][row] = bf2f(u[j] & 0xffffu); As1[kk + 2 * j + 1][row] = bf2f(u[j] >> 16); }
                }
            }
            {
                const int k = tid >> 4, c = (tid & 15) * 4;
                const float4 b0 = *(const float4*)(p.W0 + (size_t)(k0 + k) * p.ldw0 + c0 + c);
                const float4 b1 = *(const float4*)(p.W1 + (size_t)(k0 + k) * p.ldw1 + c1 + c);
                Bs0[k][c] = b0.x; Bs0[k][c + 1] = b0.y; Bs0[k][c + 2] = b0.z; Bs0[k][c + 3] = b0.w;
                Bs1[k][c] = b1.x; Bs1[k][c + 1] = b1.y; Bs1[k][c + 2] = b1.z; Bs1[k][c + 3] = b1.w;
            }
            __syncthreads();
            for (int kk = 0; kk < 32; ++kk) {
                float a0[8], a1[8];
                for (int r = 0; r < 8; ++r) { a0[r] = As0[kk][ty * 8 + r]; a1[r] = twoA ? As1[kk][ty * 8 + r] : a0[r]; }
                const float b00 = Bs0[kk][tx * 2], b01 = Bs0[kk][tx * 2 + 1], b10 = Bs1[kk][tx * 2], b11 = Bs1[kk][tx * 2 + 1];
                for (int r = 0; r < 8; ++r) { acc[r][0][0] += a0[r] * b00; acc[r][1][0] += a0[r] * b01; acc[r][0][1] += a1[r] * b10; acc[r][1][1] += a1[r] * b11; }
            }
            __syncthreads();
        }
        for (int r = 0; r < 8; ++r) for (int j = 0; j < 2; ++j) epi_pair(p, row0 + ty * 8 + r, tx * 2 + j, c0, c1, acc[r][j][0], acc[r][j][1]);
    }
}

__global__ __launch_bounds__(512) void k_naive_ret(unsigned char* act) {
    __shared__ float Qs[32][129]; __shared__ bf16 Ks[32][130]; __shared__ bf16 Vs[32][258]; __shared__ float Ss[32][33];
    const bf16* RQK = (const bf16*)(act + A_RQK); const bf16* RV = (const bf16*)(act + A_RV); bf16* GS = (bf16*)(act + A_GS);
    const int tid = threadIdx.x;
    for (int item = blockIdx.x; item < BG * 4 * 64; item += gridDim.x) {
        const int tt = 63 - (item % 64), h = (item / 64) % 4, b = item / 256, t0 = tt * 32;
        const float lg = log1pf(-exp2f(-5.0f - (float)h));
        __syncthreads();
        for (int e = tid; e < 32 * 128; e += 512) { const int i = e >> 7, d = e & 127; Qs[i][d] = bf2f(RQK[(size_t)(b * SEQ + t0 + i) * 1024 + h * 128 + d]); }
        const int row = tid >> 4, ec = (tid & 15) * 16;
        float acc[16]; for (int e = 0; e < 16; ++e) acc[e] = 0.f;
        for (int st = 0; st <= tt; ++st) {
            const int s0 = st * 32;
            __syncthreads();
            for (int e = tid; e < 32 * 128; e += 512) { const int i = e >> 7, d = e & 127; Ks[i][d] = RQK[(size_t)(b * SEQ + s0 + i) * 1024 + 512 + h * 128 + d]; }
            for (int e = tid; e < 32 * 256; e += 512) { const int i = e >> 8, d = e & 255; Vs[i][d] = RV[(size_t)(b * SEQ + s0 + i) * 1024 + h * 256 + d]; }
            __syncthreads();
            for (int jj = 0; jj < 2; ++jj) { const int i = tid >> 4, j = (tid & 15) * 2 + jj; float s = 0.f;
                for (int d = 0; d < 128; ++d) s += Qs[i][d] * bf2f(Ks[j][d]);
                const int t = t0 + i, sx = s0 + j; Ss[i][j] = (t >= sx) ? s * __expf(lg * (float)(t - sx)) : 0.f; }
            __syncthreads();
            for (int j = 0; j < 32; ++j) { const float s = Ss[row][j]; for (int e = 0; e < 16; ++e) acc[e] += s * bf2f(Vs[j][ec + e]); }
        }
        float sum = 0.f; for (int e = 0; e < 16; ++e) sum += acc[e];
        for (int o = 1; o < 16; o <<= 1) sum += __shfl_xor(sum, o);
        const float mu = sum * (1.0f / 256.0f); float q = 0.f;
        for (int e = 0; e < 16; ++e) { const float dl = acc[e] - mu; q += dl * dl; }
        for (int o = 1; o < 16; o <<= 1) q += __shfl_xor(q, o);
        const float rs = rsqrtf(q * (1.0f / 256.0f) + GN_EPS);
        bf16* g = GS + (size_t)(b * SEQ + t0 + row) * 2048 + h * 256 + ec;
        for (int e = 0; e < 16; ++e) g[e] = (bf16)f2bf((acc[e] - mu) * rs * bf2f(g[e]));
    }
}
__global__ __launch_bounds__(512) void k_naive_sb(unsigned char* act) {
    __shared__ float Qs[32][129]; __shared__ bf16 Ks[32][130]; __shared__ bf16 Vs[32][130]; __shared__ float Zs[32][33];
    bf16* GS = (bf16*)(act + A_GS); const bf16* SK = (const bf16*)(act + A_SK); const bf16* SV = (const bf16*)(act + A_SV);
    const int tid = threadIdx.x;
    for (int item = blockIdx.x; item < BG * 8 * 64; item += gridDim.x) {
        const int tt = 63 - (item % 64), h = (item / 64) % 8, b = item / 512, t0 = tt * 32;
        __syncthreads();
        for (int e = tid; e < 32 * 128; e += 512) { const int i = e >> 7, d = e & 127; Qs[i][d] = bf2f(GS[(size_t)(b * SEQ + t0 + i) * 2048 + 1024 + h * 128 + d]); }
        const int row = tid >> 4, dc = (tid & 15) * 8;
        float acc[8]; for (int e = 0; e < 8; ++e) acc[e] = 0.f;
        float R = 0.f;
        for (int st = tt; st >= 0; --st) {
            const int s0 = st * 32;
            __syncthreads();
            for (int e = tid; e < 32 * 128; e += 512) { const int i = e >> 7, d = e & 127;
                Ks[i][d] = SK[(size_t)(b * SEQ + s0 + i) * 1024 + h * 128 + d]; Vs[i][d] = SV[(size_t)(b * SEQ + s0 + i) * 1024 + h * 128 + d]; }
            __syncthreads();
            for (int jj = 0; jj < 2; ++jj) { const int i = tid >> 4, j = (tid & 15) * 2 + jj; float s = 0.f;
                for (int d = 0; d < 128; ++d) s += Qs[i][d] * bf2f(Ks[j][d]);
                Zs[i][j] = s; }
            __syncthreads();
            if (tid < 32) { const int t = t0 + tid;
                for (int j = 31; j >= 0; --j) { const int sx = s0 + j; float w = 0.f;
                    if (sx < t) { const float z = Zs[tid][j] * LN2; const float sp = fmaxf(z, 0.f) + log1pf(__expf(-fabsf(z))); w = __expf(z - sp + R); R -= sp; }
                    Zs[tid][j] = w; } }
            __syncthreads();
            for (int j = 0; j < 32; ++j) { const float w = Zs[row][j]; for (int e = 0; e < 8; ++e) acc[e] += w * bf2f(Vs[j][dc + e]); }
        }
        bf16* o = GS + (size_t)(b * SEQ + t0 + row) * 2048 + 1024 + h * 128 + dc;
        for (int e = 0; e < 8; ++e) o[e] = (bf16)f2bf(acc[e]);
    }
}

extern "C" void kernel_launch(void* const* d_in, const int* in_sizes, int n_in, void* d_out, int out_size, void* d_ws, size_t ws_size, hipStream_t stream) {
    if (n_in != 10 || in_sizes[0] != M * D || out_size != M * D || ws_size < WS_END) { fprintf(stderr, "kernel_launch: unexpected shapes (n_in %d, ws %zu)\n", n_in, ws_size); return; }
    const float* x = (const float*)d_in[0]; const float* w_in = (const float*)d_in[1]; const float* p_ret = (const float*)d_in[2]; const float* p_sb = (const float*)d_in[3];
    const float* w_out = (const float*)d_in[4]; const float* w_up = (const float*)d_in[5]; const float* w_down = (const float*)d_in[6];
    const float* g_mix = (const float*)d_in[7]; const float* g_mlp = (const float*)d_in[8]; const float* g_final = (const float*)d_in[9];
    unsigned char* ws = (unsigned char*)d_ws; float* out = (float*)d_out;
    float* rope = (float*)(ws + WS_ROPE); float* ssq = (float*)(ws + WS_SSQ); bf16* xb = (bf16*)(ws + WS_XB); unsigned char* act = ws + WS_ACT;
    k_prologue<<<1024, 256, 0, stream>>>(x, out, xb, ssq, rope);
    for (int l = 0; l < DEPTH; ++l) {
        for (int g = 0; g < NGRP; ++g) {
            const int grow0 = g * MG;
            NGP p{}; p.act = act; p.ssq = ssq; p.rope = rope; p.xout = out; p.xb = xb; p.grow0 = grow0; p.rows = MG;
            p.A0 = p.A1 = xb + (size_t)grow0 * D; p.lda0 = p.lda1 = D; p.W0 = p.W1 = w_in + (size_t)l * D * DIN; p.ldw0 = p.ldw1 = DIN; p.gain = g_mix + l * D; p.K = D; p.mode = MODE_P1; p.nct = 64;
            k_naive_gemm<<<256, 512, 0, stream>>>(p);
            k_naive_ret<<<512, 512, 0, stream>>>(act);
            k_naive_sb<<<512, 512, 0, stream>>>(act);
            p.A0 = (const bf16*)(act + A_GS); p.A1 = (const bf16*)(act + A_GS) + 1024; p.lda0 = p.lda1 = 2048; p.W0 = p_ret + (size_t)l * D * D; p.W1 = p_sb + (size_t)l * D * D; p.ldw0 = p.ldw1 = D;
            p.gain = nullptr; p.K = D; p.mode = MODE_P3; p.nct = 16;
            k_naive_gemm<<<256, 512, 0, stream>>>(p);
            p.A0 = p.A1 = (const bf16*)(ws + WS_TMP); p.lda0 = p.lda1 = D; p.W0 = p.W1 = w_out + (size_t)l * D * D; p.ldw0 = p.ldw1 = D; p.K = D; p.mode = MODE_P4; p.nct = 8;
            k_naive_gemm<<<256, 512, 0, stream>>>(p);
            k_rowstats<<<512, 256, 0, stream>>>(out, ssq, grow0, MG);
            p.A0 = p.A1 = xb + (size_t)grow0 * D; p.lda0 = p.lda1 = D; p.W0 = p.W1 = w_up + (size_t)l * D * DFF; p.ldw0 = p.ldw1 = DFF; p.gain = g_mlp + l * D; p.K = D; p.mode = MODE_P5; p.nct = 32;
            k_naive_gemm<<<256, 512, 0, stream>>>(p);
            p.A0 = p.A1 = (const bf16*)(act + A_UP); p.lda0 = p.lda1 = DFF; p.W0 = p.W1 = w_down + (size_t)l * DFF * D; p.ldw0 = p.ldw1 = D; p.gain = nullptr; p.K = DFF; p.mode = MODE_P6; p.nct = 8;
            k_naive_gemm<<<256, 512, 0, stream>>>(p);
            k_rowstats<<<512, 256, 0, stream>>>(out, ssq, grow0, MG);
        }
    }
    k_final_norm<<<1024, 256, 0, stream>>>(out, g_final);
}
```

```cpp
#include <hip/hip_runtime.h>
#include <hip/hip_cooperative_groups.h>
#include <cstdio>
#include <cstdint>
namespace cg = cooperative_groups;

constexpr int D = 1024, BATCH = 16, SEQ = 2048, DEPTH = 4, M = BATCH * SEQ;
constexpr int DIN = 8192, DFF = 4096;
constexpr int NGRP = 2, BG = BATCH / NGRP, MG = BG * SEQ;
constexpr float NORM_EPS = 1e-6f, GN_EPS = 1e-5f;
constexpr float LOG2E = 1.4426950408889634f, LN2 = 0.6931471805599453f;
constexpr float QS_SCALE = 0.08838834764831845f * LOG2E;
constexpr float KR_SCALE = 0.08838834764831845f;

typedef unsigned short bf16;
constexpr size_t MiB = 1u << 20;
constexpr size_t WS_CTL = 0;
constexpr size_t WS_ROPE = 1 * MiB;
constexpr size_t WS_SSQ = 2 * MiB;
constexpr size_t WS_XB = 4 * MiB;
constexpr size_t WS_W = 68 * MiB;
constexpr size_t WL_WIN = 0, WL_PCAT = 16 * MiB, WL_WOUT = 20 * MiB, WL_WUP = 22 * MiB, WL_WDN = 30 * MiB, WL_STRIDE = 38 * MiB;
constexpr size_t WS_ACT = 220 * MiB;
constexpr size_t WS_END = 476 * MiB;
constexpr size_t A_RQK = 0, A_RV = 32 * MiB, A_GS = 64 * MiB, A_SK = 128 * MiB, A_SV = 160 * MiB, A_GA = 192 * MiB, A_GB = 224 * MiB;
constexpr size_t A_MERGED = 0, A_UP = 0;

__device__ __forceinline__ unsigned f2bf(float f) { unsigned u = __builtin_bit_cast(unsigned, f); return (u + 0x7fffu + ((u >> 16) & 1u)) >> 16; }
__device__ __forceinline__ float bf2f(unsigned h) { return __builtin_bit_cast(float, h << 16); }
__device__ __forceinline__ unsigned pk2(float lo, float hi) { return f2bf(lo) | (f2bf(hi) << 16); }

__device__ __forceinline__ void naive_ret_phase(unsigned char* act, unsigned char* lds) {
    float (*Qs)[129] = (float (*)[129])lds; bf16 (*Ks)[130] = (bf16 (*)[130])(lds + 16512); bf16 (*Vs)[258] = (bf16 (*)[258])(lds + 16512 + 8320); float (*Ss)[33] = (float (*)[33])(lds + 16512 + 8320 + 16512);
    const bf16* RQK = (const bf16*)(act + A_RQK); const bf16* RV = (const bf16*)(act + A_RV); bf16* GS = (bf16*)(act + A_GS);
    int tid = threadIdx.x; asm volatile("" : "+v"(tid));
    for (int item = blockIdx.x; item < BG * 4 * 64; item += gridDim.x) {
        const int tt = 63 - (item % 64), h = (item / 64) % 4, b = item / 256, t0 = tt * 32;
        const float lg = log1pf(-exp2f(-5.0f - (float)h));
        __syncthreads();
        for (int e = tid; e < 32 * 128; e += 512) { const int i = e >> 7, d = e & 127; Qs[i][d] = bf2f(RQK[(size_t)(b * SEQ + t0 + i) * 1024 + h * 128 + d]); }
        const int row = tid >> 4, ec = (tid & 15) * 16;
        float acc[16];
#pragma unroll
        for (int e = 0; e < 16; ++e) acc[e] = 0.f;
        for (int st = 0; st <= tt; ++st) {
            const int s0 = st * 32;
            __syncthreads();
            for (int e = tid; e < 32 * 128; e += 512) { const int i = e >> 7, d = e & 127; Ks[i][d] = RQK[(size_t)(b * SEQ + s0 + i) * 1024 + 512 + h * 128 + d]; }
            for (int e = tid; e < 32 * 256; e += 512) { const int i = e >> 8, d = e & 255; Vs[i][d] = RV[(size_t)(b * SEQ + s0 + i) * 1024 + h * 256 + d]; }
            __syncthreads();
            for (int jj = 0; jj < 2; ++jj) { const int i = tid >> 4, j = (tid & 15) * 2 + jj; float s = 0.f;
                for (int d = 0; d < 128; ++d) s += Qs[i][d] * bf2f(Ks[j][d]);
                const int t = t0 + i, sx = s0 + j; Ss[i][j] = (t >= sx) ? s * __expf(lg * (float)(t - sx)) : 0.f; }
            __syncthreads();
            for (int j = 0; j < 32; ++j) { const float s = Ss[row][j];
#pragma unroll
                for (int e = 0; e < 16; ++e) acc[e] += s * bf2f(Vs[j][ec + e]); }
        }
        float sum = 0.f;
#pragma unroll
        for (int e = 0; e < 16; ++e) sum += acc[e];
        for (int o = 1; o < 16; o <<= 1) sum += __shfl_xor(sum, o);
        const float mu = sum * (1.0f / 256.0f); float q = 0.f;
#pragma unroll
        for (int e = 0; e < 16; ++e) { const float dl = acc[e] - mu; q += dl * dl; }
        for (int o = 1; o < 16; o <<= 1) q += __shfl_xor(q, o);
        const float rs = rsqrtf(q * (1.0f / 256.0f) + GN_EPS);
        bf16* g = GS + (size_t)(b * SEQ + t0 + row) * 2048 + h * 256 + ec;
#pragma unroll
        for (int e = 0; e < 16; ++e) g[e] = (bf16)f2bf((acc[e] - mu) * rs * bf2f(g[e]));
    }
}
__device__ __forceinline__ void naive_sb_phase(unsigned char* act, unsigned char* lds) {
    float (*Qs)[129] = (float (*)[129])lds; bf16 (*Ks)[130] = (bf16 (*)[130])(lds + 16512); bf16 (*Vs)[130] = (bf16 (*)[130])(lds + 16512 + 8320); float (*Zs)[33] = (float (*)[33])(lds + 16512 + 8320 + 8320);
    bf16* GS = (bf16*)(act + A_GS); const bf16* SK = (const bf16*)(act + A_SK); const bf16* SV = (const bf16*)(act + A_SV);
    int tid = threadIdx.x; asm volatile("" : "+v"(tid));
    for (int item = blockIdx.x; item < BG * 8 * 64; item += gridDim.x) {
        const int tt = 63 - (item % 64), h = (item / 64) % 8, b = item / 512, t0 = tt * 32;
        __syncthreads();
        for (int e = tid; e < 32 * 128; e += 512) { const int i = e >> 7, d = e & 127; Qs[i][d] = bf2f(GS[(size_t)(b * SEQ + t0 + i) * 2048 + 1024 + h * 128 + d]); }
        const int row = tid >> 4, dc = (tid & 15) * 8;
        float acc[8];
#pragma unroll
        for (int e = 0; e < 8; ++e) acc[e] = 0.f;
        float R = 0.f;
        for (int st = tt; st >= 0; --st) {
            const int s0 = st * 32;
            __syncthreads();
            for (int e = tid; e < 32 * 128; e += 512) { const int i = e >> 7, d = e & 127;
                Ks[i][d] = SK[(size_t)(b * SEQ + s0 + i) * 1024 + h * 128 + d]; Vs[i][d] = SV[(size_t)(b * SEQ + s0 + i) * 1024 + h * 128 + d]; }
            __syncthreads();
            for (int jj = 0; jj < 2; ++jj) { const int i = tid >> 4, j = (tid & 15) * 2 + jj; float s = 0.f;
                for (int d = 0; d < 128; ++d) s += Qs[i][d] * bf2f(Ks[j][d]);
                Zs[i][j] = s; }
            __syncthreads();
            if (tid < 32) { const int t = t0 + tid;
                for (int j = 31; j >= 0; --j) { const int sx = s0 + j; float w = 0.f;
                    if (sx < t) { const float z = Zs[tid][j] * LN2; const float sp = fmaxf(z, 0.f) + log1pf(__expf(-fabsf(z))); w = __expf(z - sp + R); R -= sp; }
                    Zs[tid][j] = w; } }
            __syncthreads();
            for (int j = 0; j < 32; ++j) { const float w = Zs[row][j];
#pragma unroll
                for (int e = 0; e < 8; ++e) acc[e] += w * bf2f(Vs[j][dc + e]); }
        }
        bf16* o = GS + (size_t)(b * SEQ + t0 + row) * 2048 + 1024 + h * 128 + dc;
#pragma unroll
        for (int e = 0; e < 8; ++e) o[e] = (bf16)f2bf(acc[e]);
    }
}

namespace pg8 {
#define PG8_LAS __attribute__((address_space(3)))
typedef unsigned short bf16_t;
typedef short bf16x8 __attribute__((ext_vector_type(8)));
typedef float f32x4 __attribute__((ext_vector_type(4)));
typedef unsigned u32x4 __attribute__((ext_vector_type(4)));
constexpr int BM = 256, BK = 64, HALF = 128, HTB = HALF * BK * 2  , STAGE_BYTES = 8 * HTB, NXCD = 8, WGM = 8;

__host__ __device__ __forceinline__ int lds_byte(int r, int c) { const int st = (r >> 4) * 2 + (c >> 5), rr = r & 15, cc = c & 31, ob = rr * 64 + cc * 2; return st * 1024 + (ob ^ (((ob >> 9) & 1) << 5)); }
__host__ __device__ __forceinline__ void stage_rc(int b, int& R, int& C) { const int st = b / 1024, sb = b % 1024, swz = sb ^ (((sb >> 9) & 1) << 5); R = (st >> 1) * 16 + swz / 64; C = (st & 1) * 32 + (swz % 64) / 2; }
__host__ __device__ __forceinline__ int perm32(int rho) { const int n = rho >> 4, i = rho & 15; return 8 * (i >> 2) + 4 * n + (i & 3); }

struct Unit { int pm, pn, kofs; };
struct Gemm { const bf16_t* A; const bf16_t* Bt; int M, N, K, Kloop; };

struct StaticOrder {
    int nM, nN, nwg, G, c;
    __host__ __device__ void init(int M, int N, int G_, int c_) { nM = M / BM; nN = N / BM; nwg = nM * nN; G = G_; c = c_; }
    __host__ __device__ bool next(int i, Unit& u) const {
        const long L = (long)i * G + c; if (L >= nwg) return false;
        int wgid = (int)L; { const int q = nwg / NXCD, r = nwg % NXCD, xcd = wgid % NXCD, off = wgid / NXCD; wgid = (xcd < r ? xcd * (q + 1) : r * (q + 1) + (xcd - r) * q) + off; }
        const int nig = WGM * nN, gid = wgid / nig, fm = gid * WGM, gsz = (nM - fm) < WGM ? (nM - fm) : WGM;
        u.pm = fm + ((wgid % nig) % gsz); u.pn = (wgid % nig) / gsz; u.kofs = 0; return true;
    }
    __device__ __forceinline__ void a_ready(const Unit&) const {}
    __device__ __forceinline__ void done(const Unit&) const {}
};
struct ChainOrder : StaticOrder {
    int kh;
    __host__ __device__ bool next(int i, Unit& u) const { if (!StaticOrder::next(i >> 1, u)) return false; u.kofs = (i & 1) * kh; return true; }
};


typedef unsigned u32x2 __attribute__((ext_vector_type(2)));
__device__ __forceinline__ unsigned cvt_pk_bf16(float lo, float hi) { unsigned r; asm volatile("v_cvt_pk_bf16_f32 %0, %1, %2" : "=v"(r) : "v"(lo), "v"(hi)); return r; }
__device__ __forceinline__ u32x2 pack4(const f32x4 v) { u32x2 w; w.x = cvt_pk_bf16(v[0], v[1]); w.y = cvt_pk_bf16(v[2], v[3]); return w; }
__device__ __forceinline__ u32x4 pack8(const f32x4 a, const f32x4 b) { u32x4 w; w.x = cvt_pk_bf16(a[0], a[1]); w.y = cvt_pk_bf16(a[2], a[3]); w.z = cvt_pk_bf16(b[0], b[1]); w.w = cvt_pk_bf16(b[2], b[3]); return w; }
__device__ __forceinline__ f32x4 unpack_lo(const u32x4 w) { f32x4 r; r[0] = __builtin_bit_cast(float, w.x << 16); r[1] = __builtin_bit_cast(float, w.x & 0xffff0000u); r[2] = __builtin_bit_cast(float, w.y << 16); r[3] = __builtin_bit_cast(float, w.y & 0xffff0000u); return r; }
__device__ __forceinline__ f32x4 unpack_hi(const u32x4 w) { f32x4 r; r[0] = __builtin_bit_cast(float, w.z << 16); r[1] = __builtin_bit_cast(float, w.z & 0xffff0000u); r[2] = __builtin_bit_cast(float, w.w << 16); r[3] = __builtin_bit_cast(float, w.w & 0xffff0000u); return r; }
__device__ __forceinline__ float row_rstd(const char* ub, unsigned lo) {
    const f32x4* p = (const f32x4*)(ub + lo);
    const f32x4 a = p[0], b = p[1], c = p[2], d = p[3];
    const float s = (((a[0] + a[1]) + (a[2] + a[3])) + ((b[0] + b[1]) + (b[2] + b[3]))) + (((c[0] + c[1]) + (c[2] + c[3])) + ((d[0] + d[1]) + (d[2] + d[3])));
    return rsqrtf(s * (1.0f / 1024.0f) + NORM_EPS);
}
__device__ __forceinline__ f32x4 exp4(const f32x4 v) { f32x4 r; r[0] = __expf(v[0]); r[1] = __expf(v[1]); r[2] = __expf(v[2]); r[3] = __expf(v[3]); return r; }
__device__ __forceinline__ f32x4 rcp4(const f32x4 v) { f32x4 r; r[0] = __builtin_amdgcn_rcpf(v[0]); r[1] = __builtin_amdgcn_rcpf(v[1]); r[2] = __builtin_amdgcn_rcpf(v[2]); r[3] = __builtin_amdgcn_rcpf(v[3]); return r; }

struct EpiP1 {
    static constexpr bool PERM = false, AFTER_DRAIN = false, MID = false;
    unsigned char* act; const float* ssq; const float* rope; int grow0;
    __device__ __forceinline__ void mid(f32x4 (&)[2][2][4][2], const Unit&, int, int, int, int) const {}
    __device__ __forceinline__ void operator()(const f32x4 (&acc)[2][2][4][2], const Unit& u, int wr, int wc, int fr, int fq) const {
        const int pn = u.pn, rlu = u.pm * BM + wr * 64;
        const char* sq = (const char*)ssq + (size_t)(grow0 + rlu) * 64;
        unsigned lf = (unsigned)fr, lq = (unsigned)fq; asm volatile("" : "+v"(lf), "+v"(lq));
        float rs[2][4];
#pragma unroll
        for (int ai = 0; ai < 2; ++ai)
#pragma unroll
            for (int m = 0; m < 4; ++m) rs[ai][m] = row_rstd(sq + (ai * HALF + m * 16) * 64, lf * 64u);
        if (pn < 4) {
            const unsigned j0 = 16 * wc + 4 * lq;
            char* ub = (char*)(act + A_RQK) + ((size_t)rlu * 1024 + (pn >> 1) * 512 + (pn & 1) * 256) * 2;
            const unsigned lo = (lf * 1024u + j0) * 2u;
            const char* rp = (const char*)rope + (size_t)((grow0 + rlu) & (SEQ - 1)) * 256;
            const unsigned rlo = lf * 256u + j0 * 4u;
#pragma unroll
            for (int ai = 0; ai < 2; ++ai)
#pragma unroll
                for (int m = 0; m < 4; ++m) {
                    const f32x4 cs = *(const f32x4*)(rp + (ai * HALF + m * 16) * 256 + rlo), sn = *(const f32x4*)(rp + SEQ * 256 + (ai * HALF + m * 16) * 256 + rlo);
#pragma unroll
                    for (int bj = 0; bj < 2; ++bj) {
                        const f32x4 t1 = acc[ai][bj][m][0] * rs[ai][m], t2 = acc[ai][bj][m][1] * rs[ai][m];
                        const f32x4 o1 = t1 * cs - t2 * sn, o2 = t1 * sn + t2 * cs;
                        char* d = ub + ((ai * HALF + m * 16) * 1024 + bj * 128) * 2;
                        *(u32x2*)(d + lo) = pack4(o1); *(u32x2*)(d + 128 + lo) = pack4(o2);
                    }
                }
        } else if (pn < 24) {
            char* ub; int pitch; bool silu = false;
            if (pn < 8) { ub = (char*)(act + A_RV) + (pn - 4) * 512; pitch = 2048; }
            else if (pn < 12) { ub = (char*)(act + A_GS) + (pn - 8) * 512; pitch = 4096; silu = true; }
            else if (pn < 16) { ub = (char*)(act + A_GS) + 2048 + (pn - 12) * 512; pitch = 4096; }
            else if (pn < 20) { ub = (char*)(act + A_SK) + (pn - 16) * 512; pitch = 2048; }
            else { ub = (char*)(act + A_SV) + (pn - 20) * 512; pitch = 2048; }
            ub += (size_t)rlu * pitch;
            const unsigned lo = lf * (unsigned)pitch + ((unsigned)(wc * 32) + 8u * lq) * 2u;
#pragma unroll
            for (int ai = 0; ai < 2; ++ai)
#pragma unroll
                for (int m = 0; m < 4; ++m) {
                    char* rowp = ub + (size_t)(ai * HALF + m * 16) * pitch;
#pragma unroll
                    for (int bj = 0; bj < 2; ++bj) {
                        f32x4 v0 = acc[ai][bj][m][0] * rs[ai][m], v1 = acc[ai][bj][m][1] * rs[ai][m];
                        if (silu) { v0 = v0 * rcp4(exp4(-v0) + 1.0f); v1 = v1 * rcp4(exp4(-v1) + 1.0f); }
                        *(u32x4*)(rowp + bj * 256 + lo) = pack8(v0, v1);
                    }
                }
        } else {
            const size_t uo = ((size_t)rlu * 1024 + 128 * (pn - 24)) * 2;
            char* ga = (char*)(act + A_GA) + uo; char* gb = (char*)(act + A_GB) + uo;
            const unsigned lo = (lf * 1024u + (unsigned)(32 * wc) + 8u * lq) * 2u;
#pragma unroll
            for (int ai = 0; ai < 2; ++ai)
#pragma unroll
                for (int m = 0; m < 4; ++m) {
                    f32x4 ra[2], sb[2];
#pragma unroll
                    for (int n = 0; n < 2; ++n) {
                        const f32x4 ea = exp4(-(acc[ai][0][m][n] * rs[ai][m])) + 1.0f, eb = exp4(-(acc[ai][1][m][n] * rs[ai][m])) + 1.0f;
                        sb[n] = rcp4(eb); ra[n] = eb * rcp4(ea);
                    }
                    *(u32x4*)(ga + (ai * HALF + m * 16) * 2048 + lo) = pack8(ra[0], ra[1]);
                    *(u32x4*)(gb + (ai * HALF + m * 16) * 2048 + lo) = pack8(sb[0], sb[1]);
                }
        }
    }
};
struct EpiP3 {
    static constexpr bool PERM = false, AFTER_DRAIN = false, MID = true;
    unsigned char* act;
    __device__ __forceinline__ void mid(f32x4 (&acc)[2][2][4][2], const Unit& u, int wr, int wc, int fr, int fq) const {
        const char* g = (const char*)(act + A_GA) + ((size_t)(u.pm * BM + wr * 64) * 1024 + u.pn * BM) * 2;
        unsigned lo = ((unsigned)fr * 1024u + (unsigned)(wc * 32 + 8 * fq)) * 2u; asm volatile("" : "+v"(lo));
#pragma unroll
        for (int ai = 0; ai < 2; ++ai)
#pragma unroll
            for (int m = 0; m < 4; ++m)
#pragma unroll
                for (int bj = 0; bj < 2; ++bj) {
                    const u32x4 w = *(const u32x4*)(g + ((ai * HALF + m * 16) * 2048 + bj * 256) + lo);
                    acc[ai][bj][m][0] *= unpack_lo(w); acc[ai][bj][m][1] *= unpack_hi(w);
                }
    }
    __device__ __forceinline__ void operator()(const f32x4 (&acc)[2][2][4][2], const Unit& u, int wr, int wc, int fr, int fq) const {
        const size_t uo = ((size_t)(u.pm * BM + wr * 64) * 1024 + u.pn * BM) * 2;
        const char* g = (const char*)(act + A_GB) + uo; char* o = (char*)(act + A_MERGED) + uo;
        unsigned lo = ((unsigned)fr * 1024u + (unsigned)(wc * 32 + 8 * fq)) * 2u; asm volatile("" : "+v"(lo));
#pragma unroll
        for (int ai = 0; ai < 2; ++ai)
#pragma unroll
            for (int m = 0; m < 4; ++m)
#pragma unroll
                for (int bj = 0; bj < 2; ++bj) {
                    const int co = (ai * HALF + m * 16) * 2048 + bj * 256;
                    const u32x4 w = *(const u32x4*)(g + co + lo);
                    *(u32x4*)(o + co + lo) = pack8(acc[ai][bj][m][0] * unpack_lo(w), acc[ai][bj][m][1] * unpack_hi(w));
                }
    }
};
struct EpiX {
    static constexpr bool PERM = false, AFTER_DRAIN = false, MID = false;
    float* out; bf16_t* xb; float* ssq; int grow0;
    __device__ __forceinline__ void mid(f32x4 (&)[2][2][4][2], const Unit&, int, int, int, int) const {}
    __device__ __forceinline__ void operator()(const f32x4 (&acc)[2][2][4][2], const Unit& u, int wr, int wc, int fr, int fq) const {
        const size_t Ru = (size_t)(grow0 + u.pm * BM + wr * 64), cu = (size_t)(u.pn * BM + wc * 32);
        char* xo = (char*)out + (Ru * D + cu) * 4; char* xbo = (char*)xb + (Ru * D + cu) * 2; char* sq = (char*)ssq + Ru * 64 + (u.pn * 4 + wc) * 4;
        unsigned lo4 = ((unsigned)fr * 1024u + 4u * (unsigned)fq) * 4u, los = (unsigned)fr * 64u; asm volatile("" : "+v"(lo4), "+v"(los)); const unsigned lo2 = lo4 >> 1;
#pragma unroll
        for (int ai = 0; ai < 2; ++ai)
#pragma unroll
            for (int m = 0; m < 4; ++m) {
                float s = 0.f;
#pragma unroll
                for (int bj = 0; bj < 2; ++bj)
#pragma unroll
                    for (int n = 0; n < 2; ++n) {
                        const int co = (ai * HALF + m * 16) * 1024 + bj * HALF + n * 16;
                        const f32x4 xn = *(const f32x4*)(xo + co * 4 + lo4) + acc[ai][bj][m][n];
                        *(f32x4*)(xo + co * 4 + lo4) = xn; *(u32x2*)(xbo + co * 2 + lo2) = pack4(xn);
                        s += (xn[0] * xn[0] + xn[1] * xn[1]) + (xn[2] * xn[2] + xn[3] * xn[3]);
                    }
                s += __shfl_xor(s, 16); s += __shfl_xor(s, 32);
                if (fq == 0) *(float*)(sq + (ai * HALF + m * 16) * 64 + los) = s;
            }
    }
};
struct EpiP5 {
    static constexpr bool PERM = false, AFTER_DRAIN = false, MID = false;
    unsigned char* act; const float* ssq; int grow0;
    __device__ __forceinline__ void mid(f32x4 (&)[2][2][4][2], const Unit&, int, int, int, int) const {}
    __device__ __forceinline__ void operator()(const f32x4 (&acc)[2][2][4][2], const Unit& u, int wr, int wc, int fr, int fq) const {
        const int rlu = u.pm * BM + wr * 64;
        const char* sq = (const char*)ssq + (size_t)(grow0 + rlu) * 64;
        char* ub = (char*)(act + A_UP) + ((size_t)rlu * DFF + u.pn * BM) * 2;
        unsigned lo = ((unsigned)fr * (unsigned)DFF + (unsigned)(wc * 32 + 8 * fq)) * 2u, lf = (unsigned)fr * 64u; asm volatile("" : "+v"(lo), "+v"(lf));
#pragma unroll
        for (int ai = 0; ai < 2; ++ai)
#pragma unroll
            for (int m = 0; m < 4; ++m) {
                const float rs = row_rstd(sq + (ai * HALF + m * 16) * 64, lf);
#pragma unroll
                for (int bj = 0; bj < 2; ++bj) {
                    f32x4 v0 = acc[ai][bj][m][0] * rs, v1 = acc[ai][bj][m][1] * rs;
#pragma unroll
                    for (int e = 0; e < 4; ++e) { const float a = fmaxf(v0[e], 0.f), b = fmaxf(v1[e], 0.f); v0[e] = a * a; v1[e] = b * b; }
                    *(u32x4*)(ub + ((ai * HALF + m * 16) * DFF + bj * HALF) * 2 + lo) = pack8(v0, v1);
                }
            }
    }
};

template <class Epi, class Sched, bool ALIGN_EPI = false, bool SP2 = false>
__device__ __forceinline__ void gemm_phase(PG8_LAS unsigned char* lds, const Gemm g, const Sched& S, const Epi& E) {
    int tid = threadIdx.x; asm volatile("" : "+v"(tid));
    const int wid = __builtin_amdgcn_readfirstlane(tid >> 6), lane = tid & 63, wr = wid >> 2, wc = wid & 3, fr = lane & 15, fq = lane >> 4;
    const int K = g.K, nt = g.Kloop / BK;
    unsigned voffA[2], voffB[2];
#pragma unroll
    for (int i = 0; i < 2; ++i) { int R, C; stage_rc(tid * 16 + i * 8192, R, C); const int Rb = Epi::PERM ? ((R & ~31) + perm32(R & 31)) : R;
        voffA[i] = (unsigned)(R * K + C) * 2u; voffB[i] = (unsigned)(Rb * K + C) * 2u; }
    const size_t kstep = (size_t)(BK * 2);
    const size_t hstep = (size_t)HALF * K * 2;
    const size_t tstep = 2 * hstep;
    const unsigned ldsw = (unsigned)wid * 1024u;
    const int aoff = lds_byte(wr * 64 + fr, fq * 8), boff = lds_byte(wc * 32 + fr, fq * 8);
#define PG8_SA(b, h) (((b) * 2 + (h)) * HTB)
#define PG8_SB(b, h) ((4 + (b) * 2 + (h)) * HTB)
#define PG8_STAGE(bufoff, gbase, voff) do { _Pragma("unroll") for (int _i = 0; _i < 2; ++_i) \
        __builtin_amdgcn_global_load_lds((const unsigned*)((const char*)(gbase) + (voff)[_i]), (PG8_LAS unsigned*)(lds + (bufoff) + ldsw + _i * 8192), 16, 0, 0); } while (0)
#define PG8_LDA(dst, b, h) do { _Pragma("unroll") for (int m = 0; m < 4; ++m) _Pragma("unroll") for (int k = 0; k < 2; ++k) dst[m][k] = *(const PG8_LAS bf16x8*)(lds + PG8_SA(b, h) + aoff + m * 2048 + k * 1024); } while (0)
#define PG8_LDB(dst, b, h) do { _Pragma("unroll") for (int n = 0; n < 2; ++n) _Pragma("unroll") for (int k = 0; k < 2; ++k) dst[n][k] = *(const PG8_LAS bf16x8*)(lds + PG8_SB(b, h) + boff + n * 2048 + k * 1024); } while (0)
#define PG8_MMA(ai, bj, At, Bt) do { __builtin_amdgcn_s_setprio(1); _Pragma("unroll") for (int m = 0; m < 4; ++m) _Pragma("unroll") for (int n = 0; n < 2; ++n) _Pragma("unroll") for (int k = 0; k < 2; ++k) \
        acc[ai][bj][m][n] = __builtin_amdgcn_mfma_f32_16x16x32_bf16(Bt[n][k], At[m][k], acc[ai][bj][m][n], 0, 0, 0); __builtin_amdgcn_s_setprio(0); } while (0)
#define PG8_WAIT_V(n) asm volatile("s_waitcnt vmcnt(" #n ")" ::: "memory")
#define PG8_WAIT_L(n) asm volatile("s_waitcnt lgkmcnt(" #n ")" ::: "memory")
#define PG8_BAR __builtin_amdgcn_s_barrier()
#define PG8_SCHED __builtin_amdgcn_sched_barrier(0)
    Unit cur, nxt; int ui = 0;
    if (!S.next(0, cur)) return;
    f32x4 acc[2][2][4][2];
#pragma unroll
    for (int a = 0; a < 2; ++a)
#pragma unroll
        for (int b = 0; b < 2; ++b)
#pragma unroll
            for (int m = 0; m < 4; ++m)
#pragma unroll
                for (int n = 0; n < 2; ++n) acc[a][b][m][n] = (f32x4){0.f, 0.f, 0.f, 0.f};
    bf16x8 At[4][2], B0[2][2], B1[2][2];
    const char* cA = (const char*)g.A + (size_t)cur.pm * tstep + (size_t)cur.kofs * 2; const char* cB = (const char*)g.Bt + (size_t)cur.pn * tstep + (size_t)cur.kofs * 2;
    S.a_ready(cur);
    if constexpr (SP2) {
        PG8_STAGE(PG8_SB(0, 0), cB, voffB); PG8_STAGE(PG8_SB(0, 1), cB + hstep, voffB); PG8_STAGE(PG8_SA(0, 0), cA, voffA); PG8_STAGE(PG8_SA(0, 1), cA + hstep, voffA);
        if (wr == 1) PG8_BAR;
        PG8_WAIT_V(2); PG8_BAR;
        PG8_STAGE(PG8_SB(1, 0), cB + kstep, voffB); PG8_STAGE(PG8_SA(1, 0), cA + kstep, voffA); PG8_STAGE(PG8_SB(1, 1), cB + hstep + kstep, voffB);
        PG8_WAIT_V(6); PG8_BAR;
    } else {
        PG8_STAGE(PG8_SB(0, 0), cB, voffB); PG8_STAGE(PG8_SA(0, 0), cA, voffA); PG8_STAGE(PG8_SB(0, 1), cB + hstep, voffB); PG8_STAGE(PG8_SA(0, 1), cA + hstep, voffA);
        if (wr == 1) PG8_BAR;
        PG8_WAIT_V(4); PG8_BAR;
        PG8_STAGE(PG8_SB(1, 0), cB + kstep, voffB); PG8_STAGE(PG8_SA(1, 0), cA + kstep, voffA); PG8_STAGE(PG8_SB(1, 1), cB + hstep + kstep, voffB);
        PG8_WAIT_V(6); PG8_BAR;
    }
    for (;;) {
        const bool has_next = S.next(ui + 1, nxt);
        const char* nA = has_next ? (const char*)g.A + (size_t)nxt.pm * tstep + (size_t)nxt.kofs * 2 : cA; const char* nB = has_next ? (const char*)g.Bt + (size_t)nxt.pn * tstep + (size_t)nxt.kofs * 2 : cB;
        for (int t = 0; t < nt; t += 2) {
            const bool last = (t == nt - 2);
            const char* a1 = cA + (size_t)(t + 1) * kstep;
            const char* a2 = last ? nA : cA + (size_t)(t + 2) * kstep; const char* b2 = last ? nB : cB + (size_t)(t + 2) * kstep;
            const char* a3 = a2 + kstep; const char* b3 = b2 + kstep;
            if (last && has_next) S.a_ready(nxt);
            if constexpr (SP2) {
            PG8_LDB(B0, 0, 0); PG8_LDB(B1, 0, 1); PG8_SCHED; PG8_LDA(At, 0, 0); PG8_STAGE(PG8_SA(1, 1), a1 + hstep, voffA);
            PG8_WAIT_V(8); PG8_WAIT_L(0); PG8_BAR; PG8_MMA(0, 0, At, B0); PG8_MMA(0, 1, At, B1); PG8_BAR; PG8_SCHED;
            PG8_LDA(At, 0, 1); PG8_STAGE(PG8_SB(0, 0), b2, voffB); PG8_STAGE(PG8_SB(0, 1), b2 + hstep, voffB); PG8_STAGE(PG8_SA(0, 0), a2, voffA);
            PG8_WAIT_V(8); PG8_WAIT_L(0); PG8_BAR; PG8_MMA(1, 0, At, B0); PG8_MMA(1, 1, At, B1); PG8_BAR; PG8_SCHED;
            PG8_LDB(B0, 1, 0); PG8_LDB(B1, 1, 1); PG8_SCHED; PG8_LDA(At, 1, 0); PG8_STAGE(PG8_SA(0, 1), a2 + hstep, voffA);
            PG8_WAIT_V(8); PG8_WAIT_L(0); PG8_BAR; PG8_MMA(0, 0, At, B0); PG8_MMA(0, 1, At, B1); PG8_BAR; PG8_SCHED;
            PG8_LDA(At, 1, 1); PG8_STAGE(PG8_SB(1, 0), b3, voffB); PG8_STAGE(PG8_SB(1, 1), b3 + hstep, voffB); PG8_STAGE(PG8_SA(1, 0), a3, voffA);
            PG8_WAIT_V(8); PG8_WAIT_L(0); PG8_BAR; PG8_MMA(1, 0, At, B0); PG8_MMA(1, 1, At, B1); PG8_BAR; PG8_SCHED;
            } else {
            PG8_LDB(B0, 0, 0); PG8_SCHED; PG8_LDA(At, 0, 0); PG8_STAGE(PG8_SA(1, 1), a1 + hstep, voffA);
            PG8_WAIT_L(8); PG8_BAR; PG8_WAIT_L(0); PG8_MMA(0, 0, At, B0); PG8_BAR; PG8_SCHED;
            PG8_LDB(B1, 0, 1); PG8_STAGE(PG8_SB(0, 0), b2, voffB);
            PG8_BAR; PG8_WAIT_L(0); PG8_MMA(0, 1, At, B1); PG8_BAR;
            PG8_LDA(At, 0, 1); PG8_STAGE(PG8_SA(0, 0), a2, voffA);
            PG8_BAR; PG8_WAIT_L(0); PG8_MMA(1, 0, At, B0); PG8_BAR; PG8_SCHED;
            PG8_STAGE(PG8_SB(0, 1), b2 + hstep, voffB);
            PG8_WAIT_V(6); PG8_BAR; PG8_MMA(1, 1, At, B1); PG8_BAR;
            PG8_LDB(B0, 1, 0); PG8_SCHED; PG8_LDA(At, 1, 0); PG8_STAGE(PG8_SA(0, 1), a2 + hstep, voffA);
            PG8_WAIT_L(8); PG8_BAR; PG8_WAIT_L(0); PG8_MMA(0, 0, At, B0); PG8_BAR; PG8_SCHED;
            PG8_LDB(B1, 1, 1); PG8_STAGE(PG8_SB(1, 0), b3, voffB);
            PG8_BAR; PG8_WAIT_L(0); PG8_MMA(0, 1, At, B1); PG8_BAR;
            PG8_LDA(At, 1, 1); PG8_STAGE(PG8_SA(1, 0), a3, voffA);
            PG8_BAR; PG8_WAIT_L(0); PG8_MMA(1, 0, At, B0); PG8_BAR; PG8_SCHED;
            PG8_STAGE(PG8_SB(1, 1), b3 + hstep, voffB);
            PG8_WAIT_V(6); PG8_BAR; PG8_MMA(1, 1, At, B1); PG8_BAR;
            }
        }
        if constexpr (ALIGN_EPI) { if (wr == 0) PG8_BAR; }
        bool chain_first = false;
        if constexpr (Epi::MID) { chain_first = (cur.kofs == 0); }
        if constexpr (!Epi::AFTER_DRAIN) { if (chain_first) E.mid(acc, cur, wr, wc, fr, fq); else { E(acc, cur, wr, wc, fr, fq); S.done(cur); } }
        if (!has_next) break;
        if (!chain_first)
#pragma unroll
        for (int a = 0; a < 2; ++a)
#pragma unroll
            for (int b = 0; b < 2; ++b)
#pragma unroll
                for (int m = 0; m < 4; ++m)
#pragma unroll
                    for (int n = 0; n < 2; ++n) acc[a][b][m][n] = (f32x4){0.f, 0.f, 0.f, 0.f};
        cur = nxt; cA = nA; cB = nB; ++ui;
        if constexpr (ALIGN_EPI) { if (wr == 1) PG8_BAR; }
    }
    PG8_WAIT_V(0);
    if constexpr (!ALIGN_EPI) { if (wr == 0) PG8_BAR; }
    PG8_BAR;
    if constexpr (Epi::AFTER_DRAIN) { E.fused(acc, cur, wr, wc, fr, fq, lds, wid, lane); S.done(cur); }
#undef PG8_SA
#undef PG8_SB
#undef PG8_STAGE
#undef PG8_LDA
#undef PG8_LDB
#undef PG8_MMA
#undef PG8_WAIT_V
#undef PG8_WAIT_L
#undef PG8_BAR
#undef PG8_SCHED
}
}

#define LAS __attribute__((address_space(3)))
typedef unsigned v4u __attribute__((ext_vector_type(4)));
#define LDS_WAIT() asm volatile("s_waitcnt lgkmcnt(0)" ::: "memory")
constexpr int NWAVES = 8;
constexpr int LDS_BYTES = 147456;

__device__ __forceinline__ int rho32(int l) { return 16 * ((l >> 2) & 1) + 4 * (l >> 3) + (l & 3); }
__device__ __forceinline__ int pos_win(int c) {
    if (c < 1024) { const int hh = c >> 7, j = c & 127, n = j >> 6, jj = j & 63; return 256 * (hh >> 1) + 128 * (hh & 1) + 32 * (jj >> 4) + 16 * n + (jj & 15); }
    if (c < 6144) return (c & ~31) + rho32(c & 31);
    const int isb = (c >= 7168) ? 1 : 0, ch = (c - 6144) & 1023, j = ch >> 7, w = ch & 127;
    return 256 * (24 + j) + 128 * isb + (w & ~31) + rho32(w & 31);
}
enum { KIND_NAT = 0, KIND_P32 = 1, KIND_WIN = 2 };
__device__ __forceinline__ void tr_item(const float* __restrict__ W, int N, bf16* __restrict__ WT, int ldt, int koff, int kind, const float* __restrict__ gain, LAS float* scr, int item, int lane) {
    const int nblk = N / 32, kb = item / nblk, nb = item % nblk, k0 = 64 * kb, n0 = 32 * nb;
#pragma unroll 8
    for (int i = 0; i < 32; ++i) { const int kk = 2 * i + (lane >> 5); scr[kk * 33 + (lane & 31)] = W[(size_t)(k0 + kk) * N + n0 + (lane & 31)]; }
    LDS_WAIT(); asm volatile("" ::: "memory");
    const int c = lane & 7;
    float gn[8];
#pragma unroll
    for (int i = 0; i < 8; ++i) gn[i] = gain ? gain[k0 + 8 * c + i] : 1.0f;
#pragma unroll
    for (int j = 0; j < 4; ++j) {
        const int n = (lane >> 3) + 8 * j, cl = n0 + n; int pos = cl; float sc = 1.0f;
        if (kind == KIND_P32) pos = (cl & ~31) + rho32(cl & 31);
        else if (kind == KIND_WIN) { pos = pos_win(cl); if (cl >= 512 && cl < 1024) sc = KR_SCALE; else if (cl >= 3072 && cl < 4096) sc = QS_SCALE; }
        const LAS float* s = scr + (8 * c) * 33 + n;
        v4u o; o.x = pk2(s[0 * 33] * gn[0] * sc, s[1 * 33] * gn[1] * sc); o.y = pk2(s[2 * 33] * gn[2] * sc, s[3 * 33] * gn[3] * sc);
        o.z = pk2(s[4 * 33] * gn[4] * sc, s[5 * 33] * gn[5] * sc); o.w = pk2(s[6 * 33] * gn[6] * sc, s[7 * 33] * gn[7] * sc);
        *(v4u*)(WT + (size_t)pos * ldt + koff + k0 + 8 * c) = o;
    }
    LDS_WAIT(); asm volatile("" ::: "memory");
}

struct Args { const float* in[10]; float* out; unsigned char* ws; int ph_lo, ph_hi; };
constexpr int PH_PRO = 0, PH_FINAL = 1 + 6 * DEPTH * NGRP;

__device__ __forceinline__ void prologue_phase(const Args& a, unsigned char* lds) {
    int tid_ = threadIdx.x; asm volatile("" : "+v"(tid_));
    const int lane = tid_ & 63, wave = __builtin_amdgcn_readfirstlane(tid_ >> 6);
    const float* x = a.in[0]; float* out = a.out; bf16* xb = (bf16*)(a.ws + WS_XB); float* ssq = (float*)(a.ws + WS_SSQ); float* rope = (float*)(a.ws + WS_ROPE);
    const int gw = blockIdx.x * NWAVES + wave, NGW = gridDim.x * NWAVES;
    LAS float* scr = (LAS float*)((LAS unsigned char*)lds + wave * 16384);
    constexpr int I_IN = 16 * 256, I_SQ = 16 * 32, I_UP = 16 * 128, I_DN = 64 * 32, I_LAYER = I_IN + 3 * I_SQ + I_UP + I_DN;
    for (int it = gw; it < DEPTH * I_LAYER; it += NGW) {
        const int l = it / I_LAYER; int r = it % I_LAYER;
        unsigned char* wl = a.ws + WS_W + (size_t)l * WL_STRIDE;
        if (r < I_IN) { tr_item(a.in[1] + (size_t)l * D * DIN, DIN, (bf16*)(wl + WL_WIN), D, 0, KIND_WIN, a.in[7] + l * D, scr, r, lane); continue; } r -= I_IN;
        if (r < I_SQ) { tr_item(a.in[2] + (size_t)l * D * D, D, (bf16*)(wl + WL_PCAT), 2 * D, 0, KIND_P32, nullptr, scr, r, lane); continue; } r -= I_SQ;
        if (r < I_SQ) { tr_item(a.in[3] + (size_t)l * D * D, D, (bf16*)(wl + WL_PCAT), 2 * D, D, KIND_P32, nullptr, scr, r, lane); continue; } r -= I_SQ;
        if (r < I_SQ) { tr_item(a.in[4] + (size_t)l * D * D, D, (bf16*)(wl + WL_WOUT), D, 0, KIND_NAT, nullptr, scr, r, lane); continue; } r -= I_SQ;
        if (r < I_UP) { tr_item(a.in[5] + (size_t)l * D * DFF, DFF, (bf16*)(wl + WL_WUP), D, 0, KIND_P32, a.in[8] + l * D, scr, r, lane); continue; } r -= I_UP;
        tr_item(a.in[6] + (size_t)l * DFF * D, D, (bf16*)(wl + WL_WDN), DFF, 0, KIND_NAT, nullptr, scr, r, lane);
    }
    for (int r = gw; r < M; r += NGW) {
        float s = 0.f;
#pragma unroll
        for (int j = 0; j < 4; ++j) {
            const int c = j * 256 + lane * 4;
            const float4 v = *(const float4*)(x + (size_t)r * D + c);
            *(float4*)(out + (size_t)r * D + c) = v;
            s += v.x * v.x + v.y * v.y + v.z * v.z + v.w * v.w;
            uint2 w; w.x = pk2(v.x, v.y); w.y = pk2(v.z, v.w);
            *(uint2*)(xb + (size_t)r * D + c) = w;
        }
#pragma unroll
        for (int o = 1; o < 64; o <<= 1) s += __shfl_xor(s, o);
        if (lane < 16) ssq[(size_t)r * 16 + lane] = (lane == 0) ? s : 0.f;
    }
    for (int i = blockIdx.x * 512 + tid_; i < SEQ * 64; i += gridDim.x * 512) {
        const int pos = i >> 6, j = i & 63;
        const float inv = powf(10000.0f, -(float)j / 64.0f);
        const float ang = (float)pos * inv;
        rope[i] = cosf(ang); rope[SEQ * 64 + i] = sinf(ang);
    }
}
__device__ __forceinline__ void final_phase(const Args& a) {
    int tid_ = threadIdx.x; asm volatile("" : "+v"(tid_));
    const int lane = tid_ & 63, wave = __builtin_amdgcn_readfirstlane(tid_ >> 6);
    float* out = a.out; const float* g = a.in[9];
    const int gw = blockIdx.x * NWAVES + wave, NGW = gridDim.x * NWAVES;
    for (int r = gw; r < M; r += NGW) {
        float4 v[4]; float s = 0.f;
#pragma unroll
        for (int j = 0; j < 4; ++j) { v[j] = *(const float4*)(out + (size_t)r * D + j * 256 + lane * 4); s += v[j].x * v[j].x + v[j].y * v[j].y + v[j].z * v[j].z + v[j].w * v[j].w; }
#pragma unroll
        for (int o = 1; o < 64; o <<= 1) s += __shfl_xor(s, o);
        const float rs = rsqrtf(s * (1.0f / D) + NORM_EPS);
#pragma unroll
        for (int j = 0; j < 4; ++j) { const float4 gg = *(const float4*)(g + j * 256 + lane * 4);
            float4 o; o.x = v[j].x * rs * gg.x; o.y = v[j].y * rs * gg.y; o.z = v[j].z * rs * gg.z; o.w = v[j].w * rs * gg.w;
            *(float4*)(out + (size_t)r * D + j * 256 + lane * 4) = o; }
    }
}

#ifndef PHMASK
#define PHMASK 31
#endif
#ifndef MK_ONE_LAUNCH
#define MK_ONE_LAUNCH 1
#endif
__global__ void __launch_bounds__(NWAVES * 64, 2) mega(Args a) {
    extern __shared__ __attribute__((aligned(16))) unsigned char lds[];
    const int G = gridDim.x;
    PG8_LAS unsigned char* ring = (PG8_LAS unsigned char*)lds;
#if MK_ONE_LAUNCH
#define GRID_SYNC() cg::this_grid().sync()
#else
#define GRID_SYNC() do {} while (0)
#endif
    int ph = a.ph_lo; const int ph_hi = a.ph_hi;
    if (ph == PH_PRO) { prologue_phase(a, lds); ++ph; if (ph < ph_hi) GRID_SYNC(); }
    const int ph_end = ph_hi < PH_FINAL ? ph_hi : PH_FINAL;
    for (; ph < ph_end; ++ph) {
        size_t zofs = 0; asm volatile("" : "+s"(zofs));
        unsigned char* ws = a.ws + zofs; float* outp = (float*)((unsigned char*)a.out + zofs);
        unsigned char* act = ws + WS_ACT; float* ssq = (float*)(ws + WS_SSQ); const float* rope = (const float*)(ws + WS_ROPE); bf16* xb = (bf16*)(ws + WS_XB);
        {
            const int q = ph - 1, k = q % 6, lg = q / 6, l = lg / NGRP, g = lg % NGRP, grow0 = g * MG;
            const unsigned char* wl = ws + WS_W + (size_t)l * WL_STRIDE;
            if (k == 0 && (PHMASK & 1)) {
                pg8::Gemm gm{xb + (size_t)grow0 * D, (const bf16*)(wl + WL_WIN), MG, DIN, D, D}; pg8::StaticOrder S; S.init(MG, DIN, G, (int)blockIdx.x);
                pg8::EpiP1 E{act, ssq, rope, grow0};
                pg8::gemm_phase<pg8::EpiP1, pg8::StaticOrder, true, true>(ring, gm, S, E);
            } else if (k == 1) {
                naive_ret_phase(act, lds); __syncthreads(); naive_sb_phase(act, lds); __syncthreads();
            } else if (k == 2 && (PHMASK & 2)) {
                pg8::Gemm gm{(const bf16*)(act + A_GS), (const bf16*)(wl + WL_PCAT), MG, D, 2 * D, D}; pg8::ChainOrder S; S.init(MG, D, G, (int)blockIdx.x); S.kh = D;
                pg8::EpiP3 E{act};
                pg8::gemm_phase<pg8::EpiP3, pg8::ChainOrder, true, true>(ring, gm, S, E);
            } else if (k == 3 && (PHMASK & 4)) {
                pg8::Gemm gm{(const bf16*)(act + A_MERGED), (const bf16*)(wl + WL_WOUT), MG, D, D, D}; pg8::StaticOrder S; S.init(MG, D, G, (int)blockIdx.x);
                pg8::EpiX E{outp, xb, ssq, grow0};
                pg8::gemm_phase<pg8::EpiX, pg8::StaticOrder, true, true>(ring, gm, S, E);
            } else if (k == 4 && (PHMASK & 8)) {
                pg8::Gemm gm{xb + (size_t)grow0 * D, (const bf16*)(wl + WL_WUP), MG, DFF, D, D}; pg8::StaticOrder S; S.init(MG, DFF, G, (int)blockIdx.x);
                pg8::EpiP5 E{act, ssq, grow0};
                pg8::gemm_phase<pg8::EpiP5, pg8::StaticOrder, true, true>(ring, gm, S, E);
            } else if (k == 5 && (PHMASK & 16)) {
                pg8::Gemm gm{(const bf16*)(act + A_UP), (const bf16*)(wl + WL_WDN), MG, D, DFF, DFF}; pg8::StaticOrder S; S.init(MG, D, G, (int)blockIdx.x);
                pg8::EpiX E{outp, xb, ssq, grow0};
                pg8::gemm_phase<pg8::EpiX, pg8::StaticOrder, true, true>(ring, gm, S, E);
            }
        }
        if (ph + 1 < ph_hi) GRID_SYNC();
    }
    if (ph_hi > PH_FINAL) final_phase(a);
}

extern "C" void kernel_launch(void* const* d_in, const int* in_sizes, int n_in, void* d_out, int out_size, void* d_ws, size_t ws_size, hipStream_t stream) {
    static int grid = 0;
    if (grid == 0) {
        if (n_in != 10 || in_sizes[0] != M * D || out_size != M * D || ws_size < WS_END) { fprintf(stderr, "kernel_launch: unexpected shapes (n_in %d, ws %zu)\n", n_in, ws_size); grid = -1; return; }
        int dev = 0, cus = 0;
        if (hipGetDevice(&dev) != hipSuccess || hipDeviceGetAttribute(&cus, hipDeviceAttributeMultiprocessorCount, dev) != hipSuccess) { grid = -1; return; }
        if (hipFuncSetAttribute((const void*)mega, hipFuncAttributeMaxDynamicSharedMemorySize, LDS_BYTES) != hipSuccess) { fprintf(stderr, "kernel_launch: hipFuncSetAttribute failed\n"); grid = -1; return; }
        int per_cu = 0;
        if (hipOccupancyMaxActiveBlocksPerMultiprocessor(&per_cu, (const void*)mega, NWAVES * 64, LDS_BYTES) != hipSuccess || per_cu < 1) { fprintf(stderr, "kernel_launch: occupancy query says %d blocks per CU\n", per_cu); (void)hipGetLastError(); per_cu = 1; }
        grid = cus;
    }
    if (grid < 0) return;
    Args a{};
    for (int i = 0; i < 10; ++i) a.in[i] = (const float*)d_in[i];
    a.out = (float*)d_out; a.ws = (unsigned char*)d_ws;
#if MK_ONE_LAUNCH
    a.ph_lo = 0; a.ph_hi = PH_FINAL + 1;
    void* kargs[] = {&a};
    const hipError_t le = hipLaunchCooperativeKernel((const void*)mega, dim3(grid), dim3(NWAVES * 64), kargs, LDS_BYTES, stream);
    if (le != hipSuccess) fprintf(stderr, "kernel_launch: cooperative launch failed: %s (grid %d)\n", hipGetErrorString(le), grid);
#else
    auto run = [&](int lo, int hi) { a.ph_lo = lo; a.ph_hi = hi; hipLaunchKernelGGL(mega, dim3(grid), dim3(NWAVES * 64), LDS_BYTES, stream, a); };
    for (int p = 0; p <= PH_FINAL; ++p) run(p, p + 1);
#endif
}
```

```cpp
#include <hip/hip_runtime.h>
#include <hip/hip_cooperative_groups.h>
#include <cstdio>
#include <cstdint>
namespace cg = cooperative_groups;

constexpr int D = 1024, BATCH = 16, SEQ = 2048, DEPTH = 4, M = BATCH * SEQ;
constexpr int DIN = 8192, DFF = 4096;
constexpr int NGRP = 2, BG = BATCH / NGRP, MG = BG * SEQ;
constexpr float NORM_EPS = 1e-6f, GN_EPS = 1e-5f;
constexpr float LOG2E = 1.4426950408889634f, LN2 = 0.6931471805599453f;
constexpr float QS_SCALE = 0.08838834764831845f * LOG2E;
constexpr float KR_SCALE = 0.08838834764831845f;
constexpr float LG2_GAMMA0 = -0.045803689613124954f, LG2_GAMMA1 = -0.022720076500083545f, LG2_GAMMA2 = -0.011315313227834146f, LG2_GAMMA3 = -0.005646563141142062f;

typedef unsigned short bf16;
constexpr size_t MiB = 1u << 20;
constexpr size_t WS_CTL = 0;
constexpr size_t WS_ROPE = 1 * MiB;
constexpr size_t WS_SSQ = 2 * MiB;
constexpr size_t WS_XB = 4 * MiB;
constexpr size_t WS_W = 68 * MiB;
constexpr size_t WL_WIN = 0, WL_PCAT = 16 * MiB, WL_WOUT = 20 * MiB, WL_WUP = 22 * MiB, WL_WDN = 30 * MiB, WL_STRIDE = 38 * MiB;
constexpr size_t WS_ACT = 220 * MiB;
constexpr size_t WS_END = 476 * MiB;
constexpr size_t A_RQK = 0, A_RV = 32 * MiB, A_GS = 64 * MiB, A_SK = 128 * MiB, A_SV = 160 * MiB, A_GA = 192 * MiB, A_GB = 224 * MiB;
constexpr size_t A_MERGED = 0, A_UP = 0;

__device__ __forceinline__ unsigned f2bf(float f) { unsigned u = __builtin_bit_cast(unsigned, f); return (u + 0x7fffu + ((u >> 16) & 1u)) >> 16; }
__device__ __forceinline__ float bf2f(unsigned h) { return __builtin_bit_cast(float, h << 16); }
__device__ __forceinline__ unsigned pk2(float lo, float hi) { return f2bf(lo) | (f2bf(hi) << 16); }

__device__ __forceinline__ void naive_ret_phase(unsigned char* act, unsigned char* lds) {
    float (*Qs)[129] = (float (*)[129])lds; bf16 (*Ks)[130] = (bf16 (*)[130])(lds + 16512); bf16 (*Vs)[258] = (bf16 (*)[258])(lds + 16512 + 8320); float (*Ss)[33] = (float (*)[33])(lds + 16512 + 8320 + 16512);
    const bf16* RQK = (const bf16*)(act + A_RQK); const bf16* RV = (const bf16*)(act + A_RV); bf16* GS = (bf16*)(act + A_GS);
    int tid = threadIdx.x; asm volatile("" : "+v"(tid));
    for (int item = blockIdx.x; item < BG * 4 * 64; item += gridDim.x) {
        const int tt = 63 - (item % 64), h = (item / 64) % 4, b = item / 256, t0 = tt * 32;
        __syncthreads();
        for (int e = tid; e < 32 * 128; e += 512) { const int i = e >> 7, d = e & 127; Qs[i][d] = bf2f(RQK[(size_t)(b * SEQ + t0 + i) * 1024 + h * 128 + d]); }
        const int row = tid >> 4, ec = (tid & 15) * 16;
        float acc[16];
#pragma unroll
        for (int e = 0; e < 16; ++e) acc[e] = 0.f;
        for (int st = 0; st <= tt; ++st) {
            const int s0 = st * 32;
            __syncthreads();
            for (int e = tid; e < 32 * 128; e += 512) { const int i = e >> 7, d = e & 127; Ks[i][d] = RQK[(size_t)(b * SEQ + s0 + i) * 1024 + 512 + h * 128 + d]; }
            for (int e = tid; e < 32 * 256; e += 512) { const int i = e >> 8, d = e & 255; Vs[i][d] = RV[(size_t)(b * SEQ + s0 + i) * 1024 + h * 256 + d]; }
            __syncthreads();
            for (int jj = 0; jj < 2; ++jj) { const int i = tid >> 4, j = (tid & 15) * 2 + jj; float s = 0.f;
                for (int d = 0; d < 128; ++d) s += Qs[i][d] * bf2f(Ks[j][d]);
                const int t = t0 + i, sx = s0 + j; Ss[i][j] = (t >= sx) ? s : 0.f; }
            __syncthreads();
            for (int j = 0; j < 32; ++j) { const float s = Ss[row][j];
#pragma unroll
                for (int e = 0; e < 16; ++e) acc[e] += s * bf2f(Vs[j][ec + e]); }
        }
        float sum = 0.f;
#pragma unroll
        for (int e = 0; e < 16; ++e) sum += acc[e];
        for (int o = 1; o < 16; o <<= 1) sum += __shfl_xor(sum, o);
        const float mu = sum * (1.0f / 256.0f); float q = 0.f;
#pragma unroll
        for (int e = 0; e < 16; ++e) { const float dl = acc[e] - mu; q += dl * dl; }
        for (int o = 1; o < 16; o <<= 1) q += __shfl_xor(q, o);
        const float rs = rsqrtf(q * (1.0f / 256.0f) + GN_EPS);
        bf16* g = GS + (size_t)(b * SEQ + t0 + row) * 2048 + h * 256 + ec;
#pragma unroll
        for (int e = 0; e < 16; ++e) g[e] = (bf16)f2bf((acc[e] - mu) * rs * bf2f(g[e]));
    }
}
__device__ __forceinline__ void naive_sb_phase(unsigned char* act, unsigned char* lds) {
    float (*Qs)[129] = (float (*)[129])lds; bf16 (*Ks)[130] = (bf16 (*)[130])(lds + 16512); bf16 (*Vs)[130] = (bf16 (*)[130])(lds + 16512 + 8320); float (*Zs)[33] = (float (*)[33])(lds + 16512 + 8320 + 8320);
    bf16* GS = (bf16*)(act + A_GS); const bf16* SK = (const bf16*)(act + A_SK); const bf16* SV = (const bf16*)(act + A_SV);
    int tid = threadIdx.x; asm volatile("" : "+v"(tid));
    for (int item = blockIdx.x; item < BG * 8 * 64; item += gridDim.x) {
        const int tt = 63 - (item % 64), h = (item / 64) % 8, b = item / 512, t0 = tt * 32;
        __syncthreads();
        for (int e = tid; e < 32 * 128; e += 512) { const int i = e >> 7, d = e & 127; Qs[i][d] = bf2f(GS[(size_t)(b * SEQ + t0 + i) * 2048 + 1024 + h * 128 + d]); }
        const int row = tid >> 4, dc = (tid & 15) * 8;
        float acc[8];
#pragma unroll
        for (int e = 0; e < 8; ++e) acc[e] = 0.f;
        float R = 0.f;
        for (int st = tt; st >= 0; --st) {
            const int s0 = st * 32;
            __syncthreads();
            for (int e = tid; e < 32 * 128; e += 512) { const int i = e >> 7, d = e & 127;
                Ks[i][d] = SK[(size_t)(b * SEQ + s0 + i) * 1024 + h * 128 + d]; Vs[i][d] = SV[(size_t)(b * SEQ + s0 + i) * 1024 + h * 128 + d]; }
            __syncthreads();
            for (int jj = 0; jj < 2; ++jj) { const int i = tid >> 4, j = (tid & 15) * 2 + jj; float s = 0.f;
                for (int d = 0; d < 128; ++d) s += Qs[i][d] * bf2f(Ks[j][d]);
                Zs[i][j] = s; }
            __syncthreads();
            if (tid < 32) { const int t = t0 + tid;
                for (int j = 31; j >= 0; --j) { const int sx = s0 + j; float w = 0.f;
                    if (sx < t) { const float z = Zs[tid][j] * LN2; const float sp = fmaxf(z, 0.f) + log1pf(__expf(-fabsf(z))); w = __expf(z - sp + R); R -= sp; }
                    Zs[tid][j] = w; } }
            __syncthreads();
            for (int j = 0; j < 32; ++j) { const float w = Zs[row][j];
#pragma unroll
                for (int e = 0; e < 8; ++e) acc[e] += w * bf2f(Vs[j][dc + e]); }
        }
        bf16* o = GS + (size_t)(b * SEQ + t0 + row) * 2048 + 1024 + h * 128 + dc;
#pragma unroll
        for (int e = 0; e < 8; ++e) o[e] = (bf16)f2bf(acc[e]);
    }
}

namespace pg8 {
#define PG8_LAS __attribute__((address_space(3)))
typedef unsigned short bf16_t;
typedef short bf16x8 __attribute__((ext_vector_type(8)));
typedef float f32x4 __attribute__((ext_vector_type(4)));
typedef unsigned u32x4 __attribute__((ext_vector_type(4)));
constexpr int BM = 256, BK = 64, HALF = 128, HTB = HALF * BK * 2  , STAGE_BYTES = 8 * HTB, NXCD = 8, WGM = 8;

__host__ __device__ __forceinline__ int lds_byte(int r, int c) { const int st = (r >> 4) * 2 + (c >> 5), rr = r & 15, cc = c & 31, ob = rr * 64 + cc * 2; return st * 1024 + (ob ^ (((ob >> 9) & 1) << 5)); }
__host__ __device__ __forceinline__ void stage_rc(int b, int& R, int& C) { const int st = b / 1024, sb = b % 1024, swz = sb ^ (((sb >> 9) & 1) << 5); R = (st >> 1) * 16 + swz / 64; C = (st & 1) * 32 + (swz % 64) / 2; }
__host__ __device__ __forceinline__ int perm32(int rho) { const int n = rho >> 4, i = rho & 15; return 8 * (i >> 2) + 4 * n + (i & 3); }

struct Unit { int pm, pn, kofs; };
struct Gemm { const bf16_t* A; const bf16_t* Bt; int M, N, K, Kloop; };

struct StaticOrder {
    int nM, nN, nwg, G, c;
    __host__ __device__ void init(int M, int N, int G_, int c_) { nM = M / BM; nN = N / BM; nwg = nM * nN; G = G_; c = c_; }
    __host__ __device__ bool next(int i, Unit& u) const {
        const long L = (long)i * G + c; if (L >= nwg) return false;
        int wgid = (int)L; { const int q = nwg / NXCD, r = nwg % NXCD, xcd = wgid % NXCD, off = wgid / NXCD; wgid = (xcd < r ? xcd * (q + 1) : r * (q + 1) + (xcd - r) * q) + off; }
        const int nig = WGM * nN, gid = wgid / nig, fm = gid * WGM, gsz = (nM - fm) < WGM ? (nM - fm) : WGM;
        u.pm = fm + ((wgid % nig) % gsz); u.pn = (wgid % nig) / gsz; u.kofs = 0; return true;
    }
    __device__ __forceinline__ void a_ready(const Unit&) const {}
    __device__ __forceinline__ void done(const Unit&) const {}
};
struct ChainOrder : StaticOrder {
    int kh;
    __host__ __device__ bool next(int i, Unit& u) const { if (!StaticOrder::next(i >> 1, u)) return false; u.kofs = (i & 1) * kh; return true; }
};


typedef unsigned u32x2 __attribute__((ext_vector_type(2)));
__device__ __forceinline__ unsigned cvt_pk_bf16(float lo, float hi) { unsigned r; asm volatile("v_cvt_pk_bf16_f32 %0, %1, %2" : "=v"(r) : "v"(lo), "v"(hi)); return r; }
__device__ __forceinline__ u32x2 pack4(const f32x4 v) { u32x2 w; w.x = cvt_pk_bf16(v[0], v[1]); w.y = cvt_pk_bf16(v[2], v[3]); return w; }
__device__ __forceinline__ u32x4 pack8(const f32x4 a, const f32x4 b) { u32x4 w; w.x = cvt_pk_bf16(a[0], a[1]); w.y = cvt_pk_bf16(a[2], a[3]); w.z = cvt_pk_bf16(b[0], b[1]); w.w = cvt_pk_bf16(b[2], b[3]); return w; }
__device__ __forceinline__ f32x4 unpack_lo(const u32x4 w) { f32x4 r; r[0] = __builtin_bit_cast(float, w.x << 16); r[1] = __builtin_bit_cast(float, w.x & 0xffff0000u); r[2] = __builtin_bit_cast(float, w.y << 16); r[3] = __builtin_bit_cast(float, w.y & 0xffff0000u); return r; }
__device__ __forceinline__ f32x4 unpack_hi(const u32x4 w) { f32x4 r; r[0] = __builtin_bit_cast(float, w.z << 16); r[1] = __builtin_bit_cast(float, w.z & 0xffff0000u); r[2] = __builtin_bit_cast(float, w.w << 16); r[3] = __builtin_bit_cast(float, w.w & 0xffff0000u); return r; }
__device__ __forceinline__ float row_rstd(const char* ub, unsigned lo) {
    const f32x4* p = (const f32x4*)(ub + lo);
    const f32x4 a = p[0], b = p[1], c = p[2], d = p[3];
    const float s = (((a[0] + a[1]) + (a[2] + a[3])) + ((b[0] + b[1]) + (b[2] + b[3]))) + (((c[0] + c[1]) + (c[2] + c[3])) + ((d[0] + d[1]) + (d[2] + d[3])));
    return rsqrtf(s * (1.0f / 1024.0f) + NORM_EPS);
}
__device__ __forceinline__ f32x4 exp4(const f32x4 v) { f32x4 r; r[0] = __expf(v[0]); r[1] = __expf(v[1]); r[2] = __expf(v[2]); r[3] = __expf(v[3]); return r; }
__device__ __forceinline__ f32x4 rcp4(const f32x4 v) { f32x4 r; r[0] = __builtin_amdgcn_rcpf(v[0]); r[1] = __builtin_amdgcn_rcpf(v[1]); r[2] = __builtin_amdgcn_rcpf(v[2]); r[3] = __builtin_amdgcn_rcpf(v[3]); return r; }

struct EpiP1 {
    static constexpr bool PERM = false, AFTER_DRAIN = false, MID = false;
    unsigned char* act; const float* ssq; const float* rope; int grow0;
    __device__ __forceinline__ void mid(f32x4 (&)[2][2][4][2], const Unit&, int, int, int, int) const {}
    __device__ __forceinline__ void operator()(const f32x4 (&acc)[2][2][4][2], const Unit& u, int wr, int wc, int fr, int fq) const {
        const int pn = u.pn, rlu = u.pm * BM + wr * 64;
        const char* sq = (const char*)ssq + (size_t)(grow0 + rlu) * 64;
        unsigned lf = (unsigned)fr, lq = (unsigned)fq; asm volatile("" : "+v"(lf), "+v"(lq));
        float rs[2][4];
#pragma unroll
        for (int ai = 0; ai < 2; ++ai)
#pragma unroll
            for (int m = 0; m < 4; ++m) rs[ai][m] = row_rstd(sq + (ai * HALF + m * 16) * 64, lf * 64u);
        if (pn < 4) {
            const unsigned j0 = 16 * wc + 4 * lq;
            char* ub = (char*)(act + A_RQK) + ((size_t)rlu * 1024 + (pn >> 1) * 512 + (pn & 1) * 256) * 2;
            const unsigned lo = (lf * 1024u + j0) * 2u;
            const int pos0 = (grow0 + rlu) & (SEQ - 1);
            const char* rp = (const char*)rope + (size_t)pos0 * 256;
            const float sg = (pn < 2) ? 1.0f : -1.0f;
            const float lgA0 = sg * LG2_GAMMA0, lgA1 = sg * LG2_GAMMA1, lgB0 = sg * LG2_GAMMA2, lgB1 = sg * LG2_GAMMA3;
            const unsigned rlo = lf * 256u + j0 * 4u;
#pragma unroll
            for (int ai = 0; ai < 2; ++ai)
#pragma unroll
                for (int m = 0; m < 4; ++m) {
                    const f32x4 cs = *(const f32x4*)(rp + (ai * HALF + m * 16) * 256 + rlo), sn = *(const f32x4*)(rp + SEQ * 256 + (ai * HALF + m * 16) * 256 + rlo);
                    const float posf = (float)(pos0 + ai * HALF + m * 16) + (float)lf;
#pragma unroll
                    for (int bj = 0; bj < 2; ++bj) {
                        const float fac = rs[ai][m] * __builtin_amdgcn_exp2f(posf * ((pn & 1) ? (bj ? lgB1 : lgB0) : (bj ? lgA1 : lgA0)));
                        const f32x4 t1 = acc[ai][bj][m][0] * fac, t2 = acc[ai][bj][m][1] * fac;
                        const f32x4 o1 = t1 * cs - t2 * sn, o2 = t1 * sn + t2 * cs;
                        char* d = ub + ((ai * HALF + m * 16) * 1024 + bj * 128) * 2;
                        *(u32x2*)(d + lo) = pack4(o1); *(u32x2*)(d + 128 + lo) = pack4(o2);
                    }
                }
        } else if (pn < 24) {
            char* ub; int pitch; bool silu = false;
            if (pn < 8) { ub = (char*)(act + A_RV) + (pn - 4) * 512; pitch = 2048; }
            else if (pn < 12) { ub = (char*)(act + A_GS) + (pn - 8) * 512; pitch = 4096; silu = true; }
            else if (pn < 16) { ub = (char*)(act + A_GS) + 2048 + (pn - 12) * 512; pitch = 4096; }
            else if (pn < 20) { ub = (char*)(act + A_SK) + (pn - 16) * 512; pitch = 2048; }
            else { ub = (char*)(act + A_SV) + (pn - 20) * 512; pitch = 2048; }
            ub += (size_t)rlu * pitch;
            const unsigned lo = lf * (unsigned)pitch + ((unsigned)(wc * 32) + 8u * lq) * 2u;
#pragma unroll
            for (int ai = 0; ai < 2; ++ai)
#pragma unroll
                for (int m = 0; m < 4; ++m) {
                    char* rowp = ub + (size_t)(ai * HALF + m * 16) * pitch;
#pragma unroll
                    for (int bj = 0; bj < 2; ++bj) {
                        f32x4 v0 = acc[ai][bj][m][0] * rs[ai][m], v1 = acc[ai][bj][m][1] * rs[ai][m];
                        if (silu) { v0 = v0 * rcp4(exp4(-v0) + 1.0f); v1 = v1 * rcp4(exp4(-v1) + 1.0f); }
                        *(u32x4*)(rowp + bj * 256 + lo) = pack8(v0, v1);
                    }
                }
        } else {
            const size_t uo = ((size_t)rlu * 1024 + 128 * (pn - 24)) * 2;
            char* ga = (char*)(act + A_GA) + uo; char* gb = (char*)(act + A_GB) + uo;
            const unsigned lo = (lf * 1024u + (unsigned)(32 * wc) + 8u * lq) * 2u;
#pragma unroll
            for (int ai = 0; ai < 2; ++ai)
#pragma unroll
                for (int m = 0; m < 4; ++m) {
                    f32x4 ra[2], sb[2];
#pragma unroll
                    for (int n = 0; n < 2; ++n) {
                        const f32x4 ea = exp4(-(acc[ai][0][m][n] * rs[ai][m])) + 1.0f, eb = exp4(-(acc[ai][1][m][n] * rs[ai][m])) + 1.0f;
                        sb[n] = rcp4(eb); ra[n] = eb * rcp4(ea);
                    }
                    *(u32x4*)(ga + (ai * HALF + m * 16) * 2048 + lo) = pack8(ra[0], ra[1]);
                    *(u32x4*)(gb + (ai * HALF + m * 16) * 2048 + lo) = pack8(sb[0], sb[1]);
                }
        }
    }
};
struct EpiP3 {
    static constexpr bool PERM = false, AFTER_DRAIN = false, MID = true;
    unsigned char* act;
    __device__ __forceinline__ void mid(f32x4 (&acc)[2][2][4][2], const Unit& u, int wr, int wc, int fr, int fq) const {
        const char* g = (const char*)(act + A_GA) + ((size_t)(u.pm * BM + wr * 64) * 1024 + u.pn * BM) * 2;
        unsigned lo = ((unsigned)fr * 1024u + (unsigned)(wc * 32 + 8 * fq)) * 2u; asm volatile("" : "+v"(lo));
#pragma unroll
        for (int ai = 0; ai < 2; ++ai)
#pragma unroll
            for (int m = 0; m < 4; ++m)
#pragma unroll
                for (int bj = 0; bj < 2; ++bj) {
                    const u32x4 w = *(const u32x4*)(g + ((ai * HALF + m * 16) * 2048 + bj * 256) + lo);
                    acc[ai][bj][m][0] *= unpack_lo(w); acc[ai][bj][m][1] *= unpack_hi(w);
                }
    }
    __device__ __forceinline__ void operator()(const f32x4 (&acc)[2][2][4][2], const Unit& u, int wr, int wc, int fr, int fq) const {
        const size_t uo = ((size_t)(u.pm * BM + wr * 64) * 1024 + u.pn * BM) * 2;
        const char* g = (const char*)(act + A_GB) + uo; char* o = (char*)(act + A_MERGED) + uo;
        unsigned lo = ((unsigned)fr * 1024u + (unsigned)(wc * 32 + 8 * fq)) * 2u; asm volatile("" : "+v"(lo));
#pragma unroll
        for (int ai = 0; ai < 2; ++ai)
#pragma unroll
            for (int m = 0; m < 4; ++m)
#pragma unroll
                for (int bj = 0; bj < 2; ++bj) {
                    const int co = (ai * HALF + m * 16) * 2048 + bj * 256;
                    const u32x4 w = *(const u32x4*)(g + co + lo);
                    *(u32x4*)(o + co + lo) = pack8(acc[ai][bj][m][0] * unpack_lo(w), acc[ai][bj][m][1] * unpack_hi(w));
                }
    }
};
struct EpiX {
    static constexpr bool PERM = false, AFTER_DRAIN = false, MID = false;
    float* out; bf16_t* xb; float* ssq; int grow0;
    __device__ __forceinline__ void mid(f32x4 (&)[2][2][4][2], const Unit&, int, int, int, int) const {}
    __device__ __forceinline__ void operator()(const f32x4 (&acc)[2][2][4][2], const Unit& u, int wr, int wc, int fr, int fq) const {
        const size_t Ru = (size_t)(grow0 + u.pm * BM + wr * 64), cu = (size_t)(u.pn * BM + wc * 32);
        char* xo = (char*)out + (Ru * D + cu) * 4; char* xbo = (char*)xb + (Ru * D + cu) * 2; char* sq = (char*)ssq + Ru * 64 + (u.pn * 4 + wc) * 4;
        unsigned lo4 = ((unsigned)fr * 1024u + 4u * (unsigned)fq) * 4u, los = (unsigned)fr * 64u; asm volatile("" : "+v"(lo4), "+v"(los)); const unsigned lo2 = lo4 >> 1;
#pragma unroll
        for (int ai = 0; ai < 2; ++ai)
#pragma unroll
            for (int m = 0; m < 4; ++m) {
                float s = 0.f;
#pragma unroll
                for (int bj = 0; bj < 2; ++bj)
#pragma unroll
                    for (int n = 0; n < 2; ++n) {
                        const int co = (ai * HALF + m * 16) * 1024 + bj * HALF + n * 16;
                        const f32x4 xn = *(const f32x4*)(xo + co * 4 + lo4) + acc[ai][bj][m][n];
                        *(f32x4*)(xo + co * 4 + lo4) = xn; *(u32x2*)(xbo + co * 2 + lo2) = pack4(xn);
                        s += (xn[0] * xn[0] + xn[1] * xn[1]) + (xn[2] * xn[2] + xn[3] * xn[3]);
                    }
                s += __shfl_xor(s, 16); s += __shfl_xor(s, 32);
                if (fq == 0) *(float*)(sq + (ai * HALF + m * 16) * 64 + los) = s;
            }
    }
};
struct EpiP5 {
    static constexpr bool PERM = false, AFTER_DRAIN = false, MID = false;
    unsigned char* act; const float* ssq; int grow0;
    __device__ __forceinline__ void mid(f32x4 (&)[2][2][4][2], const Unit&, int, int, int, int) const {}
    __device__ __forceinline__ void operator()(const f32x4 (&acc)[2][2][4][2], const Unit& u, int wr, int wc, int fr, int fq) const {
        const int rlu = u.pm * BM + wr * 64;
        const char* sq = (const char*)ssq + (size_t)(grow0 + rlu) * 64;
        char* ub = (char*)(act + A_UP) + ((size_t)rlu * DFF + u.pn * BM) * 2;
        unsigned lo = ((unsigned)fr * (unsigned)DFF + (unsigned)(wc * 32 + 8 * fq)) * 2u, lf = (unsigned)fr * 64u; asm volatile("" : "+v"(lo), "+v"(lf));
#pragma unroll
        for (int ai = 0; ai < 2; ++ai)
#pragma unroll
            for (int m = 0; m < 4; ++m) {
                const float rs = row_rstd(sq + (ai * HALF + m * 16) * 64, lf);
#pragma unroll
                for (int bj = 0; bj < 2; ++bj) {
                    f32x4 v0 = acc[ai][bj][m][0] * rs, v1 = acc[ai][bj][m][1] * rs;
#pragma unroll
                    for (int e = 0; e < 4; ++e) { const float a = fmaxf(v0[e], 0.f), b = fmaxf(v1[e], 0.f); v0[e] = a * a; v1[e] = b * b; }
                    *(u32x4*)(ub + ((ai * HALF + m * 16) * DFF + bj * HALF) * 2 + lo) = pack8(v0, v1);
                }
            }
    }
};

template <class Epi, class Sched, bool ALIGN_EPI = false, bool SP2 = false>
__device__ __forceinline__ void gemm_phase(PG8_LAS unsigned char* lds, const Gemm g, const Sched& S, const Epi& E) {
    int tid = threadIdx.x; asm volatile("" : "+v"(tid));
    const int wid = __builtin_amdgcn_readfirstlane(tid >> 6), lane = tid & 63, wr = wid >> 2, wc = wid & 3, fr = lane & 15, fq = lane >> 4;
    const int K = g.K, nt = g.Kloop / BK;
    unsigned voffA[2], voffB[2];
#pragma unroll
    for (int i = 0; i < 2; ++i) { int R, C; stage_rc(tid * 16 + i * 8192, R, C); const int Rb = Epi::PERM ? ((R & ~31) + perm32(R & 31)) : R;
        voffA[i] = (unsigned)(R * K + C) * 2u; voffB[i] = (unsigned)(Rb * K + C) * 2u; }
    const size_t kstep = (size_t)(BK * 2);
    const size_t hstep = (size_t)HALF * K * 2;
    const size_t tstep = 2 * hstep;
    const unsigned ldsw = (unsigned)wid * 1024u;
    const int aoff = lds_byte(wr * 64 + fr, fq * 8), boff = lds_byte(wc * 32 + fr, fq * 8);
#define PG8_SA(b, h) (((b) * 2 + (h)) * HTB)
#define PG8_SB(b, h) ((4 + (b) * 2 + (h)) * HTB)
#define PG8_STAGE(bufoff, gbase, voff) do { _Pragma("unroll") for (int _i = 0; _i < 2; ++_i) \
        __builtin_amdgcn_global_load_lds((const unsigned*)((const char*)(gbase) + (voff)[_i]), (PG8_LAS unsigned*)(lds + (bufoff) + ldsw + _i * 8192), 16, 0, 0); } while (0)
#define PG8_LDA(dst, b, h) do { _Pragma("unroll") for (int m = 0; m < 4; ++m) _Pragma("unroll") for (int k = 0; k < 2; ++k) dst[m][k] = *(const PG8_LAS bf16x8*)(lds + PG8_SA(b, h) + aoff + m * 2048 + k * 1024); } while (0)
#define PG8_LDB(dst, b, h) do { _Pragma("unroll") for (int n = 0; n < 2; ++n) _Pragma("unroll") for (int k = 0; k < 2; ++k) dst[n][k] = *(const PG8_LAS bf16x8*)(lds + PG8_SB(b, h) + boff + n * 2048 + k * 1024); } while (0)
#define PG8_MMA(ai, bj, At, Bt) do { __builtin_amdgcn_s_setprio(1); _Pragma("unroll") for (int m = 0; m < 4; ++m) _Pragma("unroll") for (int n = 0; n < 2; ++n) _Pragma("unroll") for (int k = 0; k < 2; ++k) \
        acc[ai][bj][m][n] = __builtin_amdgcn_mfma_f32_16x16x32_bf16(Bt[n][k], At[m][k], acc[ai][bj][m][n], 0, 0, 0); __builtin_amdgcn_s_setprio(0); } while (0)
#define PG8_WAIT_V(n) asm volatile("s_waitcnt vmcnt(" #n ")" ::: "memory")
#define PG8_WAIT_L(n) asm volatile("s_waitcnt lgkmcnt(" #n ")" ::: "memory")
#define PG8_BAR __builtin_amdgcn_s_barrier()
#define PG8_SCHED __builtin_amdgcn_sched_barrier(0)
    Unit cur, nxt; int ui = 0;
    if (!S.next(0, cur)) return;
    f32x4 acc[2][2][4][2];
#pragma unroll
    for (int a = 0; a < 2; ++a)
#pragma unroll
        for (int b = 0; b < 2; ++b)
#pragma unroll
            for (int m = 0; m < 4; ++m)
#pragma unroll
                for (int n = 0; n < 2; ++n) acc[a][b][m][n] = (f32x4){0.f, 0.f, 0.f, 0.f};
    bf16x8 At[4][2], B0[2][2], B1[2][2];
    const char* cA = (const char*)g.A + (size_t)cur.pm * tstep + (size_t)cur.kofs * 2; const char* cB = (const char*)g.Bt + (size_t)cur.pn * tstep + (size_t)cur.kofs * 2;
    S.a_ready(cur);
    if constexpr (SP2) {
        PG8_STAGE(PG8_SB(0, 0), cB, voffB); PG8_STAGE(PG8_SB(0, 1), cB + hstep, voffB); PG8_STAGE(PG8_SA(0, 0), cA, voffA); PG8_STAGE(PG8_SA(0, 1), cA + hstep, voffA);
        if (wr == 1) PG8_BAR;
        PG8_WAIT_V(2); PG8_BAR;
        PG8_STAGE(PG8_SB(1, 0), cB + kstep, voffB); PG8_STAGE(PG8_SA(1, 0), cA + kstep, voffA); PG8_STAGE(PG8_SB(1, 1), cB + hstep + kstep, voffB);
        PG8_WAIT_V(6); PG8_BAR;
    } else {
        PG8_STAGE(PG8_SB(0, 0), cB, voffB); PG8_STAGE(PG8_SA(0, 0), cA, voffA); PG8_STAGE(PG8_SB(0, 1), cB + hstep, voffB); PG8_STAGE(PG8_SA(0, 1), cA + hstep, voffA);
        if (wr == 1) PG8_BAR;
        PG8_WAIT_V(4); PG8_BAR;
        PG8_STAGE(PG8_SB(1, 0), cB + kstep, voffB); PG8_STAGE(PG8_SA(1, 0), cA + kstep, voffA); PG8_STAGE(PG8_SB(1, 1), cB + hstep + kstep, voffB);
        PG8_WAIT_V(6); PG8_BAR;
    }
    for (;;) {
        const bool has_next = S.next(ui + 1, nxt);
        const char* nA = has_next ? (const char*)g.A + (size_t)nxt.pm * tstep + (size_t)nxt.kofs * 2 : cA; const char* nB = has_next ? (const char*)g.Bt + (size_t)nxt.pn * tstep + (size_t)nxt.kofs * 2 : cB;
        for (int t = 0; t < nt; t += 2) {
            const bool last = (t == nt - 2);
            const char* a1 = cA + (size_t)(t + 1) * kstep;
            const char* a2 = last ? nA : cA + (size_t)(t + 2) * kstep; const char* b2 = last ? nB : cB + (size_t)(t + 2) * kstep;
            const char* a3 = a2 + kstep; const char* b3 = b2 + kstep;
            if (last && has_next) S.a_ready(nxt);
            if constexpr (SP2) {
            PG8_LDB(B0, 0, 0); PG8_LDB(B1, 0, 1); PG8_SCHED; PG8_LDA(At, 0, 0); PG8_STAGE(PG8_SA(1, 1), a1 + hstep, voffA);
            PG8_WAIT_V(8); PG8_WAIT_L(0); PG8_BAR; PG8_MMA(0, 0, At, B0); PG8_MMA(0, 1, At, B1); PG8_BAR; PG8_SCHED;
            PG8_LDA(At, 0, 1); PG8_STAGE(PG8_SB(0, 0), b2, voffB); PG8_STAGE(PG8_SB(0, 1), b2 + hstep, voffB); PG8_STAGE(PG8_SA(0, 0), a2, voffA);
            PG8_WAIT_V(8); PG8_WAIT_L(0); PG8_BAR; PG8_MMA(1, 0, At, B0); PG8_MMA(1, 1, At, B1); PG8_BAR; PG8_SCHED;
            PG8_LDB(B0, 1, 0); PG8_LDB(B1, 1, 1); PG8_SCHED; PG8_LDA(At, 1, 0); PG8_STAGE(PG8_SA(0, 1), a2 + hstep, voffA);
            PG8_WAIT_V(8); PG8_WAIT_L(0); PG8_BAR; PG8_MMA(0, 0, At, B0); PG8_MMA(0, 1, At, B1); PG8_BAR; PG8_SCHED;
            PG8_LDA(At, 1, 1); PG8_STAGE(PG8_SB(1, 0), b3, voffB); PG8_STAGE(PG8_SB(1, 1), b3 + hstep, voffB); PG8_STAGE(PG8_SA(1, 0), a3, voffA);
            PG8_WAIT_V(8); PG8_WAIT_L(0); PG8_BAR; PG8_MMA(1, 0, At, B0); PG8_MMA(1, 1, At, B1); PG8_BAR; PG8_SCHED;
            } else {
            PG8_LDB(B0, 0, 0); PG8_SCHED; PG8_LDA(At, 0, 0); PG8_STAGE(PG8_SA(1, 1), a1 + hstep, voffA);
            PG8_WAIT_L(8); PG8_BAR; PG8_WAIT_L(0); PG8_MMA(0, 0, At, B0); PG8_BAR; PG8_SCHED;
            PG8_LDB(B1, 0, 1); PG8_STAGE(PG8_SB(0, 0), b2, voffB);
            PG8_BAR; PG8_WAIT_L(0); PG8_MMA(0, 1, At, B1); PG8_BAR;
            PG8_LDA(At, 0, 1); PG8_STAGE(PG8_SA(0, 0), a2, voffA);
            PG8_BAR; PG8_WAIT_L(0); PG8_MMA(1, 0, At, B0); PG8_BAR; PG8_SCHED;
            PG8_STAGE(PG8_SB(0, 1), b2 + hstep, voffB);
            PG8_WAIT_V(6); PG8_BAR; PG8_MMA(1, 1, At, B1); PG8_BAR;
            PG8_LDB(B0, 1, 0); PG8_SCHED; PG8_LDA(At, 1, 0); PG8_STAGE(PG8_SA(0, 1), a2 + hstep, voffA);
            PG8_WAIT_L(8); PG8_BAR; PG8_WAIT_L(0); PG8_MMA(0, 0, At, B0); PG8_BAR; PG8_SCHED;
            PG8_LDB(B1, 1, 1); PG8_STAGE(PG8_SB(1, 0), b3, voffB);
            PG8_BAR; PG8_WAIT_L(0); PG8_MMA(0, 1, At, B1); PG8_BAR;
            PG8_LDA(At, 1, 1); PG8_STAGE(PG8_SA(1, 0), a3, voffA);
            PG8_BAR; PG8_WAIT_L(0); PG8_MMA(1, 0, At, B0); PG8_BAR; PG8_SCHED;
            PG8_STAGE(PG8_SB(1, 1), b3 + hstep, voffB);
            PG8_WAIT_V(6); PG8_BAR; PG8_MMA(1, 1, At, B1); PG8_BAR;
            }
        }
        if constexpr (ALIGN_EPI) { if (wr == 0) PG8_BAR; }
        bool chain_first = false;
        if constexpr (Epi::MID) { chain_first = (cur.kofs == 0); }
        if constexpr (!Epi::AFTER_DRAIN) { if (chain_first) E.mid(acc, cur, wr, wc, fr, fq); else { E(acc, cur, wr, wc, fr, fq); S.done(cur); } }
        if (!has_next) break;
        if (!chain_first)
#pragma unroll
        for (int a = 0; a < 2; ++a)
#pragma unroll
            for (int b = 0; b < 2; ++b)
#pragma unroll
                for (int m = 0; m < 4; ++m)
#pragma unroll
                    for (int n = 0; n < 2; ++n) acc[a][b][m][n] = (f32x4){0.f, 0.f, 0.f, 0.f};
        cur = nxt; cA = nA; cB = nB; ++ui;
        if constexpr (ALIGN_EPI) { if (wr == 1) PG8_BAR; }
    }
    PG8_WAIT_V(0);
    if constexpr (!ALIGN_EPI) { if (wr == 0) PG8_BAR; }
    PG8_BAR;
    if constexpr (Epi::AFTER_DRAIN) { E.fused(acc, cur, wr, wc, fr, fq, lds, wid, lane); S.done(cur); }
#undef PG8_SA
#undef PG8_SB
#undef PG8_STAGE
#undef PG8_LDA
#undef PG8_LDB
#undef PG8_MMA
#undef PG8_WAIT_V
#undef PG8_WAIT_L
#undef PG8_BAR
#undef PG8_SCHED
}
}

namespace sba {
using bf16x8 = __attribute__((ext_vector_type(8))) short;
using s16x4  = __attribute__((ext_vector_type(4))) short;
using f32x16 = __attribute__((ext_vector_type(16))) float;
using u32x4  = __attribute__((ext_vector_type(4))) unsigned;
typedef _Float16 half8 __attribute__((ext_vector_type(8)));
typedef float f32x4 __attribute__((ext_vector_type(4)));
typedef _Float16 half2v __attribute__((ext_vector_type(2)));
typedef float float2v __attribute__((ext_vector_type(2)));
constexpr int KVBLK = 64;
constexpr int SHM_V = KVBLK * 128 * 2, SHM_K = KVBLK * 128 * 2;
constexpr int OFF_V = 0, OFF_K = 2 * SHM_V, OFF_FLAG = 2 * SHM_V + 2 * SHM_K;
#define KSWZ(row, colB) ((row) * 256 + ((colB) ^ (((row) & 7) << 4)))
#define SBAR() __builtin_amdgcn_sched_barrier(0)
__device__ __forceinline__ int crow(int r, int hi) { return (r & 3) + 8 * (r >> 2) + 4 * hi; }
__device__ __forceinline__ unsigned cvtpk(float lo, float hi) { unsigned r; asm volatile("v_cvt_pk_bf16_f32 %0, %1, %2" : "=v"(r) : "v"(lo), "v"(hi)); return r; }
__device__ __forceinline__ void qkt(f32x16& p0, f32x16& p1, const char* Ks, const bf16x8* qr, int r32, int hi) {
  p0 = f32x16{}; p1 = f32x16{};
#pragma unroll
  for (int d0 = 0; d0 < 8; ++d0) { const int cb = (d0 * 16 + hi * 8) * 2;
    const bf16x8 b0 = *reinterpret_cast<const bf16x8*>(Ks + KSWZ(r32, cb));
    const bf16x8 b1 = *reinterpret_cast<const bf16x8*>(Ks + KSWZ(32 + r32, cb));
    p0 = __builtin_amdgcn_mfma_f32_32x32x16_bf16(b0, qr[d0], p0, 0, 0, 0);
    p1 = __builtin_amdgcn_mfma_f32_32x32x16_bf16(b1, qr[d0], p1, 0, 0, 0); }
}
__device__ __forceinline__ int v_st(int k, int c) { const int kk = (k & ~0xC) | ((k & 4) << 1) | ((k & 8) >> 1); return ((kk >> 3) * 4 + (c >> 5)) * 512 + ((kk & 7) * 32 + (c & 31)) * 2; }
__device__ __forceinline__ int v_rd_base(int lane) { return ((lane & 3) << 3) | (((lane >> 2) & 3) << 6) | (((lane >> 4) & 1) << 5) | (((lane >> 5) & 1) << 8); }
constexpr int v_rd_off(int d0, int ks, int half) { return d0 * 512 + ks * 4096 + half * 2048; }
template <int OFF> __device__ __forceinline__ s16x4 tr_read(int vb) {
  s16x4 r; asm volatile("ds_read_b64_tr_b16 %0, %1 offset:%2" : "=&v"(r) : "v"(vb), "i"(OFF) : "memory"); return r;
}
template <int D0> __device__ __forceinline__ void pv_one(f32x16& od, int vb, bf16x8 pa0, bf16x8 pa1, bf16x8 pa2, bf16x8 pa3) {
  const s16x4 l0 = tr_read<v_rd_off(D0, 0, 0)>(vb), h0 = tr_read<v_rd_off(D0, 0, 1)>(vb), l1 = tr_read<v_rd_off(D0, 1, 0)>(vb), h1 = tr_read<v_rd_off(D0, 1, 1)>(vb);
  const s16x4 l2 = tr_read<v_rd_off(D0, 2, 0)>(vb), h2 = tr_read<v_rd_off(D0, 2, 1)>(vb), l3 = tr_read<v_rd_off(D0, 3, 0)>(vb), h3 = tr_read<v_rd_off(D0, 3, 1)>(vb);
  asm volatile("s_waitcnt lgkmcnt(0)" ::: "memory"); SBAR();
#define PK(L, H) (bf16x8){L[0], L[1], L[2], L[3], H[0], H[1], H[2], H[3]}
  od = __builtin_amdgcn_mfma_f32_32x32x16_bf16(pa0, PK(l0, h0), od, 0, 0, 0);
  od = __builtin_amdgcn_mfma_f32_32x32x16_bf16(pa1, PK(l1, h1), od, 0, 0, 0);
  od = __builtin_amdgcn_mfma_f32_32x32x16_bf16(pa2, PK(l2, h2), od, 0, 0, 0);
  od = __builtin_amdgcn_mfma_f32_32x32x16_bf16(pa3, PK(l3, h3), od, 0, 0, 0);
#undef PK
}
__device__ __forceinline__ void pv_d0(f32x16* o, int vb, bf16x8 pa0, bf16x8 pa1, bf16x8 pa2, bf16x8 pa3) {
  pv_one<0>(o[0], vb, pa0, pa1, pa2, pa3); pv_one<1>(o[1], vb, pa0, pa1, pa2, pa3); pv_one<2>(o[2], vb, pa0, pa1, pa2, pa3); pv_one<3>(o[3], vb, pa0, pa1, pa2, pa3);
}
__device__ __forceinline__ half8 pack_h8(const f32x16& l, int base) {
  half8 r;
#pragma unroll
  for (int j = 0; j < 8; j += 2) { const float2v f = {l[base + j], l[base + j + 1]}; const half2v hh = __builtin_convertvector(f, half2v); r[j] = hh[0]; r[j + 1] = hh[1]; }
  return r;
}
template <bool BAND>
__device__ __forceinline__ void sb_half(f32x16& p, float& R, const half8 U0, const half8 U1, int kbase, int row_rel, int hi) {
  f32x16 l;
#pragma unroll
  for (int r = 0; r < 16; ++r) {
    const float z = fminf(p[r], 80.0f); p[r] = z;
    float lv = -__builtin_amdgcn_logf(1.0f + __builtin_amdgcn_exp2f(z));
    if (BAND) lv = (kbase + crow(r, hi) < row_rel) ? lv : 0.0f;
    l[r] = lv;
  }
  const half8 lf0 = pack_h8(l, 0), lf1 = pack_h8(l, 8);
  f32x16 E = __builtin_amdgcn_mfma_f32_32x32x16_f16(U0, lf0, f32x16{}, 0, 0, 0);
  E = __builtin_amdgcn_mfma_f32_32x32x16_f16(U1, lf1, E, 0, 0, 0);
#pragma unroll
  for (int r = 0; r < 16; ++r) {
    float w = __builtin_amdgcn_exp2f((p[r] + R) + (l[r] + E[r]));
    if (BAND) w = (kbase + crow(r, hi) < row_rel) ? w : 0.0f;
    p[r] = w;
  }
  const float tot = E[0] + l[0];
  const auto rr = __builtin_amdgcn_permlane32_swap(__float_as_uint(tot), __float_as_uint(tot), false, false);
  R += __uint_as_float(rr[0]);
}
#define PK4(P, BASE, OUT) do { unsigned a0 = cvtpk(P[BASE + 0], P[BASE + 1]), a1 = cvtpk(P[BASE + 2], P[BASE + 3]);   \
    unsigned b0 = cvtpk(P[BASE + 4], P[BASE + 5]), b1 = cvtpk(P[BASE + 6], P[BASE + 7]);                              \
    auto r0 = __builtin_amdgcn_permlane32_swap(a0, b0, false, false); auto r1 = __builtin_amdgcn_permlane32_swap(a1, b1, false, false); \
    u32x4 w = {r0[0], r1[0], r0[1], r1[1]}; OUT = *reinterpret_cast<bf16x8*>(&w); } while (0)

__device__ __forceinline__ void sb_unit(int b, int h, int qb, unsigned char* act, char* lds) {
  int tid = threadIdx.x; asm volatile("" : "+v"(tid));
  const int wid = __builtin_amdgcn_readfirstlane(tid >> 6), lane = tid & 63, r32 = lane & 31, hi = lane >> 5;
  const bf16* GS = (const bf16*)(act + A_GS); const bf16* SK = (const bf16*)(act + A_SK); const bf16* SV = (const bf16*)(act + A_SV);
  char* V_lds = lds + OFF_V; char* K_lds = lds + OFF_K; volatile __attribute__((address_space(3))) unsigned* flags = (volatile __attribute__((address_space(3))) unsigned*)(lds + OFF_FLAG);
  const int q0 = qb * 256;
  half8 U0, U1;
#pragma unroll
  for (int j = 0; j < 8; ++j) { const int kp = 8 * (j >> 2) + 4 * hi + (j & 3); U0[j] = (kp > r32) ? (_Float16)1.0f : (_Float16)0.0f; U1[j] = (16 + kp > r32) ? (_Float16)1.0f : (_Float16)0.0f; }
  bf16x8 qr[8];
  { const bf16* Qw = GS + (size_t)(b * SEQ + q0 + wid * 32 + r32) * 2048 + 1024 + h * 128 + hi * 8;
#pragma unroll
    for (int d0 = 0; d0 < 8; ++d0) qr[d0] = *reinterpret_cast<const bf16x8*>(Qw + d0 * 16); }
  const bf16* Kh = SK + (size_t)(b * SEQ) * 1024 + h * 128; const bf16* Vh = SV + (size_t)(b * SEQ) * 1024 + h * 128;
  const int sr = tid >> 4, sc = (tid & 15) * 8, vst0 = v_st(sr, sc), vst1 = v_st(32 + sr, sc);
  const int vb0 = (int)(uintptr_t)V_lds + v_rd_base(lane);
  bf16x8 vs0, vs1, ks0, ks1;
#define SLOAD(k0) do { vs0 = *reinterpret_cast<const bf16x8*>(&Vh[(size_t)((k0) + sr) * 1024 + sc]); vs1 = *reinterpret_cast<const bf16x8*>(&Vh[(size_t)((k0) + 32 + sr) * 1024 + sc]); \
    ks0 = *reinterpret_cast<const bf16x8*>(&Kh[(size_t)((k0) + sr) * 1024 + sc]); ks1 = *reinterpret_cast<const bf16x8*>(&Kh[(size_t)((k0) + 32 + sr) * 1024 + sc]); } while (0)
#define SWRITE(bb) do { *(bf16x8*)(V_lds + (bb) * SHM_V + vst0) = vs0; *(bf16x8*)(V_lds + (bb) * SHM_V + vst1) = vs1; const int kc = sc * 2; \
    *(bf16x8*)(K_lds + (bb) * SHM_K + KSWZ(sr, kc)) = ks0; *(bf16x8*)(K_lds + (bb) * SHM_K + KSWZ(32 + sr, kc)) = ks1; } while (0)
  f32x16 o[4] = {}; float R = 0.f;
  const int NT = 4 * qb + 4, row_rel = 32 * wid + r32;
  SLOAD((NT - 1) * KVBLK); SWRITE(0); SLOAD((NT - 2) * KVBLK);
  __syncthreads();
  int cur = 0;
  for (int jt = NT - 1; jt >= 0; --jt) {
    const int kb = 64 * (jt - 4 * qb);
    const bool band = kb >= 0;
    if (!(band && kb >= 32 * wid + 32)) {
      f32x16 p0, p1; bf16x8 pa0, pa1, pa2, pa3;
      SBAR(); qkt(p0, p1, K_lds + cur * SHM_K, qr, r32, hi);
      if (band) { sb_half<true>(p1, R, U0, U1, kb + 32, row_rel, hi); sb_half<true>(p0, R, U0, U1, kb, row_rel, hi); }
      else { sb_half<false>(p1, R, U0, U1, 0, 0, hi); sb_half<false>(p0, R, U0, U1, 0, 0, hi); }
      PK4(p0, 0, pa0); PK4(p0, 8, pa1); PK4(p1, 0, pa2); PK4(p1, 8, pa3);
      SBAR(); pv_d0(o, vb0 + cur * SHM_V, pa0, pa1, pa2, pa3);
    }
    if (jt >= 1) { SWRITE(cur ^ 1); if (jt >= 2) SLOAD((jt - 2) * KVBLK); }
    { const bool wdone = __all(R < -160.0f); if (lane == 0) flags[cur * 8 + wid] = wdone ? 1u : 0u; }
    __syncthreads();
    unsigned alld = 1u;
#pragma unroll
    for (int i = 0; i < 8; ++i) alld &= flags[cur * 8 + i];
    if (alld) break;
    cur ^= 1;
  }
  __syncthreads();
  { bf16* stg = (bf16*)(lds + wid * 8192);
#pragma unroll
    for (int r = 0; r < 16; ++r) { const int orow = crow(r, hi);
#pragma unroll
      for (int d0 = 0; d0 < 4; ++d0) stg[orow * 128 + d0 * 32 + r32] = (bf16)f2bf(o[d0][r]); }
    asm volatile("s_waitcnt lgkmcnt(0)" ::: "memory");
    bf16* Ow = (bf16*)GS + (size_t)(b * SEQ + q0 + wid * 32) * 2048 + 1024 + h * 128;
#pragma unroll
    for (int i = 0; i < 8; ++i) { const int row = i * 4 + (lane >> 4), ch = lane & 15; const u32x4 v = *(const u32x4*)(stg + row * 128 + ch * 8); *(u32x4*)(Ow + (size_t)row * 2048 + ch * 8) = v; } }
  __syncthreads();
#undef SLOAD
#undef SWRITE
}
constexpr int R_SHM_V = 2 * SHM_V, R_OFF_V = 0, R_OFF_K = 2 * R_SHM_V, R_OFF_STAT = 131072;
__device__ __forceinline__ void ret_unit(int b, int h, int qb, unsigned char* act, char* lds) {
  int tid = threadIdx.x; asm volatile("" : "+v"(tid));
  const int wid = __builtin_amdgcn_readfirstlane(tid >> 6), lane = tid & 63, r32 = lane & 31, hi = lane >> 5, rg = wid & 3, dh = wid >> 2;
  const bf16* RQK = (const bf16*)(act + A_RQK); const bf16* RV = (const bf16*)(act + A_RV); bf16* GS = (bf16*)(act + A_GS);
  char* V_lds = lds + R_OFF_V; char* K_lds = lds + R_OFF_K;
  const int q0 = qb * 128;
  bf16x8 qr[8];
  { const bf16* Qw = RQK + (size_t)(b * SEQ + q0 + rg * 32 + r32) * 1024 + h * 128 + hi * 8;
#pragma unroll
    for (int d0 = 0; d0 < 8; ++d0) qr[d0] = *reinterpret_cast<const bf16x8*>(Qw + d0 * 16); }
  const bf16* Kh = RQK + (size_t)(b * SEQ) * 1024 + 512 + h * 128; const bf16* Vh = RV + (size_t)(b * SEQ) * 1024 + h * 256;
  const int sr = tid >> 4, sc = (tid & 15) * 8, vst0 = v_st(sr, sc), vst1 = v_st(32 + sr, sc);
  const int vb0 = (int)(uintptr_t)V_lds + dh * SHM_V + v_rd_base(lane);
  bf16x8 va0, va1, vb0r, vb1r, ks0, ks1;
#define SLOAD(k0) do { const bf16* vp0 = &Vh[(size_t)((k0) + sr) * 1024 + sc]; const bf16* vp1 = &Vh[(size_t)((k0) + 32 + sr) * 1024 + sc]; \
    va0 = *reinterpret_cast<const bf16x8*>(vp0); va1 = *reinterpret_cast<const bf16x8*>(vp1); vb0r = *reinterpret_cast<const bf16x8*>(vp0 + 128); vb1r = *reinterpret_cast<const bf16x8*>(vp1 + 128); \
    ks0 = *reinterpret_cast<const bf16x8*>(&Kh[(size_t)((k0) + sr) * 1024 + sc]); ks1 = *reinterpret_cast<const bf16x8*>(&Kh[(size_t)((k0) + 32 + sr) * 1024 + sc]); } while (0)
#define SWRITE(bb) do { char* vq = V_lds + (bb) * R_SHM_V; *(bf16x8*)(vq + vst0) = va0; *(bf16x8*)(vq + vst1) = va1; *(bf16x8*)(vq + SHM_V + vst0) = vb0r; *(bf16x8*)(vq + SHM_V + vst1) = vb1r; \
    const int kc = sc * 2; *(bf16x8*)(K_lds + (bb) * SHM_K + KSWZ(sr, kc)) = ks0; *(bf16x8*)(K_lds + (bb) * SHM_K + KSWZ(32 + sr, kc)) = ks1; } while (0)
  f32x16 o[4] = {};
  const int NT = 2 * qb + 2, row_rel = 32 * rg + r32;
  SLOAD((NT - 1) * KVBLK); SWRITE(0); SLOAD((NT - 2) * KVBLK);
  __syncthreads();
  int cur = 0;
  for (int jt = NT - 1; jt >= 0; --jt) {
    const int kb = 64 * (jt - 2 * qb);
    const bool band = kb >= 0;
    if (true) {
      f32x16 p0, p1; bf16x8 pa0, pa1, pa2, pa3;
      SBAR(); qkt(p0, p1, K_lds + cur * SHM_K, qr, r32, hi);
      if (band) {
#pragma unroll
        for (int r = 0; r < 16; ++r) { const int kr = kb + crow(r, hi); p0[r] = (kr <= row_rel) ? p0[r] : 0.0f; p1[r] = (kr + 32 <= row_rel) ? p1[r] : 0.0f; }
      }
      PK4(p0, 0, pa0); PK4(p0, 8, pa1); PK4(p1, 0, pa2); PK4(p1, 8, pa3);
      SBAR(); pv_d0(o, vb0 + cur * R_SHM_V, pa0, pa1, pa2, pa3);
    }
    if (jt >= 1) { SWRITE(cur ^ 1); if (jt >= 2) SLOAD((jt - 2) * KVBLK); }
    __syncthreads();
    cur ^= 1;
  }
  { float* stg = (float*)(lds + wid * 16384);
#pragma unroll
    for (int r = 0; r < 16; ++r) { const int orow = crow(r, hi);
#pragma unroll
      for (int d0 = 0; d0 < 4; ++d0) stg[orow * 128 + d0 * 32 + r32] = o[d0][r]; }
    __syncthreads();
    const int row = lane >> 1, hc = lane & 1;
    f32x4 x[16]; float sm = 0.f, sq = 0.f;
#pragma unroll
    for (int i = 0; i < 16; ++i) { x[i] = *(const f32x4*)(stg + row * 128 + hc * 64 + i * 4); sm += (x[i][0] + x[i][1]) + (x[i][2] + x[i][3]); sq += (x[i][0] * x[i][0] + x[i][1] * x[i][1]) + (x[i][2] * x[i][2] + x[i][3] * x[i][3]); }
    sm += __shfl_xor(sm, 1); sq += __shfl_xor(sq, 1);
    float2v* stat = (float2v*)(lds + R_OFF_STAT);
    if (hc == 0) stat[wid * 32 + row] = (float2v){sm, sq};
    __syncthreads();
    const float2v ps = stat[(wid ^ 4) * 32 + row];
    const float mean = (sm + ps[0]) * (1.0f / 256.0f), var = fmaxf((sq + ps[1]) * (1.0f / 256.0f) - mean * mean, 0.0f), rstd = rsqrtf(var + GN_EPS);
    bf16* gp = GS + (size_t)(b * SEQ + q0 + rg * 32 + row) * 2048 + h * 256 + dh * 128 + hc * 64;
#pragma unroll
    for (int i = 0; i < 8; ++i) {
      const u32x4 gw = *(const u32x4*)(gp + i * 8);
      const f32x4 a = x[2 * i], c = x[2 * i + 1];
      u32x4 ow;
      ow[0] = cvtpk((a[0] - mean) * rstd * __builtin_bit_cast(float, gw[0] << 16), (a[1] - mean) * rstd * __builtin_bit_cast(float, gw[0] & 0xffff0000u));
      ow[1] = cvtpk((a[2] - mean) * rstd * __builtin_bit_cast(float, gw[1] << 16), (a[3] - mean) * rstd * __builtin_bit_cast(float, gw[1] & 0xffff0000u));
      ow[2] = cvtpk((c[0] - mean) * rstd * __builtin_bit_cast(float, gw[2] << 16), (c[1] - mean) * rstd * __builtin_bit_cast(float, gw[2] & 0xffff0000u));
      ow[3] = cvtpk((c[2] - mean) * rstd * __builtin_bit_cast(float, gw[3] << 16), (c[3] - mean) * rstd * __builtin_bit_cast(float, gw[3] & 0xffff0000u));
      *(u32x4*)(gp + i * 8) = ow;
    }
  }
  __syncthreads();
#undef SLOAD
#undef SWRITE
}
__device__ __forceinline__ void ret_phase(unsigned char* act, char* lds) {
  const int NU = BG * 4 * 16;
  for (int i = 0; i < 2; ++i) {
    for (int c = blockIdx.x; c < NU / 2; c += gridDim.x) {
      const int u = i == 0 ? c : NU - 1 - c, qb = 15 - u / (NU / 16), bh = u % (NU / 16);
      ret_unit(bh >> 2, bh & 3, qb, act, lds);
    }
  }
}
__device__ __forceinline__ void sb_phase(unsigned char* act, char* lds) {
  const int NU = BG * 8 * 8;
  for (int i = 0; i < 2; ++i) {
    for (int c = blockIdx.x; c < NU / 2; c += gridDim.x) {
      const int u = i == 0 ? c : NU - 1 - c, qb = 7 - u / (NU / 8), bh = u % (NU / 8);
      sb_unit(bh >> 3, bh & 7, qb, act, lds);
    }
  }
}
#undef PK4
#undef KSWZ
#undef SBAR
}

#define LAS __attribute__((address_space(3)))
typedef unsigned v4u __attribute__((ext_vector_type(4)));
#define LDS_WAIT() asm volatile("s_waitcnt lgkmcnt(0)" ::: "memory")
constexpr int NWAVES = 8;
constexpr int LDS_BYTES = 147456;

__device__ __forceinline__ int rho32(int l) { return 16 * ((l >> 2) & 1) + 4 * (l >> 3) + (l & 3); }
__device__ __forceinline__ int pos_win(int c) {
    if (c < 1024) { const int hh = c >> 7, j = c & 127, n = j >> 6, jj = j & 63; return 256 * (hh >> 1) + 128 * (hh & 1) + 32 * (jj >> 4) + 16 * n + (jj & 15); }
    if (c < 6144) return (c & ~31) + rho32(c & 31);
    const int isb = (c >= 7168) ? 1 : 0, ch = (c - 6144) & 1023, j = ch >> 7, w = ch & 127;
    return 256 * (24 + j) + 128 * isb + (w & ~31) + rho32(w & 31);
}
enum { KIND_NAT = 0, KIND_P32 = 1, KIND_WIN = 2 };
__device__ __forceinline__ void tr_item(const float* __restrict__ W, int N, bf16* __restrict__ WT, int ldt, int koff, int kind, const float* __restrict__ gain, LAS float* scr, int item, int lane) {
    const int nblk = N / 32, kb = item / nblk, nb = item % nblk, k0 = 64 * kb, n0 = 32 * nb;
#pragma unroll 8
    for (int i = 0; i < 32; ++i) { const int kk = 2 * i + (lane >> 5); scr[kk * 33 + (lane & 31)] = W[(size_t)(k0 + kk) * N + n0 + (lane & 31)]; }
    LDS_WAIT(); asm volatile("" ::: "memory");
    const int c = lane & 7;
    float gn[8];
#pragma unroll
    for (int i = 0; i < 8; ++i) gn[i] = gain ? gain[k0 + 8 * c + i] : 1.0f;
#pragma unroll
    for (int j = 0; j < 4; ++j) {
        const int n = (lane >> 3) + 8 * j, cl = n0 + n; int pos = cl; float sc = 1.0f;
        if (kind == KIND_P32) pos = (cl & ~31) + rho32(cl & 31);
        else if (kind == KIND_WIN) { pos = pos_win(cl); if (cl >= 512 && cl < 1024) sc = KR_SCALE; else if (cl >= 3072 && cl < 4096) sc = QS_SCALE; }
        const LAS float* s = scr + (8 * c) * 33 + n;
        v4u o; o.x = pk2(s[0 * 33] * gn[0] * sc, s[1 * 33] * gn[1] * sc); o.y = pk2(s[2 * 33] * gn[2] * sc, s[3 * 33] * gn[3] * sc);
        o.z = pk2(s[4 * 33] * gn[4] * sc, s[5 * 33] * gn[5] * sc); o.w = pk2(s[6 * 33] * gn[6] * sc, s[7 * 33] * gn[7] * sc);
        *(v4u*)(WT + (size_t)pos * ldt + koff + k0 + 8 * c) = o;
    }
    LDS_WAIT(); asm volatile("" ::: "memory");
}

struct Args { const float* in[10]; float* out; unsigned char* ws; int ph_lo, ph_hi; };
constexpr int PH_PRO = 0, PH_FINAL = 1 + 6 * DEPTH * NGRP;

__device__ __forceinline__ void prologue_phase(const Args& a, unsigned char* lds) {
    int tid_ = threadIdx.x; asm volatile("" : "+v"(tid_));
    const int lane = tid_ & 63, wave = __builtin_amdgcn_readfirstlane(tid_ >> 6);
    const float* x = a.in[0]; float* out = a.out; bf16* xb = (bf16*)(a.ws + WS_XB); float* ssq = (float*)(a.ws + WS_SSQ); float* rope = (float*)(a.ws + WS_ROPE);
    const int gw = blockIdx.x * NWAVES + wave, NGW = gridDim.x * NWAVES;
    LAS float* scr = (LAS float*)((LAS unsigned char*)lds + wave * 16384);
    constexpr int I_IN = 16 * 256, I_SQ = 16 * 32, I_UP = 16 * 128, I_DN = 64 * 32, I_LAYER = I_IN + 3 * I_SQ + I_UP + I_DN;
    for (int it = gw; it < DEPTH * I_LAYER; it += NGW) {
        const int l = it / I_LAYER; int r = it % I_LAYER;
        unsigned char* wl = a.ws + WS_W + (size_t)l * WL_STRIDE;
        if (r < I_IN) { tr_item(a.in[1] + (size_t)l * D * DIN, DIN, (bf16*)(wl + WL_WIN), D, 0, KIND_WIN, a.in[7] + l * D, scr, r, lane); continue; } r -= I_IN;
        if (r < I_SQ) { tr_item(a.in[2] + (size_t)l * D * D, D, (bf16*)(wl + WL_PCAT), 2 * D, 0, KIND_P32, nullptr, scr, r, lane); continue; } r -= I_SQ;
        if (r < I_SQ) { tr_item(a.in[3] + (size_t)l * D * D, D, (bf16*)(wl + WL_PCAT), 2 * D, D, KIND_P32, nullptr, scr, r, lane); continue; } r -= I_SQ;
        if (r < I_SQ) { tr_item(a.in[4] + (size_t)l * D * D, D, (bf16*)(wl + WL_WOUT), D, 0, KIND_NAT, nullptr, scr, r, lane); continue; } r -= I_SQ;
        if (r < I_UP) { tr_item(a.in[5] + (size_t)l * D * DFF, DFF, (bf16*)(wl + WL_WUP), D, 0, KIND_P32, a.in[8] + l * D, scr, r, lane); continue; } r -= I_UP;
        tr_item(a.in[6] + (size_t)l * DFF * D, D, (bf16*)(wl + WL_WDN), DFF, 0, KIND_NAT, nullptr, scr, r, lane);
    }
    for (int r = gw; r < M; r += NGW) {
        float s = 0.f;
#pragma unroll
        for (int j = 0; j < 4; ++j) {
            const int c = j * 256 + lane * 4;
            const float4 v = *(const float4*)(x + (size_t)r * D + c);
            *(float4*)(out + (size_t)r * D + c) = v;
            s += v.x * v.x + v.y * v.y + v.z * v.z + v.w * v.w;
            uint2 w; w.x = pk2(v.x, v.y); w.y = pk2(v.z, v.w);
            *(uint2*)(xb + (size_t)r * D + c) = w;
        }
#pragma unroll
        for (int o = 1; o < 64; o <<= 1) s += __shfl_xor(s, o);
        if (lane < 16) ssq[(size_t)r * 16 + lane] = (lane == 0) ? s : 0.f;
    }
    for (int i = blockIdx.x * 512 + tid_; i < SEQ * 64; i += gridDim.x * 512) {
        const int pos = i >> 6, j = i & 63;
        const float inv = powf(10000.0f, -(float)j / 64.0f);
        const float ang = (float)pos * inv;
        rope[i] = cosf(ang); rope[SEQ * 64 + i] = sinf(ang);
    }
}
__device__ __forceinline__ void final_phase(const Args& a) {
    int tid_ = threadIdx.x; asm volatile("" : "+v"(tid_));
    const int lane = tid_ & 63, wave = __builtin_amdgcn_readfirstlane(tid_ >> 6);
    float* out = a.out; const float* g = a.in[9];
    const int gw = blockIdx.x * NWAVES + wave, NGW = gridDim.x * NWAVES;
    for (int r = gw; r < M; r += NGW) {
        float4 v[4]; float s = 0.f;
#pragma unroll
        for (int j = 0; j < 4; ++j) { v[j] = *(const float4*)(out + (size_t)r * D + j * 256 + lane * 4); s += v[j].x * v[j].x + v[j].y * v[j].y + v[j].z * v[j].z + v[j].w * v[j].w; }
#pragma unroll
        for (int o = 1; o < 64; o <<= 1) s += __shfl_xor(s, o);
        const float rs = rsqrtf(s * (1.0f / D) + NORM_EPS);
#pragma unroll
        for (int j = 0; j < 4; ++j) { const float4 gg = *(const float4*)(g + j * 256 + lane * 4);
            float4 o; o.x = v[j].x * rs * gg.x; o.y = v[j].y * rs * gg.y; o.z = v[j].z * rs * gg.z; o.w = v[j].w * rs * gg.w;
            *(float4*)(out + (size_t)r * D + j * 256 + lane * 4) = o; }
    }
}

#ifndef RET_NAIVE
#define RET_NAIVE 0
#endif
#ifndef PHMASK
#define PHMASK 31
#endif
#ifndef MK_ONE_LAUNCH
#define MK_ONE_LAUNCH 1
#endif
__global__ void __launch_bounds__(NWAVES * 64, 2) mega(Args a) {
    extern __shared__ __attribute__((aligned(16))) unsigned char lds[];
    const int G = gridDim.x;
    PG8_LAS unsigned char* ring = (PG8_LAS unsigned char*)lds;
#if MK_ONE_LAUNCH
#define GRID_SYNC() cg::this_grid().sync()
#else
#define GRID_SYNC() do {} while (0)
#endif
    int ph = a.ph_lo; const int ph_hi = a.ph_hi;
    if (ph == PH_PRO) { prologue_phase(a, lds); ++ph; if (ph < ph_hi) GRID_SYNC(); }
    const int ph_end = ph_hi < PH_FINAL ? ph_hi : PH_FINAL;
    for (; ph < ph_end; ++ph) {
        size_t zofs = 0; asm volatile("" : "+s"(zofs));
        unsigned char* ws = a.ws + zofs; float* outp = (float*)((unsigned char*)a.out + zofs);
        unsigned char* act = ws + WS_ACT; float* ssq = (float*)(ws + WS_SSQ); const float* rope = (const float*)(ws + WS_ROPE); bf16* xb = (bf16*)(ws + WS_XB);
        {
            const int q = ph - 1, k = q % 6, lg = q / 6, l = lg / NGRP, g = lg % NGRP, grow0 = g * MG;
            const unsigned char* wl = ws + WS_W + (size_t)l * WL_STRIDE;
            if (k == 0 && (PHMASK & 1)) {
                pg8::Gemm gm{xb + (size_t)grow0 * D, (const bf16*)(wl + WL_WIN), MG, DIN, D, D}; pg8::StaticOrder S; S.init(MG, DIN, G, (int)blockIdx.x);
                pg8::EpiP1 E{act, ssq, rope, grow0};
                pg8::gemm_phase<pg8::EpiP1, pg8::StaticOrder, true, true>(ring, gm, S, E);
            } else if (k == 1) {
                #if RET_NAIVE
                naive_ret_phase(act, lds); __syncthreads();
#else
                sba::ret_phase(act, (char*)lds);
#endif
                sba::sb_phase(act, (char*)lds);
            } else if (k == 2 && (PHMASK & 2)) {
                pg8::Gemm gm{(const bf16*)(act + A_GS), (const bf16*)(wl + WL_PCAT), MG, D, 2 * D, D}; pg8::ChainOrder S; S.init(MG, D, G, (int)blockIdx.x); S.kh = D;
                pg8::EpiP3 E{act};
                pg8::gemm_phase<pg8::EpiP3, pg8::ChainOrder, true, true>(ring, gm, S, E);
            } else if (k == 3 && (PHMASK & 4)) {
                pg8::Gemm gm{(const bf16*)(act + A_MERGED), (const bf16*)(wl + WL_WOUT), MG, D, D, D}; pg8::StaticOrder S; S.init(MG, D, G, (int)blockIdx.x);
                pg8::EpiX E{outp, xb, ssq, grow0};
                pg8::gemm_phase<pg8::EpiX, pg8::StaticOrder, true, true>(ring, gm, S, E);
            } else if (k == 4 && (PHMASK & 8)) {
                pg8::Gemm gm{xb + (size_t)grow0 * D, (const bf16*)(wl + WL_WUP), MG, DFF, D, D}; pg8::StaticOrder S; S.init(MG, DFF, G, (int)blockIdx.x);
                pg8::EpiP5 E{act, ssq, grow0};
                pg8::gemm_phase<pg8::EpiP5, pg8::StaticOrder, true, true>(ring, gm, S, E);
            } else if (k == 5 && (PHMASK & 16)) {
                pg8::Gemm gm{(const bf16*)(act + A_UP), (const bf16*)(wl + WL_WDN), MG, D, DFF, DFF}; pg8::StaticOrder S; S.init(MG, D, G, (int)blockIdx.x);
                pg8::EpiX E{outp, xb, ssq, grow0};
                pg8::gemm_phase<pg8::EpiX, pg8::StaticOrder, true, true>(ring, gm, S, E);
            }
        }
        if (ph + 1 < ph_hi) GRID_SYNC();
    }
    if (ph_hi > PH_FINAL) final_phase(a);
}

extern "C" void kernel_launch(void* const* d_in, const int* in_sizes, int n_in, void* d_out, int out_size, void* d_ws, size_t ws_size, hipStream_t stream) {
    static int grid = 0;
    if (grid == 0) {
        if (n_in != 10 || in_sizes[0] != M * D || out_size != M * D || ws_size < WS_END) { fprintf(stderr, "kernel_launch: unexpected shapes (n_in %d, ws %zu)\n", n_in, ws_size); grid = -1; return; }
        int dev = 0, cus = 0;
        if (hipGetDevice(&dev) != hipSuccess || hipDeviceGetAttribute(&cus, hipDeviceAttributeMultiprocessorCount, dev) != hipSuccess) { grid = -1; return; }
        if (hipFuncSetAttribute((const void*)mega, hipFuncAttributeMaxDynamicSharedMemorySize, LDS_BYTES) != hipSuccess) { fprintf(stderr, "kernel_launch: hipFuncSetAttribute failed\n"); grid = -1; return; }
        int per_cu = 0;
        if (hipOccupancyMaxActiveBlocksPerMultiprocessor(&per_cu, (const void*)mega, NWAVES * 64, LDS_BYTES) != hipSuccess || per_cu < 1) { fprintf(stderr, "kernel_launch: occupancy query says %d blocks per CU\n", per_cu); (void)hipGetLastError(); per_cu = 1; }
        grid = cus;
    }
    if (grid < 0) return;
    Args a{};
    for (int i = 0; i < 10; ++i) a.in[i] = (const float*)d_in[i];
    a.out = (float*)d_out; a.ws = (unsigned char*)d_ws;
#if MK_ONE_LAUNCH
    a.ph_lo = 0; a.ph_hi = PH_FINAL + 1;
    void* kargs[] = {&a};
    const hipError_t le = hipLaunchCooperativeKernel((const void*)mega, dim3(grid), dim3(NWAVES * 64), kargs, LDS_BYTES, stream);
    if (le != hipSuccess) fprintf(stderr, "kernel_launch: cooperative launch failed: %s (grid %d)\n", hipGetErrorString(le), grid);
#else
    auto run = [&](int lo, int hi) { a.ph_lo = lo; a.ph_hi = hi; hipLaunchKernelGGL(mega, dim3(grid), dim3(NWAVES * 64), LDS_BYTES, stream, a); };
    for (int p = 0; p <= PH_FINAL; ++p) run(p, p + 1);
#endif
}
```

```cpp
#include <hip/hip_runtime.h>
#include <hip/hip_cooperative_groups.h>
#include <cstdio>
#include <cstdint>
namespace cg = cooperative_groups;

constexpr int D = 1024, BATCH = 16, SEQ = 2048, DEPTH = 4, M = BATCH * SEQ;
constexpr int DIN = 8192, DFF = 4096;
constexpr int NGRP = 2, BG = BATCH / NGRP, MG = BG * SEQ;
constexpr float NORM_EPS = 1e-6f, GN_EPS = 1e-5f;
constexpr float LOG2E = 1.4426950408889634f, LN2 = 0.6931471805599453f;
constexpr float QS_SCALE = 0.08838834764831845f * LOG2E;
constexpr float KR_SCALE = 0.08838834764831845f;
constexpr float LG2_GAMMA0 = -0.045803689613124954f, LG2_GAMMA1 = -0.022720076500083545f, LG2_GAMMA2 = -0.011315313227834146f, LG2_GAMMA3 = -0.005646563141142062f;

typedef unsigned short bf16;
constexpr size_t MiB = 1u << 20;
constexpr size_t WS_CTL = 0;
constexpr size_t WS_ROPE = 1 * MiB;
constexpr size_t WS_SSQ = 2 * MiB;
constexpr size_t WS_XB = 4 * MiB;
constexpr size_t WS_W = 68 * MiB;
constexpr size_t WL_WIN = 0, WL_PCAT = 16 * MiB, WL_WOUT = 20 * MiB, WL_WUP = 22 * MiB, WL_WDN = 30 * MiB, WL_STRIDE = 38 * MiB;
constexpr size_t WS_ACT = 220 * MiB;
constexpr size_t WS_END = 476 * MiB;
constexpr size_t A_RQK = 0, A_RV = 32 * MiB, A_GS = 64 * MiB, A_SK = 128 * MiB, A_SV = 160 * MiB, A_GA = 192 * MiB, A_GB = 224 * MiB;
constexpr size_t A_MERGED = 0, A_UP = 0;

__device__ __forceinline__ unsigned f2bf(float f) { unsigned u = __builtin_bit_cast(unsigned, f); return (u + 0x7fffu + ((u >> 16) & 1u)) >> 16; }
__device__ __forceinline__ float bf2f(unsigned h) { return __builtin_bit_cast(float, h << 16); }
__device__ __forceinline__ unsigned pk2(float lo, float hi) { return f2bf(lo) | (f2bf(hi) << 16); }

__device__ __forceinline__ void naive_ret_phase(unsigned char* act, unsigned char* lds) {
    float (*Qs)[129] = (float (*)[129])lds; bf16 (*Ks)[130] = (bf16 (*)[130])(lds + 16512); bf16 (*Vs)[258] = (bf16 (*)[258])(lds + 16512 + 8320); float (*Ss)[33] = (float (*)[33])(lds + 16512 + 8320 + 16512);
    const bf16* RQK = (const bf16*)(act + A_RQK); const bf16* RV = (const bf16*)(act + A_RV); bf16* GS = (bf16*)(act + A_GS);
    int tid = threadIdx.x; asm volatile("" : "+v"(tid));
    for (int item = blockIdx.x; item < BG * 4 * 64; item += gridDim.x) {
        const int tt = 63 - (item % 64), h = (item / 64) % 4, b = item / 256, t0 = tt * 32;
        __syncthreads();
        for (int e = tid; e < 32 * 128; e += 512) { const int i = e >> 7, d = e & 127; Qs[i][d] = bf2f(RQK[(size_t)(b * SEQ + t0 + i) * 1024 + h * 128 + d]); }
        const int row = tid >> 4, ec = (tid & 15) * 16;
        float acc[16];
#pragma unroll
        for (int e = 0; e < 16; ++e) acc[e] = 0.f;
        for (int st = 0; st <= tt; ++st) {
            const int s0 = st * 32;
            __syncthreads();
            for (int e = tid; e < 32 * 128; e += 512) { const int i = e >> 7, d = e & 127; Ks[i][d] = RQK[(size_t)(b * SEQ + s0 + i) * 1024 + 512 + h * 128 + d]; }
            for (int e = tid; e < 32 * 256; e += 512) { const int i = e >> 8, d = e & 255; Vs[i][d] = RV[(size_t)(b * SEQ + s0 + i) * 1024 + h * 256 + d]; }
            __syncthreads();
            for (int jj = 0; jj < 2; ++jj) { const int i = tid >> 4, j = (tid & 15) * 2 + jj; float s = 0.f;
                for (int d = 0; d < 128; ++d) s += Qs[i][d] * bf2f(Ks[j][d]);
                const int t = t0 + i, sx = s0 + j; Ss[i][j] = (t >= sx) ? s : 0.f; }
            __syncthreads();
            for (int j = 0; j < 32; ++j) { const float s = Ss[row][j];
#pragma unroll
                for (int e = 0; e < 16; ++e) acc[e] += s * bf2f(Vs[j][ec + e]); }
        }
        float sum = 0.f;
#pragma unroll
        for (int e = 0; e < 16; ++e) sum += acc[e];
        for (int o = 1; o < 16; o <<= 1) sum += __shfl_xor(sum, o);
        const float mu = sum * (1.0f / 256.0f); float q = 0.f;
#pragma unroll
        for (int e = 0; e < 16; ++e) { const float dl = acc[e] - mu; q += dl * dl; }
        for (int o = 1; o < 16; o <<= 1) q += __shfl_xor(q, o);
        const float rs = rsqrtf(q * (1.0f / 256.0f) + GN_EPS);
        bf16* g = GS + (size_t)(b * SEQ + t0 + row) * 2048 + h * 256 + ec;
#pragma unroll
        for (int e = 0; e < 16; ++e) g[e] = (bf16)f2bf((acc[e] - mu) * rs * bf2f(g[e]));
    }
}
__device__ __forceinline__ void naive_sb_phase(unsigned char* act, unsigned char* lds) {
    float (*Qs)[129] = (float (*)[129])lds; bf16 (*Ks)[130] = (bf16 (*)[130])(lds + 16512); bf16 (*Vs)[130] = (bf16 (*)[130])(lds + 16512 + 8320); float (*Zs)[33] = (float (*)[33])(lds + 16512 + 8320 + 8320);
    bf16* GS = (bf16*)(act + A_GS); const bf16* SK = (const bf16*)(act + A_SK); const bf16* SV = (const bf16*)(act + A_SV);
    int tid = threadIdx.x; asm volatile("" : "+v"(tid));
    for (int item = blockIdx.x; item < BG * 8 * 64; item += gridDim.x) {
        const int tt = 63 - (item % 64), h = (item / 64) % 8, b = item / 512, t0 = tt * 32;
        __syncthreads();
        for (int e = tid; e < 32 * 128; e += 512) { const int i = e >> 7, d = e & 127; Qs[i][d] = bf2f(GS[(size_t)(b * SEQ + t0 + i) * 2048 + 1024 + h * 128 + d]); }
        const int row = tid >> 4, dc = (tid & 15) * 8;
        float acc[8];
#pragma unroll
        for (int e = 0; e < 8; ++e) acc[e] = 0.f;
        float R = 0.f;
        for (int st = tt; st >= 0; --st) {
            const int s0 = st * 32;
            __syncthreads();
            for (int e = tid; e < 32 * 128; e += 512) { const int i = e >> 7, d = e & 127;
                Ks[i][d] = SK[(size_t)(b * SEQ + s0 + i) * 1024 + h * 128 + d]; Vs[i][d] = SV[(size_t)(b * SEQ + s0 + i) * 1024 + h * 128 + d]; }
            __syncthreads();
            for (int jj = 0; jj < 2; ++jj) { const int i = tid >> 4, j = (tid & 15) * 2 + jj; float s = 0.f;
                for (int d = 0; d < 128; ++d) s += Qs[i][d] * bf2f(Ks[j][d]);
                Zs[i][j] = s; }
            __syncthreads();
            if (tid < 32) { const int t = t0 + tid;
                for (int j = 31; j >= 0; --j) { const int sx = s0 + j; float w = 0.f;
                    if (sx < t) { const float z = Zs[tid][j] * LN2; const float sp = fmaxf(z, 0.f) + log1pf(__expf(-fabsf(z))); w = __expf(z - sp + R); R -= sp; }
                    Zs[tid][j] = w; } }
            __syncthreads();
            for (int j = 0; j < 32; ++j) { const float w = Zs[row][j];
#pragma unroll
                for (int e = 0; e < 8; ++e) acc[e] += w * bf2f(Vs[j][dc + e]); }
        }
        bf16* o = GS + (size_t)(b * SEQ + t0 + row) * 2048 + 1024 + h * 128 + dc;
#pragma unroll
        for (int e = 0; e < 8; ++e) o[e] = (bf16)f2bf(acc[e]);
    }
}

namespace pg8 {
#define PG8_LAS __attribute__((address_space(3)))
typedef unsigned short bf16_t;
typedef short bf16x8 __attribute__((ext_vector_type(8)));
typedef float f32x4 __attribute__((ext_vector_type(4)));
typedef unsigned u32x4 __attribute__((ext_vector_type(4)));
constexpr int BM = 256, BK = 64, HALF = 128, HTB = HALF * BK * 2  , STAGE_BYTES = 8 * HTB, NXCD = 8, WGM = 8;

__host__ __device__ __forceinline__ int lds_byte(int r, int c) { const int st = (r >> 4) * 2 + (c >> 5), rr = r & 15, cc = c & 31, ob = rr * 64 + cc * 2; return st * 1024 + (ob ^ (((ob >> 9) & 1) << 5)); }
__host__ __device__ __forceinline__ void stage_rc(int b, int& R, int& C) { const int st = b / 1024, sb = b % 1024, swz = sb ^ (((sb >> 9) & 1) << 5); R = (st >> 1) * 16 + swz / 64; C = (st & 1) * 32 + (swz % 64) / 2; }
__host__ __device__ __forceinline__ int perm32(int rho) { const int n = rho >> 4, i = rho & 15; return 8 * (i >> 2) + 4 * n + (i & 3); }

struct Unit { int pm, pn, kofs; };
struct Gemm { const bf16_t* A; const bf16_t* Bt; int M, N, K, Kloop; };

struct StaticOrder {
    int nM, nN, nwg, G, c;
    __host__ __device__ void init(int M, int N, int G_, int c_) { nM = M / BM; nN = N / BM; nwg = nM * nN; G = G_; c = c_; }
    __host__ __device__ bool next(int i, Unit& u) const {
        const long L = (long)i * G + c; if (L >= nwg) return false;
        int wgid = (int)L; { const int q = nwg / NXCD, r = nwg % NXCD, xcd = wgid % NXCD, off = wgid / NXCD; wgid = (xcd < r ? xcd * (q + 1) : r * (q + 1) + (xcd - r) * q) + off; }
        const int nig = WGM * nN, gid = wgid / nig, fm = gid * WGM, gsz = (nM - fm) < WGM ? (nM - fm) : WGM;
        u.pm = fm + ((wgid % nig) % gsz); u.pn = (wgid % nig) / gsz; u.kofs = 0; return true;
    }
    __device__ __forceinline__ void a_ready(const Unit&) const {}
    __device__ __forceinline__ void done(const Unit&) const {}
};
struct ChainOrder : StaticOrder {
    int kh;
    __host__ __device__ bool next(int i, Unit& u) const { if (!StaticOrder::next(i >> 1, u)) return false; u.kofs = (i & 1) * kh; return true; }
};


typedef unsigned u32x2 __attribute__((ext_vector_type(2)));
__device__ __forceinline__ unsigned cvt_pk_bf16(float lo, float hi) { unsigned r; asm volatile("v_cvt_pk_bf16_f32 %0, %1, %2" : "=v"(r) : "v"(lo), "v"(hi)); return r; }
__device__ __forceinline__ u32x2 pack4(const f32x4 v) { u32x2 w; w.x = cvt_pk_bf16(v[0], v[1]); w.y = cvt_pk_bf16(v[2], v[3]); return w; }
__device__ __forceinline__ u32x4 pack8(const f32x4 a, const f32x4 b) { u32x4 w; w.x = cvt_pk_bf16(a[0], a[1]); w.y = cvt_pk_bf16(a[2], a[3]); w.z = cvt_pk_bf16(b[0], b[1]); w.w = cvt_pk_bf16(b[2], b[3]); return w; }
__device__ __forceinline__ f32x4 unpack_lo(const u32x4 w) { f32x4 r; r[0] = __builtin_bit_cast(float, w.x << 16); r[1] = __builtin_bit_cast(float, w.x & 0xffff0000u); r[2] = __builtin_bit_cast(float, w.y << 16); r[3] = __builtin_bit_cast(float, w.y & 0xffff0000u); return r; }
__device__ __forceinline__ f32x4 unpack_hi(const u32x4 w) { f32x4 r; r[0] = __builtin_bit_cast(float, w.z << 16); r[1] = __builtin_bit_cast(float, w.z & 0xffff0000u); r[2] = __builtin_bit_cast(float, w.w << 16); r[3] = __builtin_bit_cast(float, w.w & 0xffff0000u); return r; }
__device__ __forceinline__ float row_rstd(const char* ub, unsigned lo) {
    const f32x4* p = (const f32x4*)(ub + lo);
    const f32x4 a = p[0], b = p[1], c = p[2], d = p[3];
    const float s = (((a[0] + a[1]) + (a[2] + a[3])) + ((b[0] + b[1]) + (b[2] + b[3]))) + (((c[0] + c[1]) + (c[2] + c[3])) + ((d[0] + d[1]) + (d[2] + d[3])));
    return rsqrtf(s * (1.0f / 1024.0f) + NORM_EPS);
}
__device__ __forceinline__ f32x4 exp4(const f32x4 v) { f32x4 r; r[0] = __expf(v[0]); r[1] = __expf(v[1]); r[2] = __expf(v[2]); r[3] = __expf(v[3]); return r; }
__device__ __forceinline__ f32x4 rcp4(const f32x4 v) { f32x4 r; r[0] = __builtin_amdgcn_rcpf(v[0]); r[1] = __builtin_amdgcn_rcpf(v[1]); r[2] = __builtin_amdgcn_rcpf(v[2]); r[3] = __builtin_amdgcn_rcpf(v[3]); return r; }

struct EpiP1 {
    static constexpr bool PERM = false, AFTER_DRAIN = false, MID = false;
    unsigned char* act; const float* ssq; const float* rope; int grow0;
    __device__ __forceinline__ void mid(f32x4 (&)[2][2][4][2], const Unit&, int, int, int, int) const {}
    __device__ __forceinline__ void operator()(const f32x4 (&acc)[2][2][4][2], const Unit& u, int wr, int wc, int fr, int fq) const {
        const int pn = u.pn, rlu = u.pm * BM + wr * 64;
        const char* sq = (const char*)ssq + (size_t)(grow0 + rlu) * 64;
        unsigned lf = (unsigned)fr, lq = (unsigned)fq; asm volatile("" : "+v"(lf), "+v"(lq));
        float rs[2][4];
#pragma unroll
        for (int ai = 0; ai < 2; ++ai)
#pragma unroll
            for (int m = 0; m < 4; ++m) rs[ai][m] = row_rstd(sq + (ai * HALF + m * 16) * 64, lf * 64u);
        if (pn < 4) {
            const unsigned j0 = 16 * wc + 4 * lq;
            char* ub = (char*)(act + A_RQK) + ((size_t)rlu * 1024 + (pn >> 1) * 512 + (pn & 1) * 256) * 2;
            const unsigned lo = (lf * 1024u + j0) * 2u;
            const int pos0 = (grow0 + rlu) & (SEQ - 1);
            const char* rp = (const char*)rope + (size_t)pos0 * 256;
            const float sg = (pn < 2) ? 1.0f : -1.0f;
            const float lgA0 = sg * LG2_GAMMA0, lgA1 = sg * LG2_GAMMA1, lgB0 = sg * LG2_GAMMA2, lgB1 = sg * LG2_GAMMA3;
            const unsigned rlo = lf * 256u + j0 * 4u;
#pragma unroll
            for (int ai = 0; ai < 2; ++ai)
#pragma unroll
                for (int m = 0; m < 4; ++m) {
                    const f32x4 cs = *(const f32x4*)(rp + (ai * HALF + m * 16) * 256 + rlo), sn = *(const f32x4*)(rp + SEQ * 256 + (ai * HALF + m * 16) * 256 + rlo);
                    const float posf = (float)(pos0 + ai * HALF + m * 16) + (float)lf;
#pragma unroll
                    for (int bj = 0; bj < 2; ++bj) {
                        const float fac = rs[ai][m] * __builtin_amdgcn_exp2f(posf * ((pn & 1) ? (bj ? lgB1 : lgB0) : (bj ? lgA1 : lgA0)));
                        const f32x4 t1 = acc[ai][bj][m][0] * fac, t2 = acc[ai][bj][m][1] * fac;
                        const f32x4 o1 = t1 * cs - t2 * sn, o2 = t1 * sn + t2 * cs;
                        char* d = ub + ((ai * HALF + m * 16) * 1024 + bj * 128) * 2;
                        *(u32x2*)(d + lo) = pack4(o1); *(u32x2*)(d + 128 + lo) = pack4(o2);
                    }
                }
        } else if (pn < 24) {
            char* ub; int pitch; bool silu = false;
            if (pn < 8) { ub = (char*)(act + A_RV) + (pn - 4) * 512; pitch = 2048; }
            else if (pn < 12) { ub = (char*)(act + A_GS) + (pn - 8) * 512; pitch = 4096; silu = true; }
            else if (pn < 16) { ub = (char*)(act + A_GS) + 2048 + (pn - 12) * 512; pitch = 4096; }
            else if (pn < 20) { ub = (char*)(act + A_SK) + (pn - 16) * 512; pitch = 2048; }
            else { ub = (char*)(act + A_SV) + (pn - 20) * 512; pitch = 2048; }
            ub += (size_t)rlu * pitch;
            const unsigned lo = lf * (unsigned)pitch + ((unsigned)(wc * 32) + 8u * lq) * 2u;
#pragma unroll
            for (int ai = 0; ai < 2; ++ai)
#pragma unroll
                for (int m = 0; m < 4; ++m) {
                    char* rowp = ub + (size_t)(ai * HALF + m * 16) * pitch;
#pragma unroll
                    for (int bj = 0; bj < 2; ++bj) {
                        f32x4 v0 = acc[ai][bj][m][0] * rs[ai][m], v1 = acc[ai][bj][m][1] * rs[ai][m];
                        if (silu) { v0 = v0 * rcp4(exp4(-v0) + 1.0f); v1 = v1 * rcp4(exp4(-v1) + 1.0f); }
                        *(u32x4*)(rowp + bj * 256 + lo) = pack8(v0, v1);
                    }
                }
        } else {
            const size_t uo = ((size_t)rlu * 1024 + 128 * (pn - 24)) * 2;
            char* ga = (char*)(act + A_GA) + uo; char* gb = (char*)(act + A_GB) + uo;
            const unsigned lo = (lf * 1024u + (unsigned)(32 * wc) + 8u * lq) * 2u;
#pragma unroll
            for (int ai = 0; ai < 2; ++ai)
#pragma unroll
                for (int m = 0; m < 4; ++m) {
                    f32x4 ra[2], sb[2];
#pragma unroll
                    for (int n = 0; n < 2; ++n) {
                        const f32x4 ea = exp4(-(acc[ai][0][m][n] * rs[ai][m])) + 1.0f, eb = exp4(-(acc[ai][1][m][n] * rs[ai][m])) + 1.0f;
                        sb[n] = rcp4(eb); ra[n] = eb * rcp4(ea);
                    }
                    *(u32x4*)(ga + (ai * HALF + m * 16) * 2048 + lo) = pack8(ra[0], ra[1]);
                    *(u32x4*)(gb + (ai * HALF + m * 16) * 2048 + lo) = pack8(sb[0], sb[1]);
                }
        }
    }
};
struct EpiP3 {
    static constexpr bool PERM = false, AFTER_DRAIN = false, MID = true;
    unsigned char* act;
    __device__ __forceinline__ void mid(f32x4 (&acc)[2][2][4][2], const Unit& u, int wr, int wc, int fr, int fq) const {
        const char* g = (const char*)(act + A_GA) + ((size_t)(u.pm * BM + wr * 64) * 1024 + u.pn * BM) * 2;
        unsigned lo = ((unsigned)fr * 1024u + (unsigned)(wc * 32 + 8 * fq)) * 2u; asm volatile("" : "+v"(lo));
#pragma unroll
        for (int ai = 0; ai < 2; ++ai)
#pragma unroll
            for (int m = 0; m < 4; ++m)
#pragma unroll
                for (int bj = 0; bj < 2; ++bj) {
                    const u32x4 w = *(const u32x4*)(g + ((ai * HALF + m * 16) * 2048 + bj * 256) + lo);
                    acc[ai][bj][m][0] *= unpack_lo(w); acc[ai][bj][m][1] *= unpack_hi(w);
                }
    }
    __device__ __forceinline__ void operator()(const f32x4 (&acc)[2][2][4][2], const Unit& u, int wr, int wc, int fr, int fq) const {
        const size_t uo = ((size_t)(u.pm * BM + wr * 64) * 1024 + u.pn * BM) * 2;
        const char* g = (const char*)(act + A_GB) + uo; char* o = (char*)(act + A_MERGED) + uo;
        unsigned lo = ((unsigned)fr * 1024u + (unsigned)(wc * 32 + 8 * fq)) * 2u; asm volatile("" : "+v"(lo));
#pragma unroll
        for (int ai = 0; ai < 2; ++ai)
#pragma unroll
            for (int m = 0; m < 4; ++m)
#pragma unroll
                for (int bj = 0; bj < 2; ++bj) {
                    const int co = (ai * HALF + m * 16) * 2048 + bj * 256;
                    const u32x4 w = *(const u32x4*)(g + co + lo);
                    *(u32x4*)(o + co + lo) = pack8(acc[ai][bj][m][0] * unpack_lo(w), acc[ai][bj][m][1] * unpack_hi(w));
                }
    }
};
struct EpiX {
    static constexpr bool PERM = false, AFTER_DRAIN = false, MID = false;
    float* out; bf16_t* xb; float* ssq; int grow0;
    __device__ __forceinline__ void mid(f32x4 (&)[2][2][4][2], const Unit&, int, int, int, int) const {}
    __device__ __forceinline__ void operator()(const f32x4 (&acc)[2][2][4][2], const Unit& u, int wr, int wc, int fr, int fq) const {
        const size_t Ru = (size_t)(grow0 + u.pm * BM + wr * 64), cu = (size_t)(u.pn * BM + wc * 32);
        char* xo = (char*)out + (Ru * D + cu) * 4; char* xbo = (char*)xb + (Ru * D + cu) * 2; char* sq = (char*)ssq + Ru * 64 + (u.pn * 4 + wc) * 4;
        unsigned lo4 = ((unsigned)fr * 1024u + 4u * (unsigned)fq) * 4u, los = (unsigned)fr * 64u; asm volatile("" : "+v"(lo4), "+v"(los)); const unsigned lo2 = lo4 >> 1;
#pragma unroll
        for (int ai = 0; ai < 2; ++ai)
#pragma unroll
            for (int m = 0; m < 4; ++m) {
                float s = 0.f;
#pragma unroll
                for (int bj = 0; bj < 2; ++bj)
#pragma unroll
                    for (int n = 0; n < 2; ++n) {
                        const int co = (ai * HALF + m * 16) * 1024 + bj * HALF + n * 16;
                        const f32x4 xn = *(const f32x4*)(xo + co * 4 + lo4) + acc[ai][bj][m][n];
                        *(f32x4*)(xo + co * 4 + lo4) = xn; *(u32x2*)(xbo + co * 2 + lo2) = pack4(xn);
                        s += (xn[0] * xn[0] + xn[1] * xn[1]) + (xn[2] * xn[2] + xn[3] * xn[3]);
                    }
                s += __shfl_xor(s, 16); s += __shfl_xor(s, 32);
                if (fq == 0) *(float*)(sq + (ai * HALF + m * 16) * 64 + los) = s;
            }
    }
};
struct EpiP5 {
    static constexpr bool PERM = false, AFTER_DRAIN = false, MID = false;
    unsigned char* act; const float* ssq; int grow0;
    __device__ __forceinline__ void mid(f32x4 (&)[2][2][4][2], const Unit&, int, int, int, int) const {}
    __device__ __forceinline__ void operator()(const f32x4 (&acc)[2][2][4][2], const Unit& u, int wr, int wc, int fr, int fq) const {
        const int rlu = u.pm * BM + wr * 64;
        const char* sq = (const char*)ssq + (size_t)(grow0 + rlu) * 64;
        char* ub = (char*)(act + A_UP) + ((size_t)rlu * DFF + u.pn * BM) * 2;
        unsigned lo = ((unsigned)fr * (unsigned)DFF + (unsigned)(wc * 32 + 8 * fq)) * 2u, lf = (unsigned)fr * 64u; asm volatile("" : "+v"(lo), "+v"(lf));
#pragma unroll
        for (int ai = 0; ai < 2; ++ai)
#pragma unroll
            for (int m = 0; m < 4; ++m) {
                const float rs = row_rstd(sq + (ai * HALF + m * 16) * 64, lf);
#pragma unroll
                for (int bj = 0; bj < 2; ++bj) {
                    f32x4 v0 = acc[ai][bj][m][0] * rs, v1 = acc[ai][bj][m][1] * rs;
#pragma unroll
                    for (int e = 0; e < 4; ++e) { const float a = fmaxf(v0[e], 0.f), b = fmaxf(v1[e], 0.f); v0[e] = a * a; v1[e] = b * b; }
                    *(u32x4*)(ub + ((ai * HALF + m * 16) * DFF + bj * HALF) * 2 + lo) = pack8(v0, v1);
                }
            }
    }
};

template <class Epi, class Sched, bool ALIGN_EPI = false, bool SP2 = false>
__device__ __forceinline__ void gemm_phase(PG8_LAS unsigned char* lds, const Gemm g, const Sched& S, const Epi& E) {
    int tid = threadIdx.x; asm volatile("" : "+v"(tid));
    const int wid = __builtin_amdgcn_readfirstlane(tid >> 6), lane = tid & 63, wr = wid >> 2, wc = wid & 3, fr = lane & 15, fq = lane >> 4;
    const int K = g.K, nt = g.Kloop / BK;
    unsigned voffA[2], voffB[2];
#pragma unroll
    for (int i = 0; i < 2; ++i) { int R, C; stage_rc(tid * 16 + i * 8192, R, C); const int Rb = Epi::PERM ? ((R & ~31) + perm32(R & 31)) : R;
        voffA[i] = (unsigned)(R * K + C) * 2u; voffB[i] = (unsigned)(Rb * K + C) * 2u; }
    const size_t kstep = (size_t)(BK * 2);
    const size_t hstep = (size_t)HALF * K * 2;
    const size_t tstep = 2 * hstep;
    const unsigned ldsw = (unsigned)wid * 1024u;
    const int aoff = lds_byte(wr * 64 + fr, fq * 8), boff = lds_byte(wc * 32 + fr, fq * 8);
#define PG8_SA(b, h) (((b) * 2 + (h)) * HTB)
#define PG8_SB(b, h) ((4 + (b) * 2 + (h)) * HTB)
#define PG8_STAGE(bufoff, gbase, voff) do { _Pragma("unroll") for (int _i = 0; _i < 2; ++_i) \
        __builtin_amdgcn_global_load_lds((const unsigned*)((const char*)(gbase) + (voff)[_i]), (PG8_LAS unsigned*)(lds + (bufoff) + ldsw + _i * 8192), 16, 0, 0); } while (0)
#define PG8_LDA(dst, b, h) do { _Pragma("unroll") for (int m = 0; m < 4; ++m) _Pragma("unroll") for (int k = 0; k < 2; ++k) dst[m][k] = *(const PG8_LAS bf16x8*)(lds + PG8_SA(b, h) + aoff + m * 2048 + k * 1024); } while (0)
#define PG8_LDB(dst, b, h) do { _Pragma("unroll") for (int n = 0; n < 2; ++n) _Pragma("unroll") for (int k = 0; k < 2; ++k) dst[n][k] = *(const PG8_LAS bf16x8*)(lds + PG8_SB(b, h) + boff + n * 2048 + k * 1024); } while (0)
#define PG8_MMA(ai, bj, At, Bt) do { __builtin_amdgcn_s_setprio(1); _Pragma("unroll") for (int m = 0; m < 4; ++m) _Pragma("unroll") for (int n = 0; n < 2; ++n) _Pragma("unroll") for (int k = 0; k < 2; ++k) \
        acc[ai][bj][m][n] = __builtin_amdgcn_mfma_f32_16x16x32_bf16(Bt[n][k], At[m][k], acc[ai][bj][m][n], 0, 0, 0); __builtin_amdgcn_s_setprio(0); } while (0)
#define PG8_WAIT_V(n) asm volatile("s_waitcnt vmcnt(" #n ")" ::: "memory")
#define PG8_WAIT_L(n) asm volatile("s_waitcnt lgkmcnt(" #n ")" ::: "memory")
#define PG8_BAR __builtin_amdgcn_s_barrier()
#define PG8_SCHED __builtin_amdgcn_sched_barrier(0)
    Unit cur, nxt; int ui = 0;
    if (!S.next(0, cur)) return;
    f32x4 acc[2][2][4][2];
#pragma unroll
    for (int a = 0; a < 2; ++a)
#pragma unroll
        for (int b = 0; b < 2; ++b)
#pragma unroll
            for (int m = 0; m < 4; ++m)
#pragma unroll
                for (int n = 0; n < 2; ++n) acc[a][b][m][n] = (f32x4){0.f, 0.f, 0.f, 0.f};
    bf16x8 At[4][2], B0[2][2], B1[2][2];
    const char* cA = (const char*)g.A + (size_t)cur.pm * tstep + (size_t)cur.kofs * 2; const char* cB = (const char*)g.Bt + (size_t)cur.pn * tstep + (size_t)cur.kofs * 2;
    S.a_ready(cur);
    if constexpr (SP2) {
        PG8_STAGE(PG8_SB(0, 0), cB, voffB); PG8_STAGE(PG8_SB(0, 1), cB + hstep, voffB); PG8_STAGE(PG8_SA(0, 0), cA, voffA); PG8_STAGE(PG8_SA(0, 1), cA + hstep, voffA);
        if (wr == 1) PG8_BAR;
        PG8_WAIT_V(2); PG8_BAR;
        PG8_STAGE(PG8_SB(1, 0), cB + kstep, voffB); PG8_STAGE(PG8_SA(1, 0), cA + kstep, voffA); PG8_STAGE(PG8_SB(1, 1), cB + hstep + kstep, voffB);
        PG8_WAIT_V(6); PG8_BAR;
    } else {
        PG8_STAGE(PG8_SB(0, 0), cB, voffB); PG8_STAGE(PG8_SA(0, 0), cA, voffA); PG8_STAGE(PG8_SB(0, 1), cB + hstep, voffB); PG8_STAGE(PG8_SA(0, 1), cA + hstep, voffA);
        if (wr == 1) PG8_BAR;
        PG8_WAIT_V(4); PG8_BAR;
        PG8_STAGE(PG8_SB(1, 0), cB + kstep, voffB); PG8_STAGE(PG8_SA(1, 0), cA + kstep, voffA); PG8_STAGE(PG8_SB(1, 1), cB + hstep + kstep, voffB);
        PG8_WAIT_V(6); PG8_BAR;
    }
    for (;;) {
        const bool has_next = S.next(ui + 1, nxt);
        const char* nA = has_next ? (const char*)g.A + (size_t)nxt.pm * tstep + (size_t)nxt.kofs * 2 : cA; const char* nB = has_next ? (const char*)g.Bt + (size_t)nxt.pn * tstep + (size_t)nxt.kofs * 2 : cB;
        for (int t = 0; t < nt; t += 2) {
            const bool last = (t == nt - 2);
            const char* a1 = cA + (size_t)(t + 1) * kstep;
            const char* a2 = last ? nA : cA + (size_t)(t + 2) * kstep; const char* b2 = last ? nB : cB + (size_t)(t + 2) * kstep;
            const char* a3 = a2 + kstep; const char* b3 = b2 + kstep;
            if (last && has_next) S.a_ready(nxt);
            if constexpr (SP2) {
            PG8_LDB(B0, 0, 0); PG8_LDB(B1, 0, 1); PG8_SCHED; PG8_LDA(At, 0, 0); PG8_STAGE(PG8_SA(1, 1), a1 + hstep, voffA);
            PG8_WAIT_V(8); PG8_WAIT_L(0); PG8_BAR; PG8_MMA(0, 0, At, B0); PG8_MMA(0, 1, At, B1); PG8_BAR; PG8_SCHED;
            PG8_LDA(At, 0, 1); PG8_STAGE(PG8_SB(0, 0), b2, voffB); PG8_STAGE(PG8_SB(0, 1), b2 + hstep, voffB); PG8_STAGE(PG8_SA(0, 0), a2, voffA);
            PG8_WAIT_V(8); PG8_WAIT_L(0); PG8_BAR; PG8_MMA(1, 0, At, B0); PG8_MMA(1, 1, At, B1); PG8_BAR; PG8_SCHED;
            PG8_LDB(B0, 1, 0); PG8_LDB(B1, 1, 1); PG8_SCHED; PG8_LDA(At, 1, 0); PG8_STAGE(PG8_SA(0, 1), a2 + hstep, voffA);
            PG8_WAIT_V(8); PG8_WAIT_L(0); PG8_BAR; PG8_MMA(0, 0, At, B0); PG8_MMA(0, 1, At, B1); PG8_BAR; PG8_SCHED;
            PG8_LDA(At, 1, 1); PG8_STAGE(PG8_SB(1, 0), b3, voffB); PG8_STAGE(PG8_SB(1, 1), b3 + hstep, voffB); PG8_STAGE(PG8_SA(1, 0), a3, voffA);
            PG8_WAIT_V(8); PG8_WAIT_L(0); PG8_BAR; PG8_MMA(1, 0, At, B0); PG8_MMA(1, 1, At, B1); PG8_BAR; PG8_SCHED;
            } else {
            PG8_LDB(B0, 0, 0); PG8_SCHED; PG8_LDA(At, 0, 0); PG8_STAGE(PG8_SA(1, 1), a1 + hstep, voffA);
            PG8_WAIT_L(8); PG8_BAR; PG8_WAIT_L(0); PG8_MMA(0, 0, At, B0); PG8_BAR; PG8_SCHED;
            PG8_LDB(B1, 0, 1); PG8_STAGE(PG8_SB(0, 0), b2, voffB);
            PG8_BAR; PG8_WAIT_L(0); PG8_MMA(0, 1, At, B1); PG8_BAR;
            PG8_LDA(At, 0, 1); PG8_STAGE(PG8_SA(0, 0), a2, voffA);
            PG8_BAR; PG8_WAIT_L(0); PG8_MMA(1, 0, At, B0); PG8_BAR; PG8_SCHED;
            PG8_STAGE(PG8_SB(0, 1), b2 + hstep, voffB);
            PG8_WAIT_V(6); PG8_BAR; PG8_MMA(1, 1, At, B1); PG8_BAR;
            PG8_LDB(B0, 1, 0); PG8_SCHED; PG8_LDA(At, 1, 0); PG8_STAGE(PG8_SA(0, 1), a2 + hstep, voffA);
            PG8_WAIT_L(8); PG8_BAR; PG8_WAIT_L(0); PG8_MMA(0, 0, At, B0); PG8_BAR; PG8_SCHED;
            PG8_LDB(B1, 1, 1); PG8_STAGE(PG8_SB(1, 0), b3, voffB);
            PG8_BAR; PG8_WAIT_L(0); PG8_MMA(0, 1, At, B1); PG8_BAR;
            PG8_LDA(At, 1, 1); PG8_STAGE(PG8_SA(1, 0), a3, voffA);
            PG8_BAR; PG8_WAIT_L(0); PG8_MMA(1, 0, At, B0); PG8_BAR; PG8_SCHED;
            PG8_STAGE(PG8_SB(1, 1), b3 + hstep, voffB);
            PG8_WAIT_V(6); PG8_BAR; PG8_MMA(1, 1, At, B1); PG8_BAR;
            }
        }
        if constexpr (ALIGN_EPI) { if (wr == 0) PG8_BAR; }
        bool chain_first = false;
        if constexpr (Epi::MID) { chain_first = (cur.kofs == 0); }
        if constexpr (!Epi::AFTER_DRAIN) { if (chain_first) E.mid(acc, cur, wr, wc, fr, fq); else { E(acc, cur, wr, wc, fr, fq); S.done(cur); } }
        if (!has_next) break;
        if (!chain_first)
#pragma unroll
        for (int a = 0; a < 2; ++a)
#pragma unroll
            for (int b = 0; b < 2; ++b)
#pragma unroll
                for (int m = 0; m < 4; ++m)
#pragma unroll
                    for (int n = 0; n < 2; ++n) acc[a][b][m][n] = (f32x4){0.f, 0.f, 0.f, 0.f};
        cur = nxt; cA = nA; cB = nB; ++ui;
        if constexpr (ALIGN_EPI) { if (wr == 1) PG8_BAR; }
    }
    PG8_WAIT_V(0);
    if constexpr (!ALIGN_EPI) { if (wr == 0) PG8_BAR; }
    PG8_BAR;
    if constexpr (Epi::AFTER_DRAIN) { E.fused(acc, cur, wr, wc, fr, fq, lds, wid, lane); S.done(cur); }
#undef PG8_SA
#undef PG8_SB
#undef PG8_STAGE
#undef PG8_LDA
#undef PG8_LDB
#undef PG8_MMA
#undef PG8_WAIT_V
#undef PG8_WAIT_L
#undef PG8_BAR
#undef PG8_SCHED
}
}

namespace sba {
using bf16x8 = __attribute__((ext_vector_type(8))) short;
using s16x4  = __attribute__((ext_vector_type(4))) short;
using f32x16 = __attribute__((ext_vector_type(16))) float;
using u32x4  = __attribute__((ext_vector_type(4))) unsigned;
typedef _Float16 half8 __attribute__((ext_vector_type(8)));
typedef float f32x4 __attribute__((ext_vector_type(4)));
typedef _Float16 half2v __attribute__((ext_vector_type(2)));
typedef float float2v __attribute__((ext_vector_type(2)));
constexpr int KVBLK = 64;
constexpr int SHM_V = KVBLK * 128 * 2, SHM_K = KVBLK * 128 * 2;
constexpr int OFF_V = 0, OFF_K = 2 * SHM_V, OFF_FLAG = 2 * SHM_V + 2 * SHM_K;
#define KSWZ(row, colB) ((row) * 256 + ((colB) ^ (((row) & 7) << 4)))
#define SBAR() __builtin_amdgcn_sched_barrier(0)
__device__ __forceinline__ int crow(int r, int hi) { return (r & 3) + 8 * (r >> 2) + 4 * hi; }
__device__ __forceinline__ unsigned cvtpk(float lo, float hi) { unsigned r; asm volatile("v_cvt_pk_bf16_f32 %0, %1, %2" : "=v"(r) : "v"(lo), "v"(hi)); return r; }
__device__ __forceinline__ void qkt(f32x16& p0, f32x16& p1, const char* Ks, const bf16x8* qr, int r32, int hi) {
  p0 = f32x16{}; p1 = f32x16{};
#pragma unroll
  for (int d0 = 0; d0 < 8; ++d0) { const int cb = (d0 * 16 + hi * 8) * 2;
    const bf16x8 b0 = *reinterpret_cast<const bf16x8*>(Ks + KSWZ(r32, cb));
    const bf16x8 b1 = *reinterpret_cast<const bf16x8*>(Ks + KSWZ(32 + r32, cb));
    p0 = __builtin_amdgcn_mfma_f32_32x32x16_bf16(b0, qr[d0], p0, 0, 0, 0);
    p1 = __builtin_amdgcn_mfma_f32_32x32x16_bf16(b1, qr[d0], p1, 0, 0, 0); }
}
__device__ __forceinline__ int v_st(int k, int c) { const int kk = (k & ~0xC) | ((k & 4) << 1) | ((k & 8) >> 1); return ((kk >> 3) * 4 + (c >> 5)) * 512 + ((kk & 7) * 32 + (c & 31)) * 2; }
__device__ __forceinline__ int v_rd_base(int lane) { return ((lane & 3) << 3) | (((lane >> 2) & 3) << 6) | (((lane >> 4) & 1) << 5) | (((lane >> 5) & 1) << 8); }
constexpr int v_rd_off(int d0, int ks, int half) { return d0 * 512 + ks * 4096 + half * 2048; }
template <int OFF> __device__ __forceinline__ s16x4 tr_read(int vb) {
  s16x4 r; asm volatile("ds_read_b64_tr_b16 %0, %1 offset:%2" : "=&v"(r) : "v"(vb), "i"(OFF) : "memory"); return r;
}
template <int D0> __device__ __forceinline__ void pv_one(f32x16& od, int vb, bf16x8 pa0, bf16x8 pa1, bf16x8 pa2, bf16x8 pa3) {
  const s16x4 l0 = tr_read<v_rd_off(D0, 0, 0)>(vb), h0 = tr_read<v_rd_off(D0, 0, 1)>(vb), l1 = tr_read<v_rd_off(D0, 1, 0)>(vb), h1 = tr_read<v_rd_off(D0, 1, 1)>(vb);
  const s16x4 l2 = tr_read<v_rd_off(D0, 2, 0)>(vb), h2 = tr_read<v_rd_off(D0, 2, 1)>(vb), l3 = tr_read<v_rd_off(D0, 3, 0)>(vb), h3 = tr_read<v_rd_off(D0, 3, 1)>(vb);
  asm volatile("s_waitcnt lgkmcnt(0)" ::: "memory"); SBAR();
#define PK(L, H) (bf16x8){L[0], L[1], L[2], L[3], H[0], H[1], H[2], H[3]}
  od = __builtin_amdgcn_mfma_f32_32x32x16_bf16(pa0, PK(l0, h0), od, 0, 0, 0);
  od = __builtin_amdgcn_mfma_f32_32x32x16_bf16(pa1, PK(l1, h1), od, 0, 0, 0);
  od = __builtin_amdgcn_mfma_f32_32x32x16_bf16(pa2, PK(l2, h2), od, 0, 0, 0);
  od = __builtin_amdgcn_mfma_f32_32x32x16_bf16(pa3, PK(l3, h3), od, 0, 0, 0);
#undef PK
}
__device__ __forceinline__ void pv_d0(f32x16* o, int vb, bf16x8 pa0, bf16x8 pa1, bf16x8 pa2, bf16x8 pa3) {
  pv_one<0>(o[0], vb, pa0, pa1, pa2, pa3); pv_one<1>(o[1], vb, pa0, pa1, pa2, pa3); pv_one<2>(o[2], vb, pa0, pa1, pa2, pa3); pv_one<3>(o[3], vb, pa0, pa1, pa2, pa3);
}
__device__ __forceinline__ half8 pack_h8(const f32x16& l, int base) {
  half8 r;
#pragma unroll
  for (int j = 0; j < 8; j += 2) { const float2v f = {l[base + j], l[base + j + 1]}; const half2v hh = __builtin_convertvector(f, half2v); r[j] = hh[0]; r[j + 1] = hh[1]; }
  return r;
}
template <bool BAND>
__device__ __forceinline__ void sb_half(f32x16& p, float& R, const half8 U0, const half8 U1, int kbase, int row_rel, int hi) {
  f32x16 l;
#pragma unroll
  for (int r = 0; r < 16; ++r) {
    const float z = fminf(p[r], 80.0f); p[r] = z;
    float lv = -__builtin_amdgcn_logf(1.0f + __builtin_amdgcn_exp2f(z));
    if (BAND) lv = (kbase + crow(r, hi) < row_rel) ? lv : 0.0f;
    l[r] = lv;
  }
  const half8 lf0 = pack_h8(l, 0), lf1 = pack_h8(l, 8);
  f32x16 E = __builtin_amdgcn_mfma_f32_32x32x16_f16(U0, lf0, f32x16{}, 0, 0, 0);
  E = __builtin_amdgcn_mfma_f32_32x32x16_f16(U1, lf1, E, 0, 0, 0);
#pragma unroll
  for (int r = 0; r < 16; ++r) {
    float w = __builtin_amdgcn_exp2f((p[r] + R) + (l[r] + E[r]));
    if (BAND) w = (kbase + crow(r, hi) < row_rel) ? w : 0.0f;
    p[r] = w;
  }
  const float tot = E[0] + l[0];
  const auto rr = __builtin_amdgcn_permlane32_swap(__float_as_uint(tot), __float_as_uint(tot), false, false);
  R += __uint_as_float(rr[0]);
}
#define PK4(P, BASE, OUT) do { unsigned a0 = cvtpk(P[BASE + 0], P[BASE + 1]), a1 = cvtpk(P[BASE + 2], P[BASE + 3]);   \
    unsigned b0 = cvtpk(P[BASE + 4], P[BASE + 5]), b1 = cvtpk(P[BASE + 6], P[BASE + 7]);                              \
    auto r0 = __builtin_amdgcn_permlane32_swap(a0, b0, false, false); auto r1 = __builtin_amdgcn_permlane32_swap(a1, b1, false, false); \
    u32x4 w = {r0[0], r1[0], r0[1], r1[1]}; OUT = *reinterpret_cast<bf16x8*>(&w); } while (0)

__device__ __forceinline__ void sb_unit(int b, int h, int qb, unsigned char* act, char* lds) {
  int tid = threadIdx.x; asm volatile("" : "+v"(tid));
  const int wid = __builtin_amdgcn_readfirstlane(tid >> 6), lane = tid & 63, r32 = lane & 31, hi = lane >> 5;
  const bf16* GS = (const bf16*)(act + A_GS); const bf16* SK = (const bf16*)(act + A_SK); const bf16* SV = (const bf16*)(act + A_SV);
  char* V_lds = lds + OFF_V; char* K_lds = lds + OFF_K; volatile __attribute__((address_space(3))) unsigned* flags = (volatile __attribute__((address_space(3))) unsigned*)(lds + OFF_FLAG);
  const int q0 = qb * 256;
  half8 U0, U1;
#pragma unroll
  for (int j = 0; j < 8; ++j) { const int kp = 8 * (j >> 2) + 4 * hi + (j & 3); U0[j] = (kp > r32) ? (_Float16)1.0f : (_Float16)0.0f; U1[j] = (16 + kp > r32) ? (_Float16)1.0f : (_Float16)0.0f; }
  bf16x8 qr[8];
  { const bf16* Qw = GS + (size_t)(b * SEQ + q0 + wid * 32 + r32) * 2048 + 1024 + h * 128 + hi * 8;
#pragma unroll
    for (int d0 = 0; d0 < 8; ++d0) qr[d0] = *reinterpret_cast<const bf16x8*>(Qw + d0 * 16); }
  const bf16* Kh = SK + (size_t)(b * SEQ) * 1024 + h * 128; const bf16* Vh = SV + (size_t)(b * SEQ) * 1024 + h * 128;
  const int sr = tid >> 4, sc = (tid & 15) * 8, vst0 = v_st(sr, sc), vst1 = v_st(32 + sr, sc);
  const int vb0 = (int)(uintptr_t)V_lds + v_rd_base(lane);
  bf16x8 vs0, vs1, ks0, ks1;
#define SLOAD(k0) do { vs0 = *reinterpret_cast<const bf16x8*>(&Vh[(size_t)((k0) + sr) * 1024 + sc]); vs1 = *reinterpret_cast<const bf16x8*>(&Vh[(size_t)((k0) + 32 + sr) * 1024 + sc]); \
    ks0 = *reinterpret_cast<const bf16x8*>(&Kh[(size_t)((k0) + sr) * 1024 + sc]); ks1 = *reinterpret_cast<const bf16x8*>(&Kh[(size_t)((k0) + 32 + sr) * 1024 + sc]); } while (0)
#define SWRITE(bb) do { *(bf16x8*)(V_lds + (bb) * SHM_V + vst0) = vs0; *(bf16x8*)(V_lds + (bb) * SHM_V + vst1) = vs1; const int kc = sc * 2; \
    *(bf16x8*)(K_lds + (bb) * SHM_K + KSWZ(sr, kc)) = ks0; *(bf16x8*)(K_lds + (bb) * SHM_K + KSWZ(32 + sr, kc)) = ks1; } while (0)
  f32x16 o[4] = {}; float R = 0.f;
  const int NT = 4 * qb + 4, row_rel = 32 * wid + r32;
  SLOAD((NT - 1) * KVBLK); SWRITE(0); SLOAD((NT - 2) * KVBLK);
  __syncthreads();
  int cur = 0;
  for (int jt = NT - 1; jt >= 0; --jt) {
    const int kb = 64 * (jt - 4 * qb);
    const bool band = kb >= 0;
    if (!(band && kb >= 32 * wid + 32)) {
      f32x16 p0, p1; bf16x8 pa0, pa1, pa2, pa3;
      SBAR(); qkt(p0, p1, K_lds + cur * SHM_K, qr, r32, hi);
      if (band) { sb_half<true>(p1, R, U0, U1, kb + 32, row_rel, hi); sb_half<true>(p0, R, U0, U1, kb, row_rel, hi); }
      else { sb_half<false>(p1, R, U0, U1, 0, 0, hi); sb_half<false>(p0, R, U0, U1, 0, 0, hi); }
      PK4(p0, 0, pa0); PK4(p0, 8, pa1); PK4(p1, 0, pa2); PK4(p1, 8, pa3);
      SBAR(); pv_d0(o, vb0 + cur * SHM_V, pa0, pa1, pa2, pa3);
    }
    if (jt >= 1) { SWRITE(cur ^ 1); if (jt >= 2) SLOAD((jt - 2) * KVBLK); }
    { const bool wdone = __all(R < -160.0f); if (lane == 0) flags[cur * 8 + wid] = wdone ? 1u : 0u; }
    __syncthreads();
    unsigned alld = 1u;
#pragma unroll
    for (int i = 0; i < 8; ++i) alld &= flags[cur * 8 + i];
    if (alld) break;
    cur ^= 1;
  }
  __syncthreads();
  { bf16* stg = (bf16*)(lds + wid * 8192);
#pragma unroll
    for (int r = 0; r < 16; ++r) { const int orow = crow(r, hi);
#pragma unroll
      for (int d0 = 0; d0 < 4; ++d0) stg[orow * 128 + d0 * 32 + r32] = (bf16)f2bf(o[d0][r]); }
    asm volatile("s_waitcnt lgkmcnt(0)" ::: "memory");
    bf16* Ow = (bf16*)GS + (size_t)(b * SEQ + q0 + wid * 32) * 2048 + 1024 + h * 128;
#pragma unroll
    for (int i = 0; i < 8; ++i) { const int row = i * 4 + (lane >> 4), ch = lane & 15; const u32x4 v = *(const u32x4*)(stg + row * 128 + ch * 8); *(u32x4*)(Ow + (size_t)row * 2048 + ch * 8) = v; } }
  __syncthreads();
#undef SLOAD
#undef SWRITE
}
constexpr int R_SHM_V = 2 * SHM_V, R_OFF_V = 0, R_OFF_K = 2 * R_SHM_V, R_OFF_STAT = 131072;
__device__ __forceinline__ void ret_unit(int b, int h, int qb, unsigned char* act, char* lds) {
  int tid = threadIdx.x; asm volatile("" : "+v"(tid));
  const int wid = __builtin_amdgcn_readfirstlane(tid >> 6), lane = tid & 63, r32 = lane & 31, hi = lane >> 5, rg = wid & 3, dh = wid >> 2;
  const bf16* RQK = (const bf16*)(act + A_RQK); const bf16* RV = (const bf16*)(act + A_RV); bf16* GS = (bf16*)(act + A_GS);
  char* V_lds = lds + R_OFF_V; char* K_lds = lds + R_OFF_K;
  const int q0 = qb * 128;
  bf16x8 qr[8];
  { const bf16* Qw = RQK + (size_t)(b * SEQ + q0 + rg * 32 + r32) * 1024 + h * 128 + hi * 8;
#pragma unroll
    for (int d0 = 0; d0 < 8; ++d0) qr[d0] = *reinterpret_cast<const bf16x8*>(Qw + d0 * 16); }
  const bf16* Kh = RQK + (size_t)(b * SEQ) * 1024 + 512 + h * 128; const bf16* Vh = RV + (size_t)(b * SEQ) * 1024 + h * 256;
  const int sr = tid >> 4, sc = (tid & 15) * 8, vst0 = v_st(sr, sc), vst1 = v_st(32 + sr, sc);
  const int vb0 = (int)(uintptr_t)V_lds + dh * SHM_V + v_rd_base(lane);
  bf16x8 va0, va1, vb0r, vb1r, ks0, ks1;
#define SLOAD(k0) do { const bf16* vp0 = &Vh[(size_t)((k0) + sr) * 1024 + sc]; const bf16* vp1 = &Vh[(size_t)((k0) + 32 + sr) * 1024 + sc]; \
    va0 = *reinterpret_cast<const bf16x8*>(vp0); va1 = *reinterpret_cast<const bf16x8*>(vp1); vb0r = *reinterpret_cast<const bf16x8*>(vp0 + 128); vb1r = *reinterpret_cast<const bf16x8*>(vp1 + 128); \
    ks0 = *reinterpret_cast<const bf16x8*>(&Kh[(size_t)((k0) + sr) * 1024 + sc]); ks1 = *reinterpret_cast<const bf16x8*>(&Kh[(size_t)((k0) + 32 + sr) * 1024 + sc]); } while (0)
#define SWRITE(bb) do { char* vq = V_lds + (bb) * R_SHM_V; *(bf16x8*)(vq + vst0) = va0; *(bf16x8*)(vq + vst1) = va1; *(bf16x8*)(vq + SHM_V + vst0) = vb0r; *(bf16x8*)(vq + SHM_V + vst1) = vb1r; \
    const int kc = sc * 2; *(bf16x8*)(K_lds + (bb) * SHM_K + KSWZ(sr, kc)) = ks0; *(bf16x8*)(K_lds + (bb) * SHM_K + KSWZ(32 + sr, kc)) = ks1; } while (0)
  f32x16 o[4] = {};
  const int NT = 2 * qb + 2, row_rel = 32 * rg + r32;
  SLOAD((NT - 1) * KVBLK); SWRITE(0); SLOAD((NT - 2) * KVBLK);
  __syncthreads();
  int cur = 0;
  for (int jt = NT - 1; jt >= 0; --jt) {
    const int kb = 64 * (jt - 2 * qb);
    const bool band = kb >= 0;
    if (true) {
      f32x16 p0, p1; bf16x8 pa0, pa1, pa2, pa3;
      SBAR(); qkt(p0, p1, K_lds + cur * SHM_K, qr, r32, hi);
      if (band) {
#pragma unroll
        for (int r = 0; r < 16; ++r) { const int kr = kb + crow(r, hi); p0[r] = (kr <= row_rel) ? p0[r] : 0.0f; p1[r] = (kr + 32 <= row_rel) ? p1[r] : 0.0f; }
      }
      PK4(p0, 0, pa0); PK4(p0, 8, pa1); PK4(p1, 0, pa2); PK4(p1, 8, pa3);
      SBAR(); pv_d0(o, vb0 + cur * R_SHM_V, pa0, pa1, pa2, pa3);
    }
    if (jt >= 1) { SWRITE(cur ^ 1); if (jt >= 2) SLOAD((jt - 2) * KVBLK); }
    __syncthreads();
    cur ^= 1;
  }
  { float* stg = (float*)(lds + wid * 16384);
#pragma unroll
    for (int r = 0; r < 16; ++r) { const int orow = crow(r, hi);
#pragma unroll
      for (int d0 = 0; d0 < 4; ++d0) stg[orow * 128 + d0 * 32 + r32] = o[d0][r]; }
    __syncthreads();
    const int row = lane >> 1, hc = lane & 1;
    f32x4 x[16]; float sm = 0.f, sq = 0.f;
#pragma unroll
    for (int i = 0; i < 16; ++i) { x[i] = *(const f32x4*)(stg + row * 128 + hc * 64 + i * 4); sm += (x[i][0] + x[i][1]) + (x[i][2] + x[i][3]); sq += (x[i][0] * x[i][0] + x[i][1] * x[i][1]) + (x[i][2] * x[i][2] + x[i][3] * x[i][3]); }
    sm += __shfl_xor(sm, 1); sq += __shfl_xor(sq, 1);
    float2v* stat = (float2v*)(lds + R_OFF_STAT);
    if (hc == 0) stat[wid * 32 + row] = (float2v){sm, sq};
    __syncthreads();
    const float2v ps = stat[(wid ^ 4) * 32 + row];
    const float mean = (sm + ps[0]) * (1.0f / 256.0f), var = fmaxf((sq + ps[1]) * (1.0f / 256.0f) - mean * mean, 0.0f), rstd = rsqrtf(var + GN_EPS);
    bf16* gp = GS + (size_t)(b * SEQ + q0 + rg * 32 + row) * 2048 + h * 256 + dh * 128 + hc * 64;
#pragma unroll
    for (int i = 0; i < 8; ++i) {
      const u32x4 gw = *(const u32x4*)(gp + i * 8);
      const f32x4 a = x[2 * i], c = x[2 * i + 1];
      u32x4 ow;
      ow[0] = cvtpk((a[0] - mean) * rstd * __builtin_bit_cast(float, gw[0] << 16), (a[1] - mean) * rstd * __builtin_bit_cast(float, gw[0] & 0xffff0000u));
      ow[1] = cvtpk((a[2] - mean) * rstd * __builtin_bit_cast(float, gw[1] << 16), (a[3] - mean) * rstd * __builtin_bit_cast(float, gw[1] & 0xffff0000u));
      ow[2] = cvtpk((c[0] - mean) * rstd * __builtin_bit_cast(float, gw[2] << 16), (c[1] - mean) * rstd * __builtin_bit_cast(float, gw[2] & 0xffff0000u));
      ow[3] = cvtpk((c[2] - mean) * rstd * __builtin_bit_cast(float, gw[3] << 16), (c[3] - mean) * rstd * __builtin_bit_cast(float, gw[3] & 0xffff0000u));
      *(u32x4*)(gp + i * 8) = ow;
    }
  }
  __syncthreads();
#undef SLOAD
#undef SWRITE
}
__device__ __forceinline__ void ret_phase(unsigned char* act, char* lds) {
  const int NU = BG * 4 * 16;
  for (int i = 0; i < 2; ++i) {
    for (int c = blockIdx.x; c < NU / 2; c += gridDim.x) {
      const int u = i == 0 ? c : NU - 1 - c, qb = 15 - u / (NU / 16), bh = u % (NU / 16);
      ret_unit(bh >> 2, bh & 3, qb, act, lds);
    }
  }
}
__device__ __forceinline__ void sb_phase(unsigned char* act, char* lds) {
  const int NU = BG * 8 * 8;
  for (int i = 0; i < 2; ++i) {
    for (int c = blockIdx.x; c < NU / 2; c += gridDim.x) {
      const int u = i == 0 ? c : NU - 1 - c, qb = 7 - u / (NU / 8), bh = u % (NU / 8);
      sb_unit(bh >> 3, bh & 7, qb, act, lds);
    }
  }
}
#undef PK4
#undef KSWZ
#undef SBAR
}

#define LAS __attribute__((address_space(3)))
typedef unsigned v4u __attribute__((ext_vector_type(4)));
#define LDS_WAIT() asm volatile("s_waitcnt lgkmcnt(0)" ::: "memory")
constexpr int NWAVES = 8;
constexpr int LDS_BYTES = 147456;

__device__ __forceinline__ int rho32(int l) { return 16 * ((l >> 2) & 1) + 4 * (l >> 3) + (l & 3); }
__device__ __forceinline__ int pos_win(int c) {
    if (c < 1024) { const int hh = c >> 7, j = c & 127, n = j >> 6, jj = j & 63; return 256 * (hh >> 1) + 128 * (hh & 1) + 32 * (jj >> 4) + 16 * n + (jj & 15); }
    if (c < 6144) return (c & ~31) + rho32(c & 31);
    const int isb = (c >= 7168) ? 1 : 0, ch = (c - 6144) & 1023, j = ch >> 7, w = ch & 127;
    return 256 * (24 + j) + 128 * isb + (w & ~31) + rho32(w & 31);
}
enum { KIND_NAT = 0, KIND_P32 = 1, KIND_WIN = 2 };
__device__ __forceinline__ void tr_item(const float* __restrict__ W, int N, bf16* __restrict__ WT, int ldt, int koff, int kind, const float* __restrict__ gain, LAS float* scr, int item, int lane) {
    const int nblk = N / 32, kb = item / nblk, nb = item % nblk, k0 = 64 * kb, n0 = 32 * nb;
#pragma unroll 8
    for (int i = 0; i < 32; ++i) { const int kk = 2 * i + (lane >> 5); scr[kk * 33 + (lane & 31)] = W[(size_t)(k0 + kk) * N + n0 + (lane & 31)]; }
    LDS_WAIT(); asm volatile("" ::: "memory");
    const int c = lane & 7;
    float gn[8];
#pragma unroll
    for (int i = 0; i < 8; ++i) gn[i] = gain ? gain[k0 + 8 * c + i] : 1.0f;
#pragma unroll
    for (int j = 0; j < 4; ++j) {
        const int n = (lane >> 3) + 8 * j, cl = n0 + n; int pos = cl; float sc = 1.0f;
        if (kind == KIND_P32) pos = (cl & ~31) + rho32(cl & 31);
        else if (kind == KIND_WIN) { pos = pos_win(cl); if (cl >= 512 && cl < 1024) sc = KR_SCALE; else if (cl >= 3072 && cl < 4096) sc = QS_SCALE; }
        const LAS float* s = scr + (8 * c) * 33 + n;
        v4u o; o.x = pk2(s[0 * 33] * gn[0] * sc, s[1 * 33] * gn[1] * sc); o.y = pk2(s[2 * 33] * gn[2] * sc, s[3 * 33] * gn[3] * sc);
        o.z = pk2(s[4 * 33] * gn[4] * sc, s[5 * 33] * gn[5] * sc); o.w = pk2(s[6 * 33] * gn[6] * sc, s[7 * 33] * gn[7] * sc);
        *(v4u*)(WT + (size_t)pos * ldt + koff + k0 + 8 * c) = o;
    }
    LDS_WAIT(); asm volatile("" ::: "memory");
}

#define RLX_AGENT __ATOMIC_RELAXED, __HIP_MEMORY_SCOPE_AGENT
constexpr int MISC_OFF = 131072 + 4096;
constexpr size_t CTL_ZERO_BYTES = 65536;
#define XB_TMO      128
#define XB_XCNT(j)  (256  + 64 * (j))
#define XB_XSUB(j)  (1280 + 64 * (j))
#define XB_XGEN(j)  (2304 + 64 * (j))
#define XB_TOP      3328
#define XB_TOPGEN   3392
#define XCD_BAR_WORDS 3456
#define XB_SPIN_CAP (1u << 18)

__device__ __forceinline__ unsigned xb_ld(unsigned* p)              { return __hip_atomic_load(p, __ATOMIC_RELAXED, __HIP_MEMORY_SCOPE_AGENT); }
__device__ __forceinline__ unsigned xb_add(unsigned* p, unsigned v) { return __hip_atomic_fetch_add(p, v, __ATOMIC_RELAXED, __HIP_MEMORY_SCOPE_AGENT); }
__device__ __forceinline__ unsigned xb_xcc_id() { return (unsigned)__builtin_amdgcn_s_getreg((3 << 11) | 20) & 0xFu; }
#define XB_SPIN(cond, bar) do { unsigned _sp = 0; while (cond) { __builtin_amdgcn_s_sleep(1); \
    if ((++_sp & 255u) == 0u) { if (xb_ld(&(bar)[XB_TMO])) break; if (_sp > XB_SPIN_CAP) { atomicAdd(&(bar)[XB_TMO], 1u); break; } } } } while (0)

struct XcdBarrier {
    unsigned* bar; unsigned x;
    volatile LAS unsigned* st;
};

__device__ __forceinline__ XcdBarrier xcd_barrier_post(unsigned* bar, volatile LAS unsigned* st) {
    XcdBarrier b; b.bar = bar; b.x = xb_xcc_id(); b.st = st;
    if (threadIdx.x == 0) (void)xb_add(&bar[XB_XCNT(b.x)], 1u);
    return b;
}
__device__ __forceinline__ void xcd_barrier_complete(unsigned* bar, unsigned x, unsigned& nloc, unsigned& nx) {
    const unsigned G = gridDim.x * gridDim.y * gridDim.z;
    unsigned sum, cnt, mine, sp = 0u;
    for (;;) {
        sum = 0u; cnt = 0u; mine = 0u;
#pragma unroll
        for (unsigned j = 0; j < 16; ++j) { const unsigned c = xb_ld(&bar[XB_XCNT(j)]); sum += c; cnt += (c > 0u) ? 1u : 0u; mine = (j == x) ? c : mine; }
        if (sum == G) break;
        __builtin_amdgcn_s_sleep(1);
        if ((++sp & 255u) == 0u) { if (xb_ld(&bar[XB_TMO])) break; if (sp > XB_SPIN_CAP) { atomicAdd(&bar[XB_TMO], 1u); break; } }
    }
    nloc = mine > 0u ? mine : 1u; nx = cnt > 0u ? cnt : 1u;
}

__device__ __forceinline__ void xcd_barrier(const XcdBarrier& b) {
    asm volatile("s_waitcnt vmcnt(0)" ::: "memory");
    __syncthreads();
    if (threadIdx.x == 0) {
        unsigned* bar = b.bar;
        __builtin_amdgcn_s_waitcnt(0);
        unsigned nloc = b.st[0], nx = b.st[1];
        if (nloc == 0u) { xcd_barrier_complete(bar, b.x, nloc, nx); b.st[0] = nloc; b.st[1] = nx; }
        const unsigned old = xb_add(&bar[XB_XSUB(b.x)], 1u);
        const unsigned gen = old / nloc;
        if (old + 1u == (gen + 1u) * nloc) {
            __builtin_amdgcn_fence(__ATOMIC_RELEASE, "agent");
            asm volatile("s_waitcnt vmcnt(0)" ::: "memory");
            const unsigned og = xb_add(&bar[XB_TOP], 1u);
            const unsigned tg = og / nx;
            if (og + 1u == (tg + 1u) * nx) xb_add(&bar[XB_TOPGEN], 1u);
            else XB_SPIN(xb_ld(&bar[XB_TOPGEN]) == tg, bar);
            __builtin_amdgcn_fence(__ATOMIC_ACQUIRE, "agent");
            xb_add(&bar[XB_XGEN(b.x)], 1u);
            asm volatile("s_waitcnt vmcnt(0)" ::: "memory");
        } else {
            XB_SPIN(xb_ld(&bar[XB_XGEN(b.x)]) == gen, bar);
            __builtin_amdgcn_fence(__ATOMIC_ACQUIRE, "agent");
            asm volatile("s_waitcnt vmcnt(0)" ::: "memory");
        }
    }
    __syncthreads();
}

struct Args { const float* in[10]; float* out; unsigned char* ws; int ph_lo, ph_hi; };
constexpr int PH_PRO = 0, PH_FINAL = 1 + 6 * DEPTH * NGRP;

__device__ __forceinline__ void prologue_phase(const Args& a, unsigned char* lds) {
    int tid_ = threadIdx.x; asm volatile("" : "+v"(tid_));
    const int lane = tid_ & 63, wave = __builtin_amdgcn_readfirstlane(tid_ >> 6);
    const float* x = a.in[0]; float* out = a.out; bf16* xb = (bf16*)(a.ws + WS_XB); float* ssq = (float*)(a.ws + WS_SSQ); float* rope = (float*)(a.ws + WS_ROPE);
    const int gw = blockIdx.x * NWAVES + wave, NGW = gridDim.x * NWAVES;
    LAS float* scr = (LAS float*)((LAS unsigned char*)lds + wave * 16384);
    constexpr int I_IN = 16 * 256, I_SQ = 16 * 32, I_UP = 16 * 128, I_DN = 64 * 32, I_LAYER = I_IN + 3 * I_SQ + I_UP + I_DN;
    for (int it = gw; it < DEPTH * I_LAYER; it += NGW) {
        const int l = it / I_LAYER; int r = it % I_LAYER;
        unsigned char* wl = a.ws + WS_W + (size_t)l * WL_STRIDE;
        if (r < I_IN) { tr_item(a.in[1] + (size_t)l * D * DIN, DIN, (bf16*)(wl + WL_WIN), D, 0, KIND_WIN, a.in[7] + l * D, scr, r, lane); continue; } r -= I_IN;
        if (r < I_SQ) { tr_item(a.in[2] + (size_t)l * D * D, D, (bf16*)(wl + WL_PCAT), 2 * D, 0, KIND_P32, nullptr, scr, r, lane); continue; } r -= I_SQ;
        if (r < I_SQ) { tr_item(a.in[3] + (size_t)l * D * D, D, (bf16*)(wl + WL_PCAT), 2 * D, D, KIND_P32, nullptr, scr, r, lane); continue; } r -= I_SQ;
        if (r < I_SQ) { tr_item(a.in[4] + (size_t)l * D * D, D, (bf16*)(wl + WL_WOUT), D, 0, KIND_NAT, nullptr, scr, r, lane); continue; } r -= I_SQ;
        if (r < I_UP) { tr_item(a.in[5] + (size_t)l * D * DFF, DFF, (bf16*)(wl + WL_WUP), D, 0, KIND_P32, a.in[8] + l * D, scr, r, lane); continue; } r -= I_UP;
        tr_item(a.in[6] + (size_t)l * DFF * D, D, (bf16*)(wl + WL_WDN), DFF, 0, KIND_NAT, nullptr, scr, r, lane);
    }
    for (int r = gw; r < M; r += NGW) {
        float s = 0.f;
#pragma unroll
        for (int j = 0; j < 4; ++j) {
            const int c = j * 256 + lane * 4;
            const float4 v = *(const float4*)(x + (size_t)r * D + c);
            *(float4*)(out + (size_t)r * D + c) = v;
            s += v.x * v.x + v.y * v.y + v.z * v.z + v.w * v.w;
            uint2 w; w.x = pk2(v.x, v.y); w.y = pk2(v.z, v.w);
            *(uint2*)(xb + (size_t)r * D + c) = w;
        }
#pragma unroll
        for (int o = 1; o < 64; o <<= 1) s += __shfl_xor(s, o);
        if (lane < 16) ssq[(size_t)r * 16 + lane] = (lane == 0) ? s : 0.f;
    }
    for (int i = blockIdx.x * 512 + tid_; i < SEQ * 64; i += gridDim.x * 512) {
        const int pos = i >> 6, j = i & 63;
        const float inv = powf(10000.0f, -(float)j / 64.0f);
        const float ang = (float)pos * inv;
        rope[i] = cosf(ang); rope[SEQ * 64 + i] = sinf(ang);
    }
}
__device__ __forceinline__ void final_phase(const Args& a) {
    int tid_ = threadIdx.x; asm volatile("" : "+v"(tid_));
    const int lane = tid_ & 63, wave = __builtin_amdgcn_readfirstlane(tid_ >> 6);
    float* out = a.out; const float* g = a.in[9];
    const int gw = blockIdx.x * NWAVES + wave, NGW = gridDim.x * NWAVES;
    for (int r = gw; r < M; r += NGW) {
        float4 v[4]; float s = 0.f;
#pragma unroll
        for (int j = 0; j < 4; ++j) { v[j] = *(const float4*)(out + (size_t)r * D + j * 256 + lane * 4); s += v[j].x * v[j].x + v[j].y * v[j].y + v[j].z * v[j].z + v[j].w * v[j].w; }
#pragma unroll
        for (int o = 1; o < 64; o <<= 1) s += __shfl_xor(s, o);
        const float rs = rsqrtf(s * (1.0f / D) + NORM_EPS);
#pragma unroll
        for (int j = 0; j < 4; ++j) { const float4 gg = *(const float4*)(g + j * 256 + lane * 4);
            float4 o; o.x = v[j].x * rs * gg.x; o.y = v[j].y * rs * gg.y; o.z = v[j].z * rs * gg.z; o.w = v[j].w * rs * gg.w;
            *(float4*)(out + (size_t)r * D + j * 256 + lane * 4) = o; }
    }
}

#ifndef RET_NAIVE
#define RET_NAIVE 0
#endif
#ifndef PHMASK
#define PHMASK 31
#endif
#ifndef MK_ONE_LAUNCH
#define MK_ONE_LAUNCH 1
#endif
__global__ void __launch_bounds__(NWAVES * 64, 2) mega(Args a) {
    extern __shared__ __attribute__((aligned(16))) unsigned char lds[];
    const int G = gridDim.x;
    PG8_LAS unsigned char* ring = (PG8_LAS unsigned char*)lds;
#if MK_ONE_LAUNCH
    volatile LAS unsigned* MISC = (volatile LAS unsigned*)((LAS unsigned char*)lds + MISC_OFF);
    if (threadIdx.x < 4) MISC[threadIdx.x] = 0u;
    __syncthreads();
    const XcdBarrier bar = xcd_barrier_post((unsigned*)(a.ws + WS_CTL), MISC);
#define GRID_SYNC() xcd_barrier(bar)
#else
#define GRID_SYNC() do {} while (0)
#endif
    int ph = a.ph_lo; const int ph_hi = a.ph_hi;
    if (ph == PH_PRO) { prologue_phase(a, lds); ++ph;
#if MK_ONE_LAUNCH
        if (ph < ph_hi) cg::this_grid().sync();
#endif
    }
    const int ph_end = ph_hi < PH_FINAL ? ph_hi : PH_FINAL;
    for (; ph < ph_end; ++ph) {
        size_t zofs = 0; asm volatile("" : "+s"(zofs));
        unsigned char* ws = a.ws + zofs; float* outp = (float*)((unsigned char*)a.out + zofs);
        unsigned char* act = ws + WS_ACT; float* ssq = (float*)(ws + WS_SSQ); const float* rope = (const float*)(ws + WS_ROPE); bf16* xb = (bf16*)(ws + WS_XB);
        {
            const int q = ph - 1, k = q % 6, lg = q / 6, l = lg / NGRP, g = lg % NGRP, grow0 = g * MG;
            const unsigned char* wl = ws + WS_W + (size_t)l * WL_STRIDE;
            if (k == 0 && (PHMASK & 1)) {
                pg8::Gemm gm{xb + (size_t)grow0 * D, (const bf16*)(wl + WL_WIN), MG, DIN, D, D}; pg8::StaticOrder S; S.init(MG, DIN, G, (int)blockIdx.x);
                pg8::EpiP1 E{act, ssq, rope, grow0};
                pg8::gemm_phase<pg8::EpiP1, pg8::StaticOrder, true, true>(ring, gm, S, E);
            } else if (k == 1) {
                #if RET_NAIVE
                naive_ret_phase(act, lds); __syncthreads();
#else
                sba::ret_phase(act, (char*)lds);
#endif
                sba::sb_phase(act, (char*)lds);
            } else if (k == 2 && (PHMASK & 2)) {
                pg8::Gemm gm{(const bf16*)(act + A_GS), (const bf16*)(wl + WL_PCAT), MG, D, 2 * D, D}; pg8::ChainOrder S; S.init(MG, D, G, (int)blockIdx.x); S.kh = D;
                pg8::EpiP3 E{act};
                pg8::gemm_phase<pg8::EpiP3, pg8::ChainOrder, true, true>(ring, gm, S, E);
            } else if (k == 3 && (PHMASK & 4)) {
                pg8::Gemm gm{(const bf16*)(act + A_MERGED), (const bf16*)(wl + WL_WOUT), MG, D, D, D}; pg8::StaticOrder S; S.init(MG, D, G, (int)blockIdx.x);
                pg8::EpiX E{outp, xb, ssq, grow0};
                pg8::gemm_phase<pg8::EpiX, pg8::StaticOrder, true, true>(ring, gm, S, E);
            } else if (k == 4 && (PHMASK & 8)) {
                pg8::Gemm gm{xb + (size_t)grow0 * D, (const bf16*)(wl + WL_WUP), MG, DFF, D, D}; pg8::StaticOrder S; S.init(MG, DFF, G, (int)blockIdx.x);
                pg8::EpiP5 E{act, ssq, grow0};
                pg8::gemm_phase<pg8::EpiP5, pg8::StaticOrder, true, true>(ring, gm, S, E);
            } else if (k == 5 && (PHMASK & 16)) {
                pg8::Gemm gm{(const bf16*)(act + A_UP), (const bf16*)(wl + WL_WDN), MG, D, DFF, DFF}; pg8::StaticOrder S; S.init(MG, D, G, (int)blockIdx.x);
                pg8::EpiX E{outp, xb, ssq, grow0};
                pg8::gemm_phase<pg8::EpiX, pg8::StaticOrder, true, true>(ring, gm, S, E);
            }
        }
        if (ph + 1 < ph_hi) GRID_SYNC();
    }
    if (ph_hi > PH_FINAL) final_phase(a);
}

extern "C" void kernel_launch(void* const* d_in, const int* in_sizes, int n_in, void* d_out, int out_size, void* d_ws, size_t ws_size, hipStream_t stream) {
    static int grid = 0;
    if (grid == 0) {
        if (n_in != 10 || in_sizes[0] != M * D || out_size != M * D || ws_size < WS_END) { fprintf(stderr, "kernel_launch: unexpected shapes (n_in %d, ws %zu)\n", n_in, ws_size); grid = -1; return; }
        int dev = 0, cus = 0;
        if (hipGetDevice(&dev) != hipSuccess || hipDeviceGetAttribute(&cus, hipDeviceAttributeMultiprocessorCount, dev) != hipSuccess) { grid = -1; return; }
        if (hipFuncSetAttribute((const void*)mega, hipFuncAttributeMaxDynamicSharedMemorySize, LDS_BYTES) != hipSuccess) { fprintf(stderr, "kernel_launch: hipFuncSetAttribute failed\n"); grid = -1; return; }
        int per_cu = 0;
        if (hipOccupancyMaxActiveBlocksPerMultiprocessor(&per_cu, (const void*)mega, NWAVES * 64, LDS_BYTES) != hipSuccess || per_cu < 1) { fprintf(stderr, "kernel_launch: occupancy query says %d blocks per CU\n", per_cu); (void)hipGetLastError(); per_cu = 1; }
        grid = cus;
    }
    if (grid < 0) return;
    Args a{};
    for (int i = 0; i < 10; ++i) a.in[i] = (const float*)d_in[i];
    a.out = (float*)d_out; a.ws = (unsigned char*)d_ws;
#if MK_ONE_LAUNCH
    if (hipMemsetAsync((char*)d_ws + WS_CTL, 0, CTL_ZERO_BYTES, stream) != hipSuccess) { fprintf(stderr, "kernel_launch: hipMemsetAsync failed\n"); return; }
    a.ph_lo = 0; a.ph_hi = PH_FINAL + 1;
    void* kargs[] = {&a};
    const hipError_t le = hipLaunchCooperativeKernel((const void*)mega, dim3(grid), dim3(NWAVES * 64), kargs, LDS_BYTES, stream);
    if (le != hipSuccess) fprintf(stderr, "kernel_launch: cooperative launch failed: %s (grid %d)\n", hipGetErrorString(le), grid);
#else
    auto run = [&](int lo, int hi) { a.ph_lo = lo; a.ph_hi = hi; hipLaunchKernelGGL(mega, dim3(grid), dim3(NWAVES * 64), LDS_BYTES, stream, a); };
    for (int p = 0; p <= PH_FINAL; ++p) run(p, p + 1);
#endif
}
```

```cpp
#include <hip/hip_runtime.h>
#include <hip/hip_cooperative_groups.h>
#include <cstdio>
#include <cstdint>
namespace cg = cooperative_groups;

constexpr int D = 1024, BATCH = 16, SEQ = 2048, DEPTH = 4, M = BATCH * SEQ;
constexpr int DIN = 8192, DFF = 4096;
constexpr int NGRP = 2, BG = BATCH / NGRP, MG = BG * SEQ;
constexpr float NORM_EPS = 1e-6f, GN_EPS = 1e-5f;
constexpr float LOG2E = 1.4426950408889634f, LN2 = 0.6931471805599453f;
constexpr float QS_SCALE = 0.08838834764831845f * LOG2E;
constexpr float KR_SCALE = 0.08838834764831845f;
constexpr float LG2_GAMMA0 = -0.045803689613124954f, LG2_GAMMA1 = -0.022720076500083545f, LG2_GAMMA2 = -0.011315313227834146f, LG2_GAMMA3 = -0.005646563141142062f;

#ifndef PROBE_K
#define PROBE_K (-1)
#endif
#ifndef TIME_K
#define TIME_K (-1)
#endif
#define TSTAMP(type) do { if (TIME_K >= 0 && blockIdx.x == 0 && threadIdx.x == 0) { const unsigned long long t_ = __builtin_amdgcn_s_memrealtime(); \
    const unsigned long long p_ = ((unsigned long long)MISCT[3] << 32) | MISCT[2]; if ((type) == TIME_K) MISCT[4] += (unsigned)(t_ - p_); MISCT[2] = (unsigned)t_; MISCT[3] = (unsigned)(t_ >> 32); } } while (0)
typedef unsigned short bf16;
constexpr size_t MiB = 1u << 20;
constexpr size_t WS_CTL = 0;
constexpr size_t WS_ROPE = 1 * MiB;
constexpr size_t WS_SSQ = 2 * MiB;
constexpr size_t WS_XB = 4 * MiB;
constexpr size_t WS_W = 68 * MiB;
constexpr size_t WL_WIN = 0, WL_PCAT = 16 * MiB, WL_WOUT = 20 * MiB, WL_WUP = 22 * MiB, WL_WDN = 30 * MiB;
constexpr size_t WS_GS = 106 * MiB;
constexpr size_t WS_GA = 234 * MiB;
constexpr size_t WS_GB = 298 * MiB;
constexpr size_t WS_SCR = 362 * MiB;
constexpr size_t S_RQK = 0, S_RV = 32 * MiB, S_SK = 64 * MiB, S_SV = 96 * MiB;
constexpr size_t WS_MERGED = WS_SCR, WS_UP = WS_GS;
constexpr size_t WS_END = 490 * MiB;

__device__ __forceinline__ unsigned f2bf(float f) { unsigned u = __builtin_bit_cast(unsigned, f); return (u + 0x7fffu + ((u >> 16) & 1u)) >> 16; }
__device__ __forceinline__ float bf2f(unsigned h) { return __builtin_bit_cast(float, h << 16); }
__device__ __forceinline__ unsigned pk2(float lo, float hi) { return f2bf(lo) | (f2bf(hi) << 16); }

namespace pg8 {
#define PG8_LAS __attribute__((address_space(3)))
typedef unsigned short bf16_t;
typedef short bf16x8 __attribute__((ext_vector_type(8)));
typedef float f32x4 __attribute__((ext_vector_type(4)));
typedef unsigned u32x4 __attribute__((ext_vector_type(4)));
constexpr int BM = 256, BK = 64, HALF = 128, HTB = HALF * BK * 2  , STAGE_BYTES = 8 * HTB, NXCD = 8, WGM = 8;

__host__ __device__ __forceinline__ int lds_byte(int r, int c) { const int st = (r >> 4) * 2 + (c >> 5), rr = r & 15, cc = c & 31, ob = rr * 64 + cc * 2; return st * 1024 + (ob ^ (((ob >> 9) & 1) << 5)); }
__host__ __device__ __forceinline__ void stage_rc(int b, int& R, int& C) { const int st = b / 1024, sb = b % 1024, swz = sb ^ (((sb >> 9) & 1) << 5); R = (st >> 1) * 16 + swz / 64; C = (st & 1) * 32 + (swz % 64) / 2; }
__host__ __device__ __forceinline__ int perm32(int rho) { const int n = rho >> 4, i = rho & 15; return 8 * (i >> 2) + 4 * n + (i & 3); }

struct Unit { int pm, pn, kofs; };
struct Gemm { const bf16_t* A; const bf16_t* Bt; int M, N, K, Kloop; };

struct StaticOrder {
    int nM, nN, nwg, G, c;
    __host__ __device__ void init(int M, int N, int G_, int c_) { nM = M / BM; nN = N / BM; nwg = nM * nN; G = G_; c = c_; }
    __host__ __device__ bool next(int i, Unit& u) const {
        const long L = (long)i * G + c; if (L >= nwg) return false;
        int wgid = (int)L; { const int q = nwg / NXCD, r = nwg % NXCD, xcd = wgid % NXCD, off = wgid / NXCD; wgid = (xcd < r ? xcd * (q + 1) : r * (q + 1) + (xcd - r) * q) + off; }
        const int nig = WGM * nN, gid = wgid / nig, fm = gid * WGM, gsz = (nM - fm) < WGM ? (nM - fm) : WGM;
        u.pm = fm + ((wgid % nig) % gsz); u.pn = (wgid % nig) / gsz; u.kofs = 0; return true;
    }
    __device__ __forceinline__ void a_ready(const Unit&) const {}
    __device__ __forceinline__ void done(const Unit&) const {}
};
struct ChainOrder : StaticOrder {
    int kh;
    __host__ __device__ bool next(int i, Unit& u) const { if (!StaticOrder::next(i >> 1, u)) return false; u.kofs = (i & 1) * kh; return true; }
};


typedef unsigned u32x2 __attribute__((ext_vector_type(2)));
__device__ __forceinline__ unsigned cvt_pk_bf16(float lo, float hi) { unsigned r; asm volatile("v_cvt_pk_bf16_f32 %0, %1, %2" : "=v"(r) : "v"(lo), "v"(hi)); return r; }
__device__ __forceinline__ u32x2 pack4(const f32x4 v) { u32x2 w; w.x = cvt_pk_bf16(v[0], v[1]); w.y = cvt_pk_bf16(v[2], v[3]); return w; }
__device__ __forceinline__ u32x4 pack8(const f32x4 a, const f32x4 b) { u32x4 w; w.x = cvt_pk_bf16(a[0], a[1]); w.y = cvt_pk_bf16(a[2], a[3]); w.z = cvt_pk_bf16(b[0], b[1]); w.w = cvt_pk_bf16(b[2], b[3]); return w; }
__device__ __forceinline__ f32x4 unpack_lo(const u32x4 w) { f32x4 r; r[0] = __builtin_bit_cast(float, w.x << 16); r[1] = __builtin_bit_cast(float, w.x & 0xffff0000u); r[2] = __builtin_bit_cast(float, w.y << 16); r[3] = __builtin_bit_cast(float, w.y & 0xffff0000u); return r; }
__device__ __forceinline__ f32x4 unpack_hi(const u32x4 w) { f32x4 r; r[0] = __builtin_bit_cast(float, w.z << 16); r[1] = __builtin_bit_cast(float, w.z & 0xffff0000u); r[2] = __builtin_bit_cast(float, w.w << 16); r[3] = __builtin_bit_cast(float, w.w & 0xffff0000u); return r; }
__device__ __forceinline__ float row_rstd(const char* ub, unsigned lo) {
    const f32x4* p = (const f32x4*)(ub + lo);
    const f32x4 a = p[0], b = p[1], c = p[2], d = p[3];
    const float s = (((a[0] + a[1]) + (a[2] + a[3])) + ((b[0] + b[1]) + (b[2] + b[3]))) + (((c[0] + c[1]) + (c[2] + c[3])) + ((d[0] + d[1]) + (d[2] + d[3])));
    return rsqrtf(s * (1.0f / 1024.0f) + NORM_EPS);
}
__device__ __forceinline__ f32x4 exp4(const f32x4 v) { f32x4 r; r[0] = __expf(v[0]); r[1] = __expf(v[1]); r[2] = __expf(v[2]); r[3] = __expf(v[3]); return r; }
__device__ __forceinline__ f32x4 rcp4(const f32x4 v) { f32x4 r; r[0] = __builtin_amdgcn_rcpf(v[0]); r[1] = __builtin_amdgcn_rcpf(v[1]); r[2] = __builtin_amdgcn_rcpf(v[2]); r[3] = __builtin_amdgcn_rcpf(v[3]); return r; }

__device__ __forceinline__ void panel_rstd(PG8_LAS float* rst, const float* ssq, int grow0, int pmA, int pmB) {
    int tid = threadIdx.x; asm volatile("" : "+v"(tid));
    const int pm = (tid < 256) ? pmA : pmB;
    rst[tid] = row_rstd((const char*)ssq + (size_t)(grow0 + pm * BM) * 64, (unsigned)(tid & 255) * 64u);
    __syncthreads();
}
struct EpiP1 {
    static constexpr bool PERM = false, AFTER_DRAIN = false, MID = false, PRELOAD = false; static constexpr bool SLACK = true;
    __device__ __forceinline__ bool slack_ok() const { return (PROBE_K < 0) || !dry; }
    unsigned char* ws; const float* rope; int grow0; bool dry; const PG8_LAS float* rst;
    __device__ __forceinline__ void mid(f32x4 (&)[2][2][4][2], const Unit&, int, int, int, int) const {}
    __device__ __forceinline__ void operator()(const f32x4 (&acc)[2][2][4][2], const Unit& u, int wr, int wc, int fr, int fq) const {
        if (dry) return;
        const int pn = u.pn, rlu = u.pm * BM + wr * 64;
        unsigned lf = (unsigned)fr, lq = (unsigned)fq; asm volatile("" : "+v"(lf), "+v"(lq));
        float rs[2][4];
#pragma unroll
        for (int ai = 0; ai < 2; ++ai)
#pragma unroll
            for (int m = 0; m < 4; ++m) rs[ai][m] = rst[wr * 64 + ai * HALF + m * 16 + lf];
        if (pn < 4) {
            const unsigned j0 = 16 * wc + 4 * lq;
            char* ub = (char*)(ws + WS_SCR + S_RQK) + ((size_t)rlu * 1024 + (pn >> 1) * 512 + (pn & 1) * 256) * 2;
            const unsigned lo = (lf * 1024u + j0) * 2u;
            const int pos0 = (grow0 + rlu) & (SEQ - 1);
            const char* rp = (const char*)rope + (size_t)pos0 * 256;
            const float sg = (pn < 2) ? 1.0f : -1.0f;
            const float lgA0 = sg * LG2_GAMMA0, lgA1 = sg * LG2_GAMMA1, lgB0 = sg * LG2_GAMMA2, lgB1 = sg * LG2_GAMMA3;
            const unsigned rlo = lf * 256u + j0 * 4u;
            f32x4 csv[2][4], snv[2][4];
#pragma unroll
            for (int ai = 0; ai < 2; ++ai)
#pragma unroll
                for (int m = 0; m < 4; ++m) { csv[ai][m] = *(const f32x4*)(rp + (ai * HALF + m * 16) * 256 + rlo); snv[ai][m] = *(const f32x4*)(rp + SEQ * 256 + (ai * HALF + m * 16) * 256 + rlo); }
            asm volatile("" ::: "memory");
#pragma unroll
            for (int ai = 0; ai < 2; ++ai)
#pragma unroll
                for (int m = 0; m < 4; ++m) {
                    const f32x4 cs = csv[ai][m], sn = snv[ai][m];
                    const float posf = (float)(pos0 + ai * HALF + m * 16) + (float)lf;
#pragma unroll
                    for (int bj = 0; bj < 2; ++bj) {
                        const float fac = rs[ai][m] * __builtin_amdgcn_exp2f(posf * ((pn & 1) ? (bj ? lgB1 : lgB0) : (bj ? lgA1 : lgA0)));
                        const f32x4 t1 = acc[ai][bj][m][0] * fac, t2 = acc[ai][bj][m][1] * fac;
                        const f32x4 o1 = t1 * cs - t2 * sn, o2 = t1 * sn + t2 * cs;
                        char* d = ub + ((ai * HALF + m * 16) * 1024 + bj * 128) * 2;
                        *(u32x2*)(d + lo) = pack4(o1); *(u32x2*)(d + 128 + lo) = pack4(o2);
                    }
                }
        } else if (pn < 24) {
            char* ub; int pitch; bool silu = false;
            if (pn < 8) { ub = (char*)(ws + WS_SCR + S_RV) + (pn - 4) * 512; pitch = 2048; }
            else if (pn < 12) { ub = (char*)(ws + WS_GS) + (size_t)grow0 * 4096 + (pn - 8) * 512; pitch = 4096; silu = true; }
            else if (pn < 16) { ub = (char*)(ws + WS_GS) + (size_t)grow0 * 4096 + 2048 + (pn - 12) * 512; pitch = 4096; }
            else if (pn < 20) { ub = (char*)(ws + WS_SCR + S_SK) + (pn - 16) * 512; pitch = 2048; }
            else { ub = (char*)(ws + WS_SCR + S_SV) + (pn - 20) * 512; pitch = 2048; }
            ub += (size_t)rlu * pitch;
            const unsigned lo = lf * (unsigned)pitch + ((unsigned)(wc * 32) + 8u * lq) * 2u;
#pragma unroll
            for (int ai = 0; ai < 2; ++ai)
#pragma unroll
                for (int m = 0; m < 4; ++m) {
                    char* rowp = ub + (size_t)(ai * HALF + m * 16) * pitch;
#pragma unroll
                    for (int bj = 0; bj < 2; ++bj) {
                        f32x4 v0 = acc[ai][bj][m][0] * rs[ai][m], v1 = acc[ai][bj][m][1] * rs[ai][m];
                        if (silu) { v0 = v0 * rcp4(exp4(-v0) + 1.0f); v1 = v1 * rcp4(exp4(-v1) + 1.0f); }
                        *(u32x4*)(rowp + bj * 256 + lo) = pack8(v0, v1);
                    }
                }
        } else {
            const size_t uo = ((size_t)rlu * 1024 + 128 * (pn - 24)) * 2;
            char* ga = (char*)(ws + WS_GA) + (size_t)grow0 * 2048 + uo; char* gb = (char*)(ws + WS_GB) + (size_t)grow0 * 2048 + uo;
            const unsigned lo = (lf * 1024u + (unsigned)(32 * wc) + 8u * lq) * 2u;
#pragma unroll
            for (int ai = 0; ai < 2; ++ai)
#pragma unroll
                for (int m = 0; m < 4; ++m) {
                    f32x4 ra[2], sb[2];
#pragma unroll
                    for (int n = 0; n < 2; ++n) {
                        const f32x4 ea = exp4(-(acc[ai][0][m][n] * rs[ai][m])) + 1.0f, eb = exp4(-(acc[ai][1][m][n] * rs[ai][m])) + 1.0f;
                        const f32x4 t = rcp4(ea * eb); sb[n] = t * ea; ra[n] = (t * eb) * eb;
                    }
                    *(u32x4*)(ga + (ai * HALF + m * 16) * 2048 + lo) = pack8(ra[0], ra[1]);
                    *(u32x4*)(gb + (ai * HALF + m * 16) * 2048 + lo) = pack8(sb[0], sb[1]);
                }
        }
    }
};
struct EpiP3 {
    static constexpr bool PERM = false, AFTER_DRAIN = false, MID = true, PRELOAD = false; static constexpr bool SLACK = false;
    __device__ __forceinline__ bool slack_ok() const { return false; }
    unsigned char* ws; bool dry;
    __device__ __forceinline__ void mid(f32x4 (&acc)[2][2][4][2], const Unit& u, int wr, int wc, int fr, int fq) const {
        const char* g = (const char*)(ws + WS_GA) + ((size_t)(u.pm * BM + wr * 64) * 1024 + u.pn * BM) * 2;
        unsigned lo = ((unsigned)fr * 1024u + (unsigned)(wc * 32 + 8 * fq)) * 2u; asm volatile("" : "+v"(lo));
        u32x4 w[2][4][2];
#pragma unroll
        for (int ai = 0; ai < 2; ++ai)
#pragma unroll
            for (int m = 0; m < 4; ++m)
#pragma unroll
                for (int bj = 0; bj < 2; ++bj) w[ai][m][bj] = *(const u32x4*)(g + ((ai * HALF + m * 16) * 2048 + bj * 256) + lo);
        asm volatile("" ::: "memory");
#pragma unroll
        for (int ai = 0; ai < 2; ++ai)
#pragma unroll
            for (int m = 0; m < 4; ++m)
#pragma unroll
                for (int bj = 0; bj < 2; ++bj) { acc[ai][bj][m][0] *= unpack_lo(w[ai][m][bj]); acc[ai][bj][m][1] *= unpack_hi(w[ai][m][bj]); }
    }
    __device__ __forceinline__ void operator()(const f32x4 (&acc)[2][2][4][2], const Unit& u, int wr, int wc, int fr, int fq) const {
        if (dry) return;
        const size_t uo = ((size_t)(u.pm * BM + wr * 64) * 1024 + u.pn * BM) * 2;
        const char* g = (const char*)(ws + WS_GB) + uo; char* o = (char*)(ws + WS_MERGED) + uo;
        unsigned lo = ((unsigned)fr * 1024u + (unsigned)(wc * 32 + 8 * fq)) * 2u; asm volatile("" : "+v"(lo));
        u32x4 w[2][4][2];
#pragma unroll
        for (int ai = 0; ai < 2; ++ai)
#pragma unroll
            for (int m = 0; m < 4; ++m)
#pragma unroll
                for (int bj = 0; bj < 2; ++bj) w[ai][m][bj] = *(const u32x4*)(g + ((ai * HALF + m * 16) * 2048 + bj * 256) + lo);
        asm volatile("" ::: "memory");
#pragma unroll
        for (int ai = 0; ai < 2; ++ai)
#pragma unroll
            for (int m = 0; m < 4; ++m)
#pragma unroll
                for (int bj = 0; bj < 2; ++bj) {
                    const int co = (ai * HALF + m * 16) * 2048 + bj * 256;
                    *(u32x4*)(o + co + lo) = pack8(acc[ai][bj][m][0] * unpack_lo(w[ai][m][bj]), acc[ai][bj][m][1] * unpack_hi(w[ai][m][bj]));
                }
    }
};
struct EpiX {
    static constexpr bool PERM = false, AFTER_DRAIN = false, MID = false, PRELOAD = true; static constexpr bool SLACK = false;
    __device__ __forceinline__ bool slack_ok() const { return false; }
    float* out; bf16_t* xb; float* ssq; int grow0; bool dry; bool feed;
    __device__ __forceinline__ void mid(f32x4 (&)[2][2][4][2], const Unit&, int, int, int, int) const {}
    __device__ __forceinline__ void preload(f32x4 (&acc)[2][2][4][2], const Unit& u, int wr, int wc, int fr, int fq) const {
        const size_t Ru = (size_t)(grow0 + u.pm * BM + wr * 64), cu = (size_t)(u.pn * BM + wc * 32);
        const char* xi = (const char*)out + (Ru * D + cu) * 4;
        unsigned lo4 = ((unsigned)fr * 1024u + 4u * (unsigned)fq) * 4u; asm volatile("" : "+v"(lo4));
#pragma unroll
        for (int ai = 0; ai < 2; ++ai)
#pragma unroll
            for (int m = 0; m < 4; ++m)
#pragma unroll
                for (int bj = 0; bj < 2; ++bj)
#pragma unroll
                    for (int n = 0; n < 2; ++n) acc[ai][bj][m][n] = *(const f32x4*)(xi + ((ai * HALF + m * 16) * 1024 + bj * HALF + n * 16) * 4 + lo4);
    }
    __device__ __forceinline__ void operator()(const f32x4 (&acc)[2][2][4][2], const Unit& u, int wr, int wc, int fr, int fq) const {
        if (dry) return;
        const size_t Ru = (size_t)(grow0 + u.pm * BM + wr * 64), cu = (size_t)(u.pn * BM + wc * 32);
        char* xo = (char*)out + (Ru * D + cu) * 4; char* xbo = (char*)xb + (Ru * D + cu) * 2; char* sq = (char*)ssq + Ru * 64 + (u.pn * 4 + wc) * 4;
        unsigned lo4 = ((unsigned)fr * 1024u + 4u * (unsigned)fq) * 4u, los = (unsigned)fr * 64u; asm volatile("" : "+v"(lo4), "+v"(los)); const unsigned lo2 = lo4 >> 1;
#pragma unroll
        for (int ai = 0; ai < 2; ++ai)
#pragma unroll
            for (int m = 0; m < 4; ++m) {
                float s = 0.f;
#pragma unroll
                for (int bj = 0; bj < 2; ++bj)
#pragma unroll
                    for (int n = 0; n < 2; ++n) {
                        const int co = (ai * HALF + m * 16) * 1024 + bj * HALF + n * 16;
                        const f32x4 xn = acc[ai][bj][m][n];
                        *(f32x4*)(xo + co * 4 + lo4) = xn; if (feed) *(u32x2*)(xbo + co * 2 + lo2) = pack4(xn);
                        s += (xn[0] * xn[0] + xn[1] * xn[1]) + (xn[2] * xn[2] + xn[3] * xn[3]);
                    }
                s += __shfl_xor(s, 16); s += __shfl_xor(s, 32);
                if (feed && fq == 0) *(float*)(sq + (ai * HALF + m * 16) * 64 + los) = s;
            }
    }
};
struct EpiP5 {
    static constexpr bool PERM = false, AFTER_DRAIN = false, MID = false, PRELOAD = false; static constexpr bool SLACK = true;
    __device__ __forceinline__ bool slack_ok() const { return (PROBE_K < 0) || !dry; }
    unsigned char* ws; bool dry; const PG8_LAS float* rst;
    __device__ __forceinline__ void mid(f32x4 (&)[2][2][4][2], const Unit&, int, int, int, int) const {}
    __device__ __forceinline__ void operator()(const f32x4 (&acc)[2][2][4][2], const Unit& u, int wr, int wc, int fr, int fq) const {
        if (dry) return;
        const int rlu = u.pm * BM + wr * 64;
        char* ub = (char*)(ws + WS_UP) + ((size_t)rlu * DFF + u.pn * BM) * 2; const int ti = (u.pm & WGM) << 5;
        int t_ = threadIdx.x; asm volatile("" : "+v"(t_));
        const unsigned lf = (unsigned)t_ & 15u, lo = (lf * (unsigned)DFF + (unsigned)(wc * 32) + 8u * (((unsigned)t_ >> 4) & 3u)) * 2u;
#pragma unroll
        for (int ai = 0; ai < 2; ++ai)
#pragma unroll
            for (int m = 0; m < 4; ++m) {
                const float rsv = rst[ti + wr * 64 + ai * HALF + m * 16 + lf];
#pragma unroll
                for (int bj = 0; bj < 2; ++bj) {
                    f32x4 v0 = acc[ai][bj][m][0] * rsv, v1 = acc[ai][bj][m][1] * rsv;
#pragma unroll
                    for (int e = 0; e < 4; ++e) { const float a = fmaxf(v0[e], 0.f), b = fmaxf(v1[e], 0.f); v0[e] = a * a; v1[e] = b * b; }
                    *(u32x4*)(ub + ((ai * HALF + m * 16) * DFF + bj * HALF) * 2 + lo) = pack8(v0, v1);
                }
            }
    }
};

template <class Epi, class Sched, bool ALIGN_EPI = false, bool SP2 = false>
__device__ __forceinline__ void gemm_phase(PG8_LAS unsigned char* lds, const Gemm g, const Sched& S, const Epi& E) {
    int tid = threadIdx.x; asm volatile("" : "+v"(tid));
    const int wid = __builtin_amdgcn_readfirstlane(tid >> 6), lane = tid & 63, wr = wid >> 2, wc = wid & 3, fr = lane & 15, fq = lane >> 4;
    const int K = g.K, nt = g.Kloop / BK;
    static_assert(!Epi::PERM, "weight rows are permuted by the prologue");
    unsigned voffA, voffB;
    { int R, C; stage_rc(tid * 16, R, C); voffA = (unsigned)(R * K + C) * 2u; voffB = voffA; }
    const size_t qstep = (size_t)64 * K * 2;
    const size_t kstep = (size_t)(BK * 2);
    const size_t hstep = (size_t)HALF * K * 2;
    const size_t tstep = 2 * hstep;
    const unsigned ldsw = (unsigned)wid * 1024u;
    const int aoff = lds_byte(wr * 64 + fr, fq * 8), boff = lds_byte(wc * 32 + fr, fq * 8);
#define PG8_SA(b, h) (((b) * 2 + (h)) * HTB)
#define PG8_SB(b, h) ((4 + (b) * 2 + (h)) * HTB)
#define PG8_STAGE(bufoff, gbase, voff) do { _Pragma("unroll") for (int _i = 0; _i < 2; ++_i) \
        __builtin_amdgcn_global_load_lds((const unsigned*)((const char*)(gbase) + _i * qstep + (voff)), (PG8_LAS unsigned*)(lds + (bufoff) + ldsw + _i * 8192), 16, 0, 0); } while (0)
#define PG8_LDA(dst, b, h) do { _Pragma("unroll") for (int m = 0; m < 4; ++m) _Pragma("unroll") for (int k = 0; k < 2; ++k) dst[m][k] = *(const PG8_LAS bf16x8*)(lds + PG8_SA(b, h) + aoff + m * 2048 + k * 1024); } while (0)
#define PG8_LDB(dst, b, h) do { _Pragma("unroll") for (int n = 0; n < 2; ++n) _Pragma("unroll") for (int k = 0; k < 2; ++k) dst[n][k] = *(const PG8_LAS bf16x8*)(lds + PG8_SB(b, h) + boff + n * 2048 + k * 1024); } while (0)
#define PG8_MMA(ai, bj, At, Bt) do { __builtin_amdgcn_s_setprio(1); _Pragma("unroll") for (int m = 0; m < 4; ++m) _Pragma("unroll") for (int n = 0; n < 2; ++n) _Pragma("unroll") for (int k = 0; k < 2; ++k) \
        acc[ai][bj][m][n] = __builtin_amdgcn_mfma_f32_16x16x32_bf16(Bt[n][k], At[m][k], acc[ai][bj][m][n], 0, 0, 0); __builtin_amdgcn_s_setprio(0); } while (0)
#define PG8_WAIT_V(n) asm volatile("s_waitcnt vmcnt(" #n ")" ::: "memory")
#define PG8_WAIT_L(n) asm volatile("s_waitcnt lgkmcnt(" #n ")" ::: "memory")
#define PG8_BAR __builtin_amdgcn_s_barrier()
#define PG8_SCHED __builtin_amdgcn_sched_barrier(0)
    Unit cur, nxt; int ui = 0;
    if (!S.next(0, cur)) return;
    f32x4 acc[2][2][4][2];
#pragma unroll
    for (int a = 0; a < 2; ++a)
#pragma unroll
        for (int b = 0; b < 2; ++b)
#pragma unroll
            for (int m = 0; m < 4; ++m)
#pragma unroll
                for (int n = 0; n < 2; ++n) acc[a][b][m][n] = (f32x4){0.f, 0.f, 0.f, 0.f};
    bf16x8 At[4][2], B0[2][2], B1[2][2];
    const char* cA = (const char*)g.A + (size_t)cur.pm * tstep + (size_t)cur.kofs * 2; const char* cB = (const char*)g.Bt + (size_t)cur.pn * tstep + (size_t)cur.kofs * 2;
    S.a_ready(cur);
    if constexpr (SP2) {
        PG8_STAGE(PG8_SB(0, 0), cB, voffB); PG8_STAGE(PG8_SB(0, 1), cB + hstep, voffB); PG8_STAGE(PG8_SA(0, 0), cA, voffA); PG8_STAGE(PG8_SA(0, 1), cA + hstep, voffA);
        if (wr == 1) PG8_BAR;
        PG8_WAIT_V(2); PG8_BAR;
        PG8_STAGE(PG8_SB(1, 0), cB + kstep, voffB); PG8_STAGE(PG8_SA(1, 0), cA + kstep, voffA); PG8_STAGE(PG8_SB(1, 1), cB + hstep + kstep, voffB);
        PG8_WAIT_V(6); PG8_BAR;
    } else {
        PG8_STAGE(PG8_SB(0, 0), cB, voffB); PG8_STAGE(PG8_SA(0, 0), cA, voffA); PG8_STAGE(PG8_SB(0, 1), cB + hstep, voffB); PG8_STAGE(PG8_SA(0, 1), cA + hstep, voffA);
        if (wr == 1) PG8_BAR;
        PG8_WAIT_V(4); PG8_BAR;
        PG8_STAGE(PG8_SB(1, 0), cB + kstep, voffB); PG8_STAGE(PG8_SA(1, 0), cA + kstep, voffA); PG8_STAGE(PG8_SB(1, 1), cB + hstep + kstep, voffB);
        PG8_WAIT_V(6); PG8_BAR;
    }
    if constexpr (Epi::PRELOAD) E.preload(acc, cur, wr, wc, fr, fq);
    for (;;) {
        const bool has_next = S.next(ui + 1, nxt);
        const char* nA = has_next ? (const char*)g.A + (size_t)nxt.pm * tstep + (size_t)nxt.kofs * 2 : cA; const char* nB = has_next ? (const char*)g.Bt + (size_t)nxt.pn * tstep + (size_t)nxt.kofs * 2 : cB;
        int t = 0;
#define PG8_SP2_TRIP(ST11, W1, W2, W3) do { \
            PG8_LDB(B0, 0, 0); PG8_LDB(B1, 0, 1); PG8_SCHED; PG8_LDA(At, 0, 0); if (ST11) PG8_STAGE(PG8_SA(1, 1), a1 + hstep, voffA); \
            PG8_WAIT_V(W1); PG8_WAIT_L(0); PG8_BAR; PG8_MMA(0, 0, At, B0); PG8_MMA(0, 1, At, B1); PG8_BAR; PG8_SCHED; \
            PG8_LDA(At, 0, 1); PG8_STAGE(PG8_SB(0, 0), b2, voffB); PG8_STAGE(PG8_SB(0, 1), b2 + hstep, voffB); PG8_STAGE(PG8_SA(0, 0), a2, voffA); \
            PG8_WAIT_V(W2); PG8_WAIT_L(0); PG8_BAR; PG8_MMA(1, 0, At, B0); PG8_MMA(1, 1, At, B1); PG8_BAR; PG8_SCHED; \
            PG8_LDB(B0, 1, 0); PG8_LDB(B1, 1, 1); PG8_SCHED; PG8_LDA(At, 1, 0); PG8_STAGE(PG8_SA(0, 1), a2 + hstep, voffA); \
            PG8_WAIT_V(W3); PG8_WAIT_L(0); PG8_BAR; PG8_MMA(0, 0, At, B0); PG8_MMA(0, 1, At, B1); PG8_BAR; PG8_SCHED; \
            PG8_LDA(At, 1, 1); PG8_STAGE(PG8_SB(1, 0), b3, voffB); PG8_STAGE(PG8_SB(1, 1), b3 + hstep, voffB); PG8_STAGE(PG8_SA(1, 0), a3, voffA); \
            PG8_WAIT_V(8); PG8_WAIT_L(0); PG8_BAR; PG8_MMA(1, 0, At, B0); PG8_MMA(1, 1, At, B1); PG8_BAR; PG8_SCHED; } while (0)
        if constexpr (SP2 && ALIGN_EPI && Epi::SLACK) {
            if (ui > 0 && E.slack_ok()) {
                const char* a1 = cA + kstep; const char* a2 = cA + 2 * kstep; const char* b2 = cB + 2 * kstep; const char* a3 = a2 + kstep; const char* b3 = b2 + kstep;
                PG8_SP2_TRIP(false, 24, 24, 24);
                t = 2;
            }
        }
        for (; t < nt; t += 2) {
            const bool last = (t == nt - 2);
            const char* a1 = cA + (size_t)(t + 1) * kstep;
            const char* a2 = last ? nA : cA + (size_t)(t + 2) * kstep; const char* b2 = last ? nB : cB + (size_t)(t + 2) * kstep;
            const char* a3 = a2 + kstep; const char* b3 = b2 + kstep;
            if (last && has_next) S.a_ready(nxt);
            if constexpr (SP2) {
            PG8_SP2_TRIP(true, 8, 8, 8);
            } else {
            PG8_LDB(B0, 0, 0); PG8_SCHED; PG8_LDA(At, 0, 0); PG8_STAGE(PG8_SA(1, 1), a1 + hstep, voffA);
            PG8_WAIT_L(8); PG8_BAR; PG8_WAIT_L(0); PG8_MMA(0, 0, At, B0); PG8_BAR; PG8_SCHED;
            PG8_LDB(B1, 0, 1); PG8_STAGE(PG8_SB(0, 0), b2, voffB);
            PG8_BAR; PG8_WAIT_L(0); PG8_MMA(0, 1, At, B1); PG8_BAR;
            PG8_LDA(At, 0, 1); PG8_STAGE(PG8_SA(0, 0), a2, voffA);
            PG8_BAR; PG8_WAIT_L(0); PG8_MMA(1, 0, At, B0); PG8_BAR; PG8_SCHED;
            PG8_STAGE(PG8_SB(0, 1), b2 + hstep, voffB);
            PG8_WAIT_V(6); PG8_BAR; PG8_MMA(1, 1, At, B1); PG8_BAR;
            PG8_LDB(B0, 1, 0); PG8_SCHED; PG8_LDA(At, 1, 0); PG8_STAGE(PG8_SA(0, 1), a2 + hstep, voffA);
            PG8_WAIT_L(8); PG8_BAR; PG8_WAIT_L(0); PG8_MMA(0, 0, At, B0); PG8_BAR; PG8_SCHED;
            PG8_LDB(B1, 1, 1); PG8_STAGE(PG8_SB(1, 0), b3, voffB);
            PG8_BAR; PG8_WAIT_L(0); PG8_MMA(0, 1, At, B1); PG8_BAR;
            PG8_LDA(At, 1, 1); PG8_STAGE(PG8_SA(1, 0), a3, voffA);
            PG8_BAR; PG8_WAIT_L(0); PG8_MMA(1, 0, At, B0); PG8_BAR; PG8_SCHED;
            PG8_STAGE(PG8_SB(1, 1), b3 + hstep, voffB);
            PG8_WAIT_V(6); PG8_BAR; PG8_MMA(1, 1, At, B1); PG8_BAR;
            }
        }
        if constexpr (ALIGN_EPI) { if (wr == 0) PG8_BAR; }
        if constexpr (SP2 && ALIGN_EPI && Epi::SLACK) { if (has_next && E.slack_ok()) PG8_STAGE(PG8_SA(1, 1), nA + kstep + hstep, voffA); }
        bool chain_first = false;
        if constexpr (Epi::MID) { chain_first = (cur.kofs == 0); }
        if constexpr (!Epi::AFTER_DRAIN) { if (chain_first) E.mid(acc, cur, wr, wc, fr, fq); else { E(acc, cur, wr, wc, fr, fq); S.done(cur); } }
        if (!has_next) break;
        if constexpr (Epi::PRELOAD) E.preload(acc, nxt, wr, wc, fr, fq);
        else if (!chain_first)
#pragma unroll
        for (int a = 0; a < 2; ++a)
#pragma unroll
            for (int b = 0; b < 2; ++b)
#pragma unroll
                for (int m = 0; m < 4; ++m)
#pragma unroll
                    for (int n = 0; n < 2; ++n) acc[a][b][m][n] = (f32x4){0.f, 0.f, 0.f, 0.f};
        cur = nxt; cA = nA; cB = nB; ++ui;
        if constexpr (ALIGN_EPI) { if (wr == 1) PG8_BAR; }
    }
    PG8_WAIT_V(0);
    if constexpr (!ALIGN_EPI) { if (wr == 0) PG8_BAR; }
    PG8_BAR;
    if constexpr (Epi::AFTER_DRAIN) { E.fused(acc, cur, wr, wc, fr, fq, lds, wid, lane); S.done(cur); }
#undef PG8_SP2_TRIP
#undef PG8_SA
#undef PG8_SB
#undef PG8_STAGE
#undef PG8_LDA
#undef PG8_LDB
#undef PG8_MMA
#undef PG8_WAIT_V
#undef PG8_WAIT_L
#undef PG8_BAR
#undef PG8_SCHED
}
}

namespace sba {
using bf16x8 = __attribute__((ext_vector_type(8))) short;
using s16x4  = __attribute__((ext_vector_type(4))) short;
using f32x16 = __attribute__((ext_vector_type(16))) float;
using u32x4  = __attribute__((ext_vector_type(4))) unsigned;
typedef _Float16 half8 __attribute__((ext_vector_type(8)));
typedef float f32x4 __attribute__((ext_vector_type(4)));
typedef _Float16 half2v __attribute__((ext_vector_type(2)));
typedef float float2v __attribute__((ext_vector_type(2)));
constexpr int KVBLK = 64;
constexpr int SHM_V = KVBLK * 128 * 2, SHM_K = KVBLK * 128 * 2;
constexpr int OFF_V = 0, OFF_K = 2 * SHM_V, OFF_FLAG = 2 * SHM_V + 2 * SHM_K;
#define KSWZ(row, colB) ((row) * 256 + ((colB) ^ (((row) & 7) << 4)))
#define SBAR() __builtin_amdgcn_sched_barrier(0)
__device__ __forceinline__ int crow(int r, int hi) { return (r & 3) + 8 * (r >> 2) + 4 * hi; }
__device__ __forceinline__ unsigned cvtpk(float lo, float hi) { unsigned r; asm volatile("v_cvt_pk_bf16_f32 %0, %1, %2" : "=v"(r) : "v"(lo), "v"(hi)); return r; }
__device__ __forceinline__ void qkt(f32x16& p0, f32x16& p1, const char* Ks, const bf16x8* qr, int r32, int hi) {
  p0 = f32x16{}; p1 = f32x16{};
#pragma unroll
  for (int d0 = 0; d0 < 8; ++d0) { const int cb = (d0 * 16 + hi * 8) * 2;
    const bf16x8 b0 = *reinterpret_cast<const bf16x8*>(Ks + KSWZ(r32, cb));
    const bf16x8 b1 = *reinterpret_cast<const bf16x8*>(Ks + KSWZ(32 + r32, cb));
    p0 = __builtin_amdgcn_mfma_f32_32x32x16_bf16(b0, qr[d0], p0, 0, 0, 0);
    p1 = __builtin_amdgcn_mfma_f32_32x32x16_bf16(b1, qr[d0], p1, 0, 0, 0); }
}
__device__ __forceinline__ int v_st(int k, int c) { const int kk = (k & ~0xC) | ((k & 4) << 1) | ((k & 8) >> 1); return ((kk >> 3) * 4 + (c >> 5)) * 512 + ((kk & 7) * 32 + (c & 31)) * 2; }
__device__ __forceinline__ int v_rd_base(int lane) { return ((lane & 3) << 3) | (((lane >> 2) & 3) << 6) | (((lane >> 4) & 1) << 5) | (((lane >> 5) & 1) << 8); }
constexpr int v_rd_off(int d0, int ks, int half) { return d0 * 512 + ks * 4096 + half * 2048; }
template <int OFF> __device__ __forceinline__ s16x4 tr_read(int vb) {
  s16x4 r; asm volatile("ds_read_b64_tr_b16 %0, %1 offset:%2" : "=&v"(r) : "v"(vb), "i"(OFF) : "memory"); return r;
}
template <int D0> __device__ __forceinline__ void pv_one(f32x16& od, int vb, bf16x8 pa0, bf16x8 pa1, bf16x8 pa2, bf16x8 pa3) {
  const s16x4 l0 = tr_read<v_rd_off(D0, 0, 0)>(vb), h0 = tr_read<v_rd_off(D0, 0, 1)>(vb), l1 = tr_read<v_rd_off(D0, 1, 0)>(vb), h1 = tr_read<v_rd_off(D0, 1, 1)>(vb);
  const s16x4 l2 = tr_read<v_rd_off(D0, 2, 0)>(vb), h2 = tr_read<v_rd_off(D0, 2, 1)>(vb), l3 = tr_read<v_rd_off(D0, 3, 0)>(vb), h3 = tr_read<v_rd_off(D0, 3, 1)>(vb);
  asm volatile("s_waitcnt lgkmcnt(0)" ::: "memory"); SBAR();
#define PK(L, H) (bf16x8){L[0], L[1], L[2], L[3], H[0], H[1], H[2], H[3]}
  od = __builtin_amdgcn_mfma_f32_32x32x16_bf16(pa0, PK(l0, h0), od, 0, 0, 0);
  od = __builtin_amdgcn_mfma_f32_32x32x16_bf16(pa1, PK(l1, h1), od, 0, 0, 0);
  od = __builtin_amdgcn_mfma_f32_32x32x16_bf16(pa2, PK(l2, h2), od, 0, 0, 0);
  od = __builtin_amdgcn_mfma_f32_32x32x16_bf16(pa3, PK(l3, h3), od, 0, 0, 0);
#undef PK
}
struct VFrag { s16x4 l0, h0, l1, h1, l2, h2, l3, h3; };
template <int OFFB> __device__ __forceinline__ void vf_read(VFrag& f, int vb) {
  f.l0 = tr_read<OFFB + v_rd_off(0, 0, 0)>(vb); f.h0 = tr_read<OFFB + v_rd_off(0, 0, 1)>(vb); f.l1 = tr_read<OFFB + v_rd_off(0, 1, 0)>(vb); f.h1 = tr_read<OFFB + v_rd_off(0, 1, 1)>(vb);
  f.l2 = tr_read<OFFB + v_rd_off(0, 2, 0)>(vb); f.h2 = tr_read<OFFB + v_rd_off(0, 2, 1)>(vb); f.l3 = tr_read<OFFB + v_rd_off(0, 3, 0)>(vb); f.h3 = tr_read<OFFB + v_rd_off(0, 3, 1)>(vb);
}
__device__ __forceinline__ void vf_mma(f32x16& od, const VFrag& f, bf16x8 pa0, bf16x8 pa1, bf16x8 pa2, bf16x8 pa3) {
#define PK(L, H) (bf16x8){L[0], L[1], L[2], L[3], H[0], H[1], H[2], H[3]}
  od = __builtin_amdgcn_mfma_f32_32x32x16_bf16(pa0, PK(f.l0, f.h0), od, 0, 0, 0);
  od = __builtin_amdgcn_mfma_f32_32x32x16_bf16(pa1, PK(f.l1, f.h1), od, 0, 0, 0);
  od = __builtin_amdgcn_mfma_f32_32x32x16_bf16(pa2, PK(f.l2, f.h2), od, 0, 0, 0);
  od = __builtin_amdgcn_mfma_f32_32x32x16_bf16(pa3, PK(f.l3, f.h3), od, 0, 0, 0);
#undef PK
}
#define LGK_WAIT(n) do { asm volatile("s_waitcnt lgkmcnt(" #n ")" ::: "memory"); SBAR(); } while (0)
__device__ __forceinline__ void pv_pipe4(f32x16* o, int vb, bf16x8 pa0, bf16x8 pa1, bf16x8 pa2, bf16x8 pa3) {
  VFrag fa, fb;
  vf_read<0>(fa, vb);
  vf_read<512>(fb, vb);  LGK_WAIT(8); vf_mma(o[0], fa, pa0, pa1, pa2, pa3);
  vf_read<1024>(fa, vb); LGK_WAIT(8); vf_mma(o[1], fb, pa0, pa1, pa2, pa3);
  vf_read<1536>(fb, vb); LGK_WAIT(8); vf_mma(o[2], fa, pa0, pa1, pa2, pa3);
  LGK_WAIT(0); vf_mma(o[3], fb, pa0, pa1, pa2, pa3);
}
__device__ __forceinline__ void pv_pipe8(f32x16* o, int vb, bf16x8 pa0, bf16x8 pa1, bf16x8 pa2, bf16x8 pa3) {
  VFrag fa, fb;
  vf_read<0>(fa, vb);
  vf_read<512>(fb, vb);  LGK_WAIT(8); vf_mma(o[0], fa, pa0, pa1, pa2, pa3);
  vf_read<1024>(fa, vb); LGK_WAIT(8); vf_mma(o[1], fb, pa0, pa1, pa2, pa3);
  vf_read<1536>(fb, vb); LGK_WAIT(8); vf_mma(o[2], fa, pa0, pa1, pa2, pa3);
  vf_read<SHM_V + 0>(fa, vb);    LGK_WAIT(8); vf_mma(o[3], fb, pa0, pa1, pa2, pa3);
  vf_read<SHM_V + 512>(fb, vb);  LGK_WAIT(8); vf_mma(o[4], fa, pa0, pa1, pa2, pa3);
  vf_read<SHM_V + 1024>(fa, vb); LGK_WAIT(8); vf_mma(o[5], fb, pa0, pa1, pa2, pa3);
  vf_read<SHM_V + 1536>(fb, vb); LGK_WAIT(8); vf_mma(o[6], fa, pa0, pa1, pa2, pa3);
  LGK_WAIT(0); vf_mma(o[7], fb, pa0, pa1, pa2, pa3);
}
__device__ __forceinline__ void pv_d0(f32x16* o, int vb, bf16x8 pa0, bf16x8 pa1, bf16x8 pa2, bf16x8 pa3) {
  pv_one<0>(o[0], vb, pa0, pa1, pa2, pa3); pv_one<1>(o[1], vb, pa0, pa1, pa2, pa3); pv_one<2>(o[2], vb, pa0, pa1, pa2, pa3); pv_one<3>(o[3], vb, pa0, pa1, pa2, pa3);
}
__device__ __forceinline__ half8 pack_h8(const f32x16& l, int base) {
  half8 r;
#pragma unroll
  for (int j = 0; j < 8; j += 2) { const float2v f = {l[base + j], l[base + j + 1]}; const half2v hh = __builtin_convertvector(f, half2v); r[j] = hh[0]; r[j + 1] = hh[1]; }
  return r;
}
template <bool BAND>
__device__ __forceinline__ void sb_half(f32x16& p, float& R, const half8 U0, const half8 U1, int kbase, int row_rel, int hi) {
  f32x16 l;
#pragma unroll
  for (int r = 0; r < 16; ++r) {
    const float z = fminf(p[r], 80.0f); p[r] = z;
    float lv = -__builtin_amdgcn_logf(1.0f + __builtin_amdgcn_exp2f(z));
    if (BAND) lv = (kbase + crow(r, hi) < row_rel) ? lv : 0.0f;
    l[r] = lv;
  }
  const half8 lf0 = pack_h8(l, 0), lf1 = pack_h8(l, 8);
  f32x16 E = __builtin_amdgcn_mfma_f32_32x32x16_f16(U0, lf0, f32x16{}, 0, 0, 0);
  E = __builtin_amdgcn_mfma_f32_32x32x16_f16(U1, lf1, E, 0, 0, 0);
#pragma unroll
  for (int r = 0; r < 16; ++r) {
    float w = __builtin_amdgcn_exp2f((p[r] + R) + (l[r] + E[r]));
    if (BAND) w = (kbase + crow(r, hi) < row_rel) ? w : 0.0f;
    p[r] = w;
  }
  const float tot = E[0] + l[0];
  const auto rr = __builtin_amdgcn_permlane32_swap(__float_as_uint(tot), __float_as_uint(tot), false, false);
  R += __uint_as_float(rr[0]);
}
#define PK4(P, BASE, OUT) do { unsigned a0 = cvtpk(P[BASE + 0], P[BASE + 1]), a1 = cvtpk(P[BASE + 2], P[BASE + 3]);   \
    unsigned b0 = cvtpk(P[BASE + 4], P[BASE + 5]), b1 = cvtpk(P[BASE + 6], P[BASE + 7]);                              \
    auto r0 = __builtin_amdgcn_permlane32_swap(a0, b0, false, false); auto r1 = __builtin_amdgcn_permlane32_swap(a1, b1, false, false); \
    u32x4 w = {r0[0], r1[0], r0[1], r1[1]}; OUT = *reinterpret_cast<bf16x8*>(&w); } while (0)

__device__ __forceinline__ void glds16(const void* g, unsigned lds_base) {
  unsigned sv; asm volatile("s_mov_b32 %0, m0\n\ts_mov_b32 m0, %2\n\ts_nop 0\n\tglobal_load_lds_dwordx4 %1, off\n\ts_mov_b32 m0, %0" : "=&s"(sv) : "v"(g), "s"(lds_base) : "memory"); }
#define VM_WAIT(n) do { asm volatile("s_waitcnt vmcnt(" #n ")" ::: "memory"); SBAR(); } while (0)
constexpr int R_SHM_V = 2 * SHM_V, R_OFF_V = 0, R_OFF_K = 2 * R_SHM_V;
__device__ __forceinline__ void ret_unit(int b, int h, int qb, unsigned char* act, int grow0, char* lds, bool dry) {
  int tid = threadIdx.x; asm volatile("" : "+v"(tid));
  const int wid = __builtin_amdgcn_readfirstlane(tid >> 6), lane = tid & 63, r32 = lane & 31, hi = lane >> 5;
  const bf16* RQK = (const bf16*)(act + WS_SCR + S_RQK); const bf16* RV = (const bf16*)(act + WS_SCR + S_RV); bf16* GS = (bf16*)(act + WS_GS) + (size_t)grow0 * 2048;
  char* V_lds = lds + R_OFF_V; char* K_lds = lds + R_OFF_K;
  const int q0 = qb * 256;
  bf16x8 qr[8];
  { const bf16* Qw = RQK + (size_t)(b * SEQ + q0 + wid * 32 + r32) * 1024 + h * 128 + hi * 8;
#pragma unroll
    for (int d0 = 0; d0 < 8; ++d0) qr[d0] = *reinterpret_cast<const bf16x8*>(Qw + d0 * 16); }
  const bf16* Kh = RQK + (size_t)(b * SEQ) * 1024 + 512 + h * 128; const bf16* Vh = RV + (size_t)(b * SEQ) * 1024 + h * 256;
  const int vb0 = (int)(uintptr_t)V_lds + v_rd_base(lane);
  const unsigned lds0 = (unsigned)__builtin_amdgcn_readfirstlane((int)(uintptr_t)lds);
  const int krow = lane >> 4, kch = lane & 15;
  const bf16* ksrcE = Kh + (size_t)(8 * wid + krow) * 1024 + (((kch * 16) ^ (krow << 4)) >> 1);
  const bf16* ksrcO = Kh + (size_t)(8 * wid + 4 + krow) * 1024 + (((kch * 16) ^ ((4 + krow) << 4)) >> 1);
  const int kkv = 8 * wid + ((lane & 31) >> 2), kv = (kkv & ~0xC) | ((kkv & 4) << 1) | ((kkv & 8) >> 1);
  const bf16* vsrc = Vh + (size_t)kv * 1024 + (lane >> 5) * 32 + (lane & 3) * 8;
#define SDMA(k0, bb) do { const size_t ro_ = (size_t)(k0) * 1024; const unsigned kd_ = lds0 + R_OFF_K + (bb) * SHM_K + wid * 2048, vd_ = lds0 + R_OFF_V + (bb) * R_SHM_V + wid * 2048; \
    glds16(ksrcE + ro_, kd_); glds16(ksrcO + ro_, kd_ + 1024); \
    glds16(vsrc + ro_, vd_); glds16(vsrc + ro_ + 64, vd_ + 1024); glds16(vsrc + ro_ + 128, vd_ + SHM_V); glds16(vsrc + ro_ + 192, vd_ + SHM_V + 1024); } while (0)
  f32x16 o[8] = {};
  const int NT = 4 * qb + 4, row_rel = 32 * wid + r32;
  SDMA((NT - 1) * KVBLK, 0);
  VM_WAIT(0); __syncthreads();
  int cur = 0;
  for (int jt = NT - 1; jt >= 0; --jt) {
    const int kb = 64 * (jt - 4 * qb);
    if (jt >= 1) SDMA((jt - 1) * KVBLK, cur ^ 1);
    {
      f32x16 p0, p1; bf16x8 pa0, pa1, pa2, pa3;
      SBAR(); qkt(p0, p1, K_lds + cur * SHM_K, qr, r32, hi);
      if (kb >= 0) {
#pragma unroll
        for (int r = 0; r < 16; ++r) { const int kr = kb + crow(r, hi); p0[r] = (kr <= row_rel) ? p0[r] : 0.0f; p1[r] = (kr + 32 <= row_rel) ? p1[r] : 0.0f; }
      }
      PK4(p0, 0, pa0); PK4(p0, 8, pa1); PK4(p1, 0, pa2); PK4(p1, 8, pa3);
      LGK_WAIT(0); pv_pipe8(o, vb0 + cur * R_SHM_V, pa0, pa1, pa2, pa3);
    }
    VM_WAIT(0);
    __syncthreads();
    cur ^= 1;
  }
#undef SDMA
  { float* stg = (float*)(lds + wid * 16384);
    const int row = lane >> 1, hc = lane & 1;
    f32x4 x[32]; float sm = 0.f, sq = 0.f;
#pragma unroll
    for (int hf = 0; hf < 2; ++hf) {
#pragma unroll
      for (int r = 0; r < 16; ++r) { const int orow = crow(r, hi);
#pragma unroll
        for (int d0 = 0; d0 < 4; ++d0) stg[orow * 128 + d0 * 32 + r32] = o[hf * 4 + d0][r]; }
      asm volatile("s_waitcnt lgkmcnt(0)" ::: "memory");
#pragma unroll
      for (int i = 0; i < 16; ++i) { const f32x4 v = *(const f32x4*)(stg + row * 128 + hc * 64 + i * 4); x[hf * 16 + i] = v;
        sm += (v[0] + v[1]) + (v[2] + v[3]); sq += (v[0] * v[0] + v[1] * v[1]) + (v[2] * v[2] + v[3] * v[3]); }
      asm volatile("s_waitcnt lgkmcnt(0)" ::: "memory");
    }
    sm += __shfl_xor(sm, 1); sq += __shfl_xor(sq, 1);
    const float mean = sm * (1.0f / 256.0f), var = fmaxf(sq * (1.0f / 256.0f) - mean * mean, 0.0f), rstd = rsqrtf(var + GN_EPS);
    bf16* gp = GS + (size_t)(b * SEQ + q0 + wid * 32 + row) * 2048 + h * 256 + hc * 64;
    u32x4 gwv[2][8];
#pragma unroll
    for (int hf = 0; hf < 2; ++hf)
#pragma unroll
      for (int i = 0; i < 8; ++i) gwv[hf][i] = *(const u32x4*)(gp + hf * 128 + i * 8);
    asm volatile("" ::: "memory");
#pragma unroll
    for (int hf = 0; hf < 2; ++hf)
#pragma unroll
      for (int i = 0; i < 8; ++i) {
        bf16* gq = gp + hf * 128 + i * 8;
        const u32x4 gw = gwv[hf][i];
        const f32x4 a = x[hf * 16 + 2 * i], c = x[hf * 16 + 2 * i + 1];
        u32x4 ow;
        ow[0] = cvtpk((a[0] - mean) * rstd * __builtin_bit_cast(float, gw[0] << 16), (a[1] - mean) * rstd * __builtin_bit_cast(float, gw[0] & 0xffff0000u));
        ow[1] = cvtpk((a[2] - mean) * rstd * __builtin_bit_cast(float, gw[1] << 16), (a[3] - mean) * rstd * __builtin_bit_cast(float, gw[1] & 0xffff0000u));
        ow[2] = cvtpk((c[0] - mean) * rstd * __builtin_bit_cast(float, gw[2] << 16), (c[1] - mean) * rstd * __builtin_bit_cast(float, gw[2] & 0xffff0000u));
        ow[3] = cvtpk((c[2] - mean) * rstd * __builtin_bit_cast(float, gw[3] << 16), (c[3] - mean) * rstd * __builtin_bit_cast(float, gw[3] & 0xffff0000u));
        if (!dry) *(u32x4*)gq = ow;
      }
  }
  __syncthreads();
}
__device__ __forceinline__ void ret_phase(unsigned char* act, int grow0, char* lds, bool dry, int bx) {
  const int NU = BG * 4 * 8;
  for (int u = bx; u < NU; u += gridDim.x) {
    const int qb = 7 - u / (NU / 8), bh = u % (NU / 8);
    ret_unit(bh >> 2, bh & 3, qb, act, grow0, lds, dry);
  }
}
template <int D0> __device__ __forceinline__ void pv32_read(s16x4 (&f)[4], int vb) {
  f[0] = tr_read<v_rd_off(D0, 0, 0)>(vb); f[1] = tr_read<v_rd_off(D0, 0, 1)>(vb); f[2] = tr_read<v_rd_off(D0, 1, 0)>(vb); f[3] = tr_read<v_rd_off(D0, 1, 1)>(vb);
}
__device__ __forceinline__ void pv32_mma(f32x16& od, const s16x4 (&f)[4], bf16x8 pa0, bf16x8 pa1) {
  od = __builtin_amdgcn_mfma_f32_32x32x16_bf16(pa0, (bf16x8){f[0][0], f[0][1], f[0][2], f[0][3], f[1][0], f[1][1], f[1][2], f[1][3]}, od, 0, 0, 0);
  od = __builtin_amdgcn_mfma_f32_32x32x16_bf16(pa1, (bf16x8){f[2][0], f[2][1], f[2][2], f[2][3], f[3][0], f[3][1], f[3][2], f[3][3]}, od, 0, 0, 0);
}
__device__ __forceinline__ void sbw_unit(int b, int h, int rb, unsigned char* act, int grow0, char* wlds, bool dry) {
  int tid = threadIdx.x; asm volatile("" : "+v"(tid));
  const int lane = tid & 63, r32 = lane & 31, hi = lane >> 5;
  const bf16* GS = (const bf16*)(act + WS_GS) + (size_t)grow0 * 2048; const bf16* SK = (const bf16*)(act + WS_SCR + S_SK); const bf16* SV = (const bf16*)(act + WS_SCR + S_SV);
  char* K_l = wlds;
  const unsigned k_lds = (unsigned)__builtin_amdgcn_readfirstlane((int)(uintptr_t)wlds), v_lds = k_lds + 8192u;
  const int q0 = rb * 32;
  half8 U0, U1;
#pragma unroll
  for (int j = 0; j < 8; ++j) { const int kp = 8 * (j >> 2) + 4 * hi + (j & 3); U0[j] = (kp > r32) ? (_Float16)1.0f : (_Float16)0.0f; U1[j] = (16 + kp > r32) ? (_Float16)1.0f : (_Float16)0.0f; }
  bf16x8 qr[8];
  { const bf16* Qw = GS + (size_t)(b * SEQ + q0 + r32) * 2048 + 1024 + h * 128 + hi * 8;
#pragma unroll
    for (int d0 = 0; d0 < 8; ++d0) qr[d0] = *reinterpret_cast<const bf16x8*>(Qw + d0 * 16); }
  const bf16* Kh = SK + (size_t)(b * SEQ) * 1024 + h * 128; const bf16* Vh = SV + (size_t)(b * SEQ) * 1024 + h * 128;
  const int krow = lane >> 4, kch = lane & 15;
  const bf16* ksrc0 = Kh + (size_t)krow * 1024 + (((kch * 16) ^ (krow << 4)) >> 1);
  const bf16* ksrc1 = Kh + (size_t)(4 + krow) * 1024 + (((kch * 16) ^ ((4 + krow) << 4)) >> 1);
  const int vkl = (lane & 31) >> 2, vcc = (lane & 3) * 8, vhalf = lane >> 5;
#define KDMA(kt) do { const bf16* s0_ = ksrc0 + (size_t)(kt) * 32 * 1024; const bf16* s1_ = ksrc1 + (size_t)(kt) * 32 * 1024; \
    _Pragma("unroll") for (int q_ = 0; q_ < 4; ++q_) { glds16(s0_ + (size_t)q_ * 8 * 1024, k_lds + q_ * 2048); glds16(s1_ + (size_t)q_ * 8 * 1024, k_lds + q_ * 2048 + 1024); } } while (0)
#define VDMA(kt) do { const bf16* vb_ = Vh + (size_t)(kt) * 32 * 1024 + vcc; \
    _Pragma("unroll") for (int q_ = 0; q_ < 8; ++q_) { const int kk_ = 8 * (q_ >> 1) + vkl, k_ = (kk_ & ~0xC) | ((kk_ & 4) << 1) | ((kk_ & 8) >> 1); \
      glds16(vb_ + (size_t)k_ * 1024 + (2 * (q_ & 1) + vhalf) * 32, v_lds + q_ * 1024); } } while (0)
  const int vb = (int)v_lds + v_rd_base(lane);
  f32x16 o[4] = {}; float R = 0.f;
  KDMA(rb); VDMA(rb);
  for (int kt = rb; kt >= 0; --kt) {
    VM_WAIT(8);
    f32x16 p = {};
#pragma unroll
    for (int d0 = 0; d0 < 8; ++d0) { const bf16x8 kf = *reinterpret_cast<const bf16x8*>(K_l + KSWZ(r32, (d0 * 16 + hi * 8) * 2)); p = __builtin_amdgcn_mfma_f32_32x32x16_bf16(kf, qr[d0], p, 0, 0, 0); }
    LGK_WAIT(0);
    if (kt > 0) KDMA(kt - 1);
    if (kt == rb) sb_half<true>(p, R, U0, U1, 0, r32, hi); else sb_half<false>(p, R, U0, U1, 0, 0, hi);
    bf16x8 pa0, pa1; PK4(p, 0, pa0); PK4(p, 8, pa1);
    if (kt > 0) VM_WAIT(8); else VM_WAIT(0);
    { s16x4 f0[4], f1[4], f2[4], f3[4];
      pv32_read<0>(f0, vb); pv32_read<1>(f1, vb); pv32_read<2>(f2, vb); pv32_read<3>(f3, vb);
      LGK_WAIT(0);
      if (kt > 0) VDMA(kt - 1);
      pv32_mma(o[0], f0, pa0, pa1); pv32_mma(o[1], f1, pa0, pa1); pv32_mma(o[2], f2, pa0, pa1); pv32_mma(o[3], f3, pa0, pa1); }
    if (__all(R < -160.0f)) break;
  }
  VM_WAIT(0);
  { bf16* stg = (bf16*)wlds;
#pragma unroll
    for (int r = 0; r < 16; ++r) { const int orow = crow(r, hi);
#pragma unroll
      for (int d0 = 0; d0 < 4; ++d0) stg[orow * 128 + d0 * 32 + r32] = (bf16)f2bf(o[d0][r]); }
    asm volatile("s_waitcnt lgkmcnt(0)" ::: "memory");
    bf16* Ow = (bf16*)GS + (size_t)(b * SEQ + q0) * 2048 + 1024 + h * 128;
#pragma unroll
    for (int i = 0; i < 8; ++i) { const int row = i * 4 + (lane >> 4), ch = lane & 15; const u32x4 v = *(const u32x4*)(stg + row * 128 + ch * 8); if (!dry) *(u32x4*)(Ow + (size_t)row * 2048 + ch * 8) = v; }
    asm volatile("s_waitcnt lgkmcnt(0)" ::: "memory");
  }
#undef KDMA
#undef VDMA
}
__device__ __forceinline__ void sb_phase(unsigned char* act, int grow0, char* lds, bool dry, unsigned* ctr, int bx) {
  const int NU = BG * 8 * 64;
  int tid = threadIdx.x; asm volatile("" : "+v"(tid));
  const int wid = __builtin_amdgcn_readfirstlane(tid >> 6), lane = tid & 63;
  char* wlds = lds + wid * 16384;
  const int x = bx & 7, v = (bx >> 3) * 8 + wid;
  int u = (4 * x + (v >> 6)) * 64 + (v & 63);
  unsigned* myctr = ctr + 64 * 16 * (1 + x);
  while (u < NU) {
    unsigned nx = 0u;
    if (lane == 0) nx = __hip_atomic_fetch_add(myctr, 1u, __ATOMIC_RELAXED, __HIP_MEMORY_SCOPE_AGENT);
    const int rb = 63 - (u & 63), bh = u >> 6;
    sbw_unit(bh >> 3, bh & 7, rb, act, grow0, wlds, dry);
    const int n = (int)__builtin_amdgcn_readfirstlane(nx);
    u = (n < 256) ? (32 + 4 * x + (n >> 6)) * 64 + (n & 63) : NU;
  }
}
#undef VM_WAIT
#undef PK4
#undef KSWZ
#undef LGK_WAIT
#undef SBAR
}

#define LAS __attribute__((address_space(3)))
typedef unsigned v4u __attribute__((ext_vector_type(4)));
#define LDS_WAIT() asm volatile("s_waitcnt lgkmcnt(0)" ::: "memory")
constexpr int NWAVES = 8;
constexpr int LDS_BYTES = 147456;

__device__ __forceinline__ int rho32(int l) { return 16 * ((l >> 2) & 1) + 4 * (l >> 3) + (l & 3); }
__device__ __forceinline__ int pos_win(int c) {
    if (c < 1024) { const int hh = c >> 7, j = c & 127, n = j >> 6, jj = j & 63; return 256 * (hh >> 1) + 128 * (hh & 1) + 32 * (jj >> 4) + 16 * n + (jj & 15); }
    if (c < 6144) return (c & ~31) + rho32(c & 31);
    const int isb = (c >= 7168) ? 1 : 0, ch = (c - 6144) & 1023, j = ch >> 7, w = ch & 127;
    return 256 * (24 + j) + 128 * isb + (w & ~31) + rho32(w & 31);
}
enum { KIND_NAT = 0, KIND_P32 = 1, KIND_WIN = 2 };
__device__ __forceinline__ void tr_item(const float* __restrict__ W, int N, bf16* __restrict__ WT, int ldt, int koff, int kind, const float* __restrict__ gain, LAS float* scr, int item, int lane) {
    const int nblk = N / 32, kb = item / nblk, nb = item % nblk, k0 = 64 * kb, n0 = 32 * nb;
    float wv[32];
#pragma unroll
    for (int i = 0; i < 32; ++i) wv[i] = W[(size_t)(k0 + 2 * i + (lane >> 5)) * N + n0 + (lane & 31)];
#pragma unroll
    for (int i = 0; i < 32; ++i) scr[(2 * i + (lane >> 5)) * 33 + (lane & 31)] = wv[i];
    LDS_WAIT(); asm volatile("" ::: "memory");
    const int c = lane & 7;
    float gn[8];
#pragma unroll
    for (int i = 0; i < 8; ++i) gn[i] = gain ? gain[k0 + 8 * c + i] : 1.0f;
#pragma unroll
    for (int j = 0; j < 4; ++j) {
        const int n = (lane >> 3) + 8 * j, cl = n0 + n; int pos = cl; float sc = 1.0f;
        if (kind == KIND_P32) pos = (cl & ~31) + rho32(cl & 31);
        else if (kind == KIND_WIN) { pos = pos_win(cl); if (cl >= 512 && cl < 1024) sc = KR_SCALE; else if (cl >= 3072 && cl < 4096) sc = QS_SCALE; }
        const LAS float* s = scr + (8 * c) * 33 + n;
        v4u o; o.x = pk2(s[0 * 33] * gn[0] * sc, s[1 * 33] * gn[1] * sc); o.y = pk2(s[2 * 33] * gn[2] * sc, s[3 * 33] * gn[3] * sc);
        o.z = pk2(s[4 * 33] * gn[4] * sc, s[5 * 33] * gn[5] * sc); o.w = pk2(s[6 * 33] * gn[6] * sc, s[7 * 33] * gn[7] * sc);
        *(v4u*)(WT + (size_t)pos * ldt + koff + k0 + 8 * c) = o;
    }
    LDS_WAIT(); asm volatile("" ::: "memory");
}

#define RLX_AGENT __ATOMIC_RELAXED, __HIP_MEMORY_SCOPE_AGENT
constexpr int RSTD_OFF = 131072 + 8192;
constexpr int MISC_OFF = 131072 + 4096;
constexpr size_t CTL_ZERO_BYTES = 65536;
#define XB_TMO      128
#define XB_XCNT(j)  (256  + 64 * (j))
#define XB_XSUB(j)  (1280 + 64 * (j))
#define XB_XGEN(j)  (2304 + 64 * (j))
#define XB_TOP      3328
#define XB_TOPGEN   3392
#define XCD_BAR_WORDS 3456
#define XB_SPIN_CAP (1u << 18)

__device__ __forceinline__ unsigned xb_ld(unsigned* p)              { return __hip_atomic_load(p, __ATOMIC_RELAXED, __HIP_MEMORY_SCOPE_AGENT); }
__device__ __forceinline__ unsigned xb_add(unsigned* p, unsigned v) { return __hip_atomic_fetch_add(p, v, __ATOMIC_RELAXED, __HIP_MEMORY_SCOPE_AGENT); }
__device__ __forceinline__ unsigned xb_xcc_id() { return (unsigned)__builtin_amdgcn_s_getreg((3 << 11) | 20) & 0xFu; }
#define XB_SPIN(cond, bar) do { unsigned _sp = 0; while (cond) { __builtin_amdgcn_s_sleep(1); \
    if ((++_sp & 255u) == 0u) { if (xb_ld(&(bar)[XB_TMO])) break; if (_sp > XB_SPIN_CAP) { atomicAdd(&(bar)[XB_TMO], 1u); break; } } } } while (0)

struct XcdBarrier {
    unsigned* bar; unsigned x;
    volatile LAS unsigned* st;
};

__device__ __forceinline__ XcdBarrier xcd_barrier_post(unsigned* bar, volatile LAS unsigned* st) {
    XcdBarrier b; b.bar = bar; b.x = xb_xcc_id(); b.st = st;
    if (threadIdx.x == 0) (void)xb_add(&bar[XB_XCNT(b.x)], 1u);
    return b;
}
__device__ __forceinline__ void xcd_barrier_complete(unsigned* bar, unsigned x, unsigned& nloc, unsigned& nx) {
    const unsigned G = gridDim.x * gridDim.y * gridDim.z;
    unsigned sum, cnt, mine, sp = 0u;
    for (;;) {
        sum = 0u; cnt = 0u; mine = 0u;
#pragma unroll
        for (unsigned j = 0; j < 16; ++j) { const unsigned c = xb_ld(&bar[XB_XCNT(j)]); sum += c; cnt += (c > 0u) ? 1u : 0u; mine = (j == x) ? c : mine; }
        if (sum == G) break;
        __builtin_amdgcn_s_sleep(1);
        if ((++sp & 255u) == 0u) { if (xb_ld(&bar[XB_TMO])) break; if (sp > XB_SPIN_CAP) { atomicAdd(&bar[XB_TMO], 1u); break; } }
    }
    nloc = mine > 0u ? mine : 1u; nx = cnt > 0u ? cnt : 1u;
}

__device__ __forceinline__ void xcd_barrier(const XcdBarrier& b) {
    asm volatile("s_waitcnt vmcnt(0)" ::: "memory");
    __syncthreads();
    if (threadIdx.x == 0) {
        unsigned* bar = b.bar;
        __builtin_amdgcn_s_waitcnt(0);
        unsigned nloc = b.st[0], nx = b.st[1];
        if (nloc == 0u) { xcd_barrier_complete(bar, b.x, nloc, nx); b.st[0] = nloc; b.st[1] = nx; }
        const unsigned old = xb_add(&bar[XB_XSUB(b.x)], 1u);
        const unsigned gen = old / nloc;
        if (old + 1u == (gen + 1u) * nloc) {
            __builtin_amdgcn_fence(__ATOMIC_RELEASE, "agent");
            asm volatile("s_waitcnt vmcnt(0)" ::: "memory");
            const unsigned og = xb_add(&bar[XB_TOP], 1u);
            const unsigned tg = og / nx;
            if (og + 1u == (tg + 1u) * nx) xb_add(&bar[XB_TOPGEN], 1u);
            else XB_SPIN(xb_ld(&bar[XB_TOPGEN]) == tg, bar);
            __builtin_amdgcn_fence(__ATOMIC_ACQUIRE, "agent");
            xb_add(&bar[XB_XGEN(b.x)], 1u);
            asm volatile("s_waitcnt vmcnt(0)" ::: "memory");
        } else {
            XB_SPIN(xb_ld(&bar[XB_XGEN(b.x)]) == gen, bar);
            __builtin_amdgcn_fence(__ATOMIC_ACQUIRE, "agent");
            asm volatile("s_waitcnt vmcnt(0)" ::: "memory");
        }
    }
    __syncthreads();
}

struct Args { const float* in[10]; float* out; unsigned char* ws; int ph_lo, ph_hi; };
constexpr int PH_PRO = 0, PH_FINAL = 1 + 9 * DEPTH;

__device__ __forceinline__ Args load_args() {
    Args r = {};
#if defined(__HIP_DEVICE_COMPILE__)
    typedef const unsigned long long __attribute__((address_space(4)))* KArgP;
    KArgP kp = (KArgP)__builtin_amdgcn_kernarg_segment_ptr(); asm volatile("" : "+s"(kp));
#pragma unroll
    for (int i = 0; i < 10; ++i) r.in[i] = (const float*)kp[i];
    r.out = (float*)kp[10]; r.ws = (unsigned char*)kp[11];
    const unsigned long long p_ = kp[12]; r.ph_lo = (int)(unsigned)p_; r.ph_hi = (int)(unsigned)(p_ >> 32);
#endif
    return r;
}
constexpr int I_IN = 16 * 256, I_SQ = 16 * 32, I_UP = 16 * 128, I_DN = 64 * 32, I_LAYER = I_IN + 3 * I_SQ + I_UP + I_DN;
__device__ __forceinline__ void convert_item(const Args& a, int l, int r, LAS float* scr, int lane) {
    unsigned char* wl = a.ws + WS_W;
    if (r < I_IN) { tr_item(a.in[1] + (size_t)l * D * DIN, DIN, (bf16*)(wl + WL_WIN), D, 0, KIND_WIN, a.in[7] + l * D, scr, r, lane); return; } r -= I_IN;
    if (r < I_SQ) { tr_item(a.in[2] + (size_t)l * D * D, D, (bf16*)(wl + WL_PCAT), 2 * D, 0, KIND_P32, nullptr, scr, r, lane); return; } r -= I_SQ;
    if (r < I_SQ) { tr_item(a.in[3] + (size_t)l * D * D, D, (bf16*)(wl + WL_PCAT), 2 * D, D, KIND_P32, nullptr, scr, r, lane); return; } r -= I_SQ;
    if (r < I_SQ) { tr_item(a.in[4] + (size_t)l * D * D, D, (bf16*)(wl + WL_WOUT), D, 0, KIND_NAT, nullptr, scr, r, lane); return; } r -= I_SQ;
    if (r < I_UP) { tr_item(a.in[5] + (size_t)l * D * DFF, DFF, (bf16*)(wl + WL_WUP), D, 0, KIND_P32, a.in[8] + l * D, scr, r, lane); return; } r -= I_UP;
    tr_item(a.in[6] + (size_t)l * DFF * D, D, (bf16*)(wl + WL_WDN), DFF, 0, KIND_NAT, nullptr, scr, r, lane);
}
__device__ __forceinline__ void convert_phase(int l, unsigned char* lds) {
    const Args a = load_args();
    int tid_ = threadIdx.x; asm volatile("" : "+v"(tid_));
    const int lane = tid_ & 63, wave = __builtin_amdgcn_readfirstlane(tid_ >> 6);
    LAS float* scr = (LAS float*)((LAS unsigned char*)lds + wave * 16384);
    const int gw = blockIdx.x * NWAVES + wave, NGW = gridDim.x * NWAVES;
    for (int it = gw; it < I_LAYER; it += NGW) convert_item(a, l, it, scr, lane);
}
__device__ __forceinline__ void prologue_phase(unsigned char* lds) {
    const Args a = load_args();
    int tid_ = threadIdx.x; asm volatile("" : "+v"(tid_));
    const int lane = tid_ & 63, wave = __builtin_amdgcn_readfirstlane(tid_ >> 6);
    const float* x = a.in[0]; float* out = a.out; bf16* xb = (bf16*)(a.ws + WS_XB); float* ssq = (float*)(a.ws + WS_SSQ); float* rope = (float*)(a.ws + WS_ROPE);
    const int gw = blockIdx.x * NWAVES + wave, NGW = gridDim.x * NWAVES;
    LAS float* scr = (LAS float*)((LAS unsigned char*)lds + wave * 16384);
    for (int it = gw; it < I_LAYER; it += NGW) convert_item(a, 0, it, scr, lane);
    for (int r = gw; r < M; r += NGW) {
        float s = 0.f; float4 xv[4];
#pragma unroll
        for (int j = 0; j < 4; ++j) xv[j] = *(const float4*)(x + (size_t)r * D + j * 256 + lane * 4);
#pragma unroll
        for (int j = 0; j < 4; ++j) {
            const int c = j * 256 + lane * 4;
            const float4 v = xv[j];
            *(float4*)(out + (size_t)r * D + c) = v;
            s += v.x * v.x + v.y * v.y + v.z * v.z + v.w * v.w;
            uint2 w; w.x = pk2(v.x, v.y); w.y = pk2(v.z, v.w);
            *(uint2*)(xb + (size_t)r * D + c) = w;
        }
#pragma unroll
        for (int o = 1; o < 64; o <<= 1) s += __shfl_xor(s, o);
        if (lane < 16) ssq[(size_t)r * 16 + lane] = (lane == 0) ? s : 0.f;
    }
    for (int i = blockIdx.x * 512 + tid_; i < SEQ * 64; i += gridDim.x * 512) {
        const int pos = i >> 6, j = i & 63;
        const float inv = powf(10000.0f, -(float)j / 64.0f);
        const float ang = (float)pos * inv;
        rope[i] = cosf(ang); rope[SEQ * 64 + i] = sinf(ang);
    }
}
__device__ __forceinline__ void final_phase() {
    const Args a = load_args();
    int tid_ = threadIdx.x; asm volatile("" : "+v"(tid_));
    const int lane = tid_ & 63, wave = __builtin_amdgcn_readfirstlane(tid_ >> 6);
    float* out = a.out; const float* g = a.in[9];
    const int gw = blockIdx.x * NWAVES + wave, NGW = gridDim.x * NWAVES;
    for (int r = gw; r < M; r += NGW) {
        float4 v[4]; float s = 0.f;
#pragma unroll
        for (int j = 0; j < 4; ++j) { v[j] = *(const float4*)(out + (size_t)r * D + j * 256 + lane * 4); s += v[j].x * v[j].x + v[j].y * v[j].y + v[j].z * v[j].z + v[j].w * v[j].w; }
#pragma unroll
        for (int o = 1; o < 64; o <<= 1) s += __shfl_xor(s, o);
        const float rs = rsqrtf(s * (1.0f / D) + NORM_EPS);
#pragma unroll
        for (int j = 0; j < 4; ++j) { const float4 gg = *(const float4*)(g + j * 256 + lane * 4);
            float4 o; o.x = v[j].x * rs * gg.x; o.y = v[j].y * rs * gg.y; o.z = v[j].z * rs * gg.z; o.w = v[j].w * rs * gg.w;
            *(float4*)(out + (size_t)r * D + j * 256 + lane * 4) = o; }
    }
}

#ifndef RET_NAIVE
#define RET_NAIVE 0
#endif
#ifndef PHMASK
#define PHMASK 31
#endif
#ifndef MK_ONE_LAUNCH
#define MK_ONE_LAUNCH 1
#endif
__global__ void __launch_bounds__(NWAVES * 64, 2) mega(Args a) {
    extern __shared__ __attribute__((aligned(16))) unsigned char lds[];
    const int G = gridDim.x;
    PG8_LAS unsigned char* ring = (PG8_LAS unsigned char*)lds;
#if MK_ONE_LAUNCH
    volatile LAS unsigned* MISC = (volatile LAS unsigned*)((LAS unsigned char*)lds + MISC_OFF);
    if (threadIdx.x < 4) MISC[threadIdx.x] = 0u;
    __syncthreads();
    const XcdBarrier bar = xcd_barrier_post((unsigned*)(a.ws + WS_CTL), MISC);
#define GRID_SYNC() xcd_barrier(bar)
#else
#define GRID_SYNC() do {} while (0)
#endif
    volatile LAS unsigned* MISCT = (volatile LAS unsigned*)((LAS unsigned char*)lds + MISC_OFF + 64);
    if (TIME_K >= 0 && threadIdx.x == 0) { MISCT[4] = 0u; const unsigned long long t_ = __builtin_amdgcn_s_memrealtime(); MISCT[2] = (unsigned)t_; MISCT[3] = (unsigned)(t_ >> 32); }
    int ph = a.ph_lo; const int ph_hi = a.ph_hi;
    if (ph == PH_PRO) { prologue_phase(lds); ++ph;
#if MK_ONE_LAUNCH
        if (ph < ph_hi) { if (a.ph_lo < 0) cg::this_grid().sync(); else GRID_SYNC(); }
#endif
        TSTAMP(20);
    }
    const int ph_end = ph_hi < PH_FINAL ? ph_hi : PH_FINAL;
    const bool rt_true = (PROBE_K >= 0) && (a.ph_hi > 0);
    for (; ph < ph_end; ++ph) {
        if (ph == 1) continue;
        int bx = (int)blockIdx.x; asm volatile("" : "+s"(bx));
        size_t zofs = 0; asm volatile("" : "+s"(zofs));
        unsigned char* ws = a.ws + zofs; float* outp = (float*)((unsigned char*)a.out + zofs);
        float* ssq = (float*)(ws + WS_SSQ); const float* rope = (const float*)(ws + WS_ROPE); bf16* xb = (bf16*)(ws + WS_XB);
        {
            const int q = ph - 1, k = q % 9, l = q / 9;
            const unsigned char* wl = ws + WS_W;
            if (k == 0) {
                if (l > 0) convert_phase(l, lds);
            } else if (k == 1 || k == 3) {
                const int g = k >> 1, grow0 = g * MG;
                pg8::Gemm gm{xb + (size_t)grow0 * D, (const bf16*)(wl + WL_WIN), MG, DIN, D, D}; pg8::StaticOrder S; S.init(MG, DIN, G, bx);
                pg8::EpiP1 E{ws, rope, grow0, false, (const PG8_LAS float*)(ring + RSTD_OFF)};
                { pg8::Unit u0; u0.pm = 0; S.next(0, u0); pg8::panel_rstd((PG8_LAS float*)(ring + RSTD_OFF), ssq, grow0, u0.pm, u0.pm); }
                pg8::gemm_phase<pg8::EpiP1, pg8::StaticOrder, true, true>(ring, gm, S, E);
            } else if (k == 2 || k == 4) {
                const int g = (k >> 1) - 1, grow0 = g * MG, lg = l * NGRP + g;
                TSTAMP(100);
                sba::ret_phase(ws, grow0, (char*)lds, false, bx);
                TSTAMP(18);
                sba::sb_phase(ws, grow0, (char*)lds, false, (unsigned*)(ws + WS_CTL + 16384) + (size_t)(2 * lg + 1) * 64, bx);
                TSTAMP(19);
            } else if (k == 5) {
                pg8::Gemm gm{(const bf16*)(ws + WS_GS), (const bf16*)(wl + WL_PCAT), M, D, 2 * D, D}; pg8::ChainOrder S; S.init(M, D, G, bx); S.kh = D;
                pg8::EpiP3 E{ws, false};
                pg8::gemm_phase<pg8::EpiP3, pg8::ChainOrder, true, true>(ring, gm, S, E);
            } else if (k == 6) {
                pg8::Gemm gm{(const bf16*)(ws + WS_MERGED), (const bf16*)(wl + WL_WOUT), M, D, D, D}; pg8::StaticOrder S; S.init(M, D, G, bx);
                pg8::EpiX E{outp, xb, ssq, 0, false, true};
                pg8::gemm_phase<pg8::EpiX, pg8::StaticOrder, true, true>(ring, gm, S, E);
            } else if (k == 7) {
                pg8::Gemm gm{xb, (const bf16*)(wl + WL_WUP), M, DFF, D, D}; pg8::StaticOrder S; S.init(M, DFF, G, bx);
                pg8::Unit u0, u1; u0.pm = 0; u1.pm = 0; S.next(0, u0); if (!S.next(7, u1)) u1 = u0;
                pg8::EpiP5 E{ws, false, (const PG8_LAS float*)(ring + RSTD_OFF)};
                pg8::panel_rstd((PG8_LAS float*)(ring + RSTD_OFF), ssq, 0, (u0.pm & pg8::WGM) ? u1.pm : u0.pm, (u0.pm & pg8::WGM) ? u0.pm : u1.pm);
                pg8::gemm_phase<pg8::EpiP5, pg8::StaticOrder, true, true>(ring, gm, S, E);
            } else {
                pg8::Gemm gm{(const bf16*)(ws + WS_UP), (const bf16*)(wl + WL_WDN), M, D, DFF, DFF}; pg8::StaticOrder S; S.init(M, D, G, bx);
                pg8::EpiX E{outp, xb, ssq, 0, false, l + 1 < DEPTH};
                pg8::gemm_phase<pg8::EpiX, pg8::StaticOrder, true, true>(ring, gm, S, E);
            }
        }
        if (ph + 1 < ph_hi) GRID_SYNC();
        TSTAMP((ph - 1) % 9);
    }
    if (ph_hi > PH_FINAL) final_phase();
    TSTAMP(21);
    if (TIME_K >= 0 && blockIdx.x == 0 && threadIdx.x == 0) { const unsigned long long t0_ = __builtin_amdgcn_s_memrealtime(); const unsigned span_ = MISCT[4]; while (__builtin_amdgcn_s_memrealtime() - t0_ < span_) __builtin_amdgcn_s_sleep(8); }
}

extern "C" void kernel_launch(void* const* d_in, const int* in_sizes, int n_in, void* d_out, int out_size, void* d_ws, size_t ws_size, hipStream_t stream) {
    static int grid = 0;
    if (grid == 0) {
        if (n_in != 10 || in_sizes[0] != M * D || out_size != M * D || ws_size < WS_END) { fprintf(stderr, "kernel_launch: unexpected shapes (n_in %d, ws %zu)\n", n_in, ws_size); grid = -1; return; }
        int dev = 0, cus = 0;
        if (hipGetDevice(&dev) != hipSuccess || hipDeviceGetAttribute(&cus, hipDeviceAttributeMultiprocessorCount, dev) != hipSuccess) { grid = -1; return; }
        if (hipFuncSetAttribute((const void*)mega, hipFuncAttributeMaxDynamicSharedMemorySize, LDS_BYTES) != hipSuccess) { fprintf(stderr, "kernel_launch: hipFuncSetAttribute failed\n"); grid = -1; return; }
        int per_cu = 0;
        if (hipOccupancyMaxActiveBlocksPerMultiprocessor(&per_cu, (const void*)mega, NWAVES * 64, LDS_BYTES) != hipSuccess || per_cu < 1) { fprintf(stderr, "kernel_launch: occupancy query says %d blocks per CU\n", per_cu); (void)hipGetLastError(); per_cu = 1; }
        if (cus < 256) { fprintf(stderr, "kernel_launch: built for a 256-CU device (got %d CUs)\n", cus); grid = -1; return; }
        grid = 256;
    }
    if (grid < 0) return;
    Args a{};
    for (int i = 0; i < 10; ++i) a.in[i] = (const float*)d_in[i];
    a.out = (float*)d_out; a.ws = (unsigned char*)d_ws;
#if MK_ONE_LAUNCH
    if (hipMemsetAsync((char*)d_ws + WS_CTL, 0, CTL_ZERO_BYTES, stream) != hipSuccess) { fprintf(stderr, "kernel_launch: hipMemsetAsync failed\n"); return; }
    a.ph_lo = 0; a.ph_hi = PH_FINAL + 1;
    void* kargs[] = {&a};
    const hipError_t le = hipLaunchCooperativeKernel((const void*)mega, dim3(grid), dim3(NWAVES * 64), kargs, LDS_BYTES, stream);
    if (le != hipSuccess) fprintf(stderr, "kernel_launch: cooperative launch failed: %s (grid %d)\n", hipGetErrorString(le), grid);
#else
    auto run = [&](int lo, int hi) { a.ph_lo = lo; a.ph_hi = hi; hipLaunchKernelGGL(mega, dim3(grid), dim3(NWAVES * 64), LDS_BYTES, stream, a); };
    for (int p = 0; p <= PH_FINAL; ++p) run(p, p + 1);
#endif
}
```

```cpp
#include <hip/hip_runtime.h>
#include <hip/hip_cooperative_groups.h>
#include <cstdio>
#include <cstdint>
namespace cg = cooperative_groups;

constexpr int D = 1024, BATCH = 16, SEQ = 2048, DEPTH = 4, M = BATCH * SEQ;
constexpr int DIN = 8192, DFF = 4096;
constexpr int NGRP = 2, BG = BATCH / NGRP, MG = BG * SEQ;
constexpr float NORM_EPS = 1e-6f, GN_EPS = 1e-5f;
constexpr float LOG2E = 1.4426950408889634f, LN2 = 0.6931471805599453f;
constexpr float QS_SCALE = 0.08838834764831845f * LOG2E;
constexpr float KR_SCALE = 0.08838834764831845f;
constexpr float LG2_GAMMA0 = -0.045803689613124954f, LG2_GAMMA1 = -0.022720076500083545f, LG2_GAMMA2 = -0.011315313227834146f, LG2_GAMMA3 = -0.005646563141142062f;

#ifndef PROBE_K
#define PROBE_K (-1)
#endif
#ifndef TIME_K
#define TIME_K (-1)
#endif
#define TSTAMP(type) do { if (TIME_K >= 0 && blockIdx.x == 0 && threadIdx.x == 0) { const unsigned long long t_ = __builtin_amdgcn_s_memrealtime(); \
    const unsigned long long p_ = ((unsigned long long)MISCT[3] << 32) | MISCT[2]; if ((type) == TIME_K) MISCT[4] += (unsigned)(t_ - p_); MISCT[2] = (unsigned)t_; MISCT[3] = (unsigned)(t_ >> 32); } } while (0)
typedef unsigned short bf16;
constexpr size_t MiB = 1u << 20;
constexpr size_t WS_CTL = 0;
constexpr size_t WS_ROPE = 1 * MiB;
constexpr size_t WS_SSQ = 2 * MiB;
constexpr size_t WS_XB = 4 * MiB;
constexpr size_t WS_W = 68 * MiB;
constexpr size_t WL_WIN = 0, WL_PCAT = 16 * MiB, WL_WOUT = 20 * MiB, WL_WUP = 22 * MiB, WL_WDN = 30 * MiB, WL_STRIDE = 38 * MiB;
constexpr size_t WS_ACT = 220 * MiB;
constexpr size_t WS_END = 476 * MiB;
constexpr size_t SLAB = 32 * MiB, SKIP2K = SLAB - 2048 * 2048, SKIP4K = SLAB - 2048 * 4096, SKIP8K = SLAB - (size_t)2048 * 8192;
constexpr size_t A_RQK = 0, A_RV = 4 * MiB, A_GS = 8 * MiB, A_SK = 16 * MiB, A_SV = 20 * MiB, A_GA = 24 * MiB, A_GB = 28 * MiB;
constexpr size_t A_MERGED = 0, A_UP = 0;

__device__ __forceinline__ unsigned f2bf(float f) { unsigned u = __builtin_bit_cast(unsigned, f); return (u + 0x7fffu + ((u >> 16) & 1u)) >> 16; }
__device__ __forceinline__ float bf2f(unsigned h) { return __builtin_bit_cast(float, h << 16); }
__device__ __forceinline__ unsigned pk2(float lo, float hi) { return f2bf(lo) | (f2bf(hi) << 16); }

namespace pg8 {
#define PG8_LAS __attribute__((address_space(3)))
typedef unsigned short bf16_t;
typedef short bf16x8 __attribute__((ext_vector_type(8)));
typedef float f32x4 __attribute__((ext_vector_type(4)));
typedef unsigned u32x4 __attribute__((ext_vector_type(4)));
constexpr int BM = 256, BK = 64, HALF = 128, HTB = HALF * BK * 2  , STAGE_BYTES = 8 * HTB, NXCD = 8, WGM = 8;

__host__ __device__ __forceinline__ int lds_byte(int r, int c) { const int st = (r >> 4) * 2 + (c >> 5), rr = r & 15, cc = c & 31, ob = rr * 64 + cc * 2; return st * 1024 + (ob ^ (((ob >> 9) & 1) << 5)); }
__host__ __device__ __forceinline__ void stage_rc(int b, int& R, int& C) { const int st = b / 1024, sb = b % 1024, swz = sb ^ (((sb >> 9) & 1) << 5); R = (st >> 1) * 16 + swz / 64; C = (st & 1) * 32 + (swz % 64) / 2; }
__host__ __device__ __forceinline__ int perm32(int rho) { const int n = rho >> 4, i = rho & 15; return 8 * (i >> 2) + 4 * n + (i & 3); }

struct Unit { int pm, pn, kofs; };
struct Gemm { const bf16_t* A; const bf16_t* Bt; int M, N, K, Kloop; size_t askip = 0; };

struct StaticOrder {
    int nM, nN, nwg, G, c;
    __host__ __device__ void init(int M, int N, int G_, int c_) { nM = M / BM; nN = N / BM; nwg = nM * nN; G = G_; c = c_; }
    __host__ __device__ bool next(int i, Unit& u) const {
        const long L = (long)i * G + c; if (L >= nwg) return false;
        int wgid = (int)L; { const int q = nwg / NXCD, r = nwg % NXCD, xcd = wgid % NXCD, off = wgid / NXCD; wgid = (xcd < r ? xcd * (q + 1) : r * (q + 1) + (xcd - r) * q) + off; }
        const int nig = WGM * nN, gid = wgid / nig, fm = gid * WGM, gsz = (nM - fm) < WGM ? (nM - fm) : WGM;
        u.pm = fm + ((wgid % nig) % gsz); u.pn = (wgid % nig) / gsz; u.kofs = 0; return true;
    }
    __device__ __forceinline__ void a_ready(const Unit&) const {}
    __device__ __forceinline__ void done(const Unit&) const {}
};
struct ChainOrder : StaticOrder {
    int kh;
    __host__ __device__ bool next(int i, Unit& u) const { if (!StaticOrder::next(i >> 1, u)) return false; u.kofs = (i & 1) * kh; return true; }
};


typedef unsigned u32x2 __attribute__((ext_vector_type(2)));
__device__ __forceinline__ unsigned cvt_pk_bf16(float lo, float hi) { unsigned r; asm volatile("v_cvt_pk_bf16_f32 %0, %1, %2" : "=v"(r) : "v"(lo), "v"(hi)); return r; }
__device__ __forceinline__ u32x2 pack4(const f32x4 v) { u32x2 w; w.x = cvt_pk_bf16(v[0], v[1]); w.y = cvt_pk_bf16(v[2], v[3]); return w; }
__device__ __forceinline__ u32x4 pack8(const f32x4 a, const f32x4 b) { u32x4 w; w.x = cvt_pk_bf16(a[0], a[1]); w.y = cvt_pk_bf16(a[2], a[3]); w.z = cvt_pk_bf16(b[0], b[1]); w.w = cvt_pk_bf16(b[2], b[3]); return w; }
__device__ __forceinline__ f32x4 unpack_lo(const u32x4 w) { f32x4 r; r[0] = __builtin_bit_cast(float, w.x << 16); r[1] = __builtin_bit_cast(float, w.x & 0xffff0000u); r[2] = __builtin_bit_cast(float, w.y << 16); r[3] = __builtin_bit_cast(float, w.y & 0xffff0000u); return r; }
__device__ __forceinline__ f32x4 unpack_hi(const u32x4 w) { f32x4 r; r[0] = __builtin_bit_cast(float, w.z << 16); r[1] = __builtin_bit_cast(float, w.z & 0xffff0000u); r[2] = __builtin_bit_cast(float, w.w << 16); r[3] = __builtin_bit_cast(float, w.w & 0xffff0000u); return r; }
__device__ __forceinline__ float row_rstd(const char* ub, unsigned lo) {
    const f32x4* p = (const f32x4*)(ub + lo);
    const f32x4 a = p[0], b = p[1], c = p[2], d = p[3];
    const float s = (((a[0] + a[1]) + (a[2] + a[3])) + ((b[0] + b[1]) + (b[2] + b[3]))) + (((c[0] + c[1]) + (c[2] + c[3])) + ((d[0] + d[1]) + (d[2] + d[3])));
    return rsqrtf(s * (1.0f / 1024.0f) + NORM_EPS);
}
__device__ __forceinline__ f32x4 exp4(const f32x4 v) { f32x4 r; r[0] = __expf(v[0]); r[1] = __expf(v[1]); r[2] = __expf(v[2]); r[3] = __expf(v[3]); return r; }
__device__ __forceinline__ f32x4 rcp4(const f32x4 v) { f32x4 r; r[0] = __builtin_amdgcn_rcpf(v[0]); r[1] = __builtin_amdgcn_rcpf(v[1]); r[2] = __builtin_amdgcn_rcpf(v[2]); r[3] = __builtin_amdgcn_rcpf(v[3]); return r; }

__device__ __forceinline__ void panel_rstd(PG8_LAS float* rst, const float* ssq, int grow0, int pm) {
    int tid = threadIdx.x; asm volatile("" : "+v"(tid));
    if (tid < 256) rst[tid] = row_rstd((const char*)ssq + (size_t)(grow0 + pm * BM) * 64, (unsigned)tid * 64u);
    __syncthreads();
}
struct EpiP1 {
    static constexpr bool PERM = false, AFTER_DRAIN = false, MID = false, PRELOAD = false; static constexpr bool SLACK = true;
    __device__ __forceinline__ bool slack_ok() const { return (PROBE_K < 0) || !dry; }
    unsigned char* act; const float* rope; int grow0; bool dry; const PG8_LAS float* rst;
    __device__ __forceinline__ void mid(f32x4 (&)[2][2][4][2], const Unit&, int, int, int, int) const {}
    __device__ __forceinline__ void operator()(const f32x4 (&acc)[2][2][4][2], const Unit& u, int wr, int wc, int fr, int fq) const {
        if (dry) return;
        const int pn = u.pn, rlu = u.pm * BM + wr * 64;
        unsigned lf = (unsigned)fr, lq = (unsigned)fq; asm volatile("" : "+v"(lf), "+v"(lq));
        float rs[2][4];
#pragma unroll
        for (int ai = 0; ai < 2; ++ai)
#pragma unroll
            for (int m = 0; m < 4; ++m) rs[ai][m] = rst[wr * 64 + ai * HALF + m * 16 + lf];
        if (pn < 4) {
            const unsigned j0 = 16 * wc + 4 * lq;
            char* ub = (char*)(act + A_RQK + (size_t)(u.pm >> 3) * SKIP2K) + ((size_t)rlu * 1024 + (pn >> 1) * 512 + (pn & 1) * 256) * 2;
            const unsigned lo = (lf * 1024u + j0) * 2u;
            const int pos0 = (grow0 + rlu) & (SEQ - 1);
            const char* rp = (const char*)rope + (size_t)pos0 * 256;
            const float sg = (pn < 2) ? 1.0f : -1.0f;
            const float lgA0 = sg * LG2_GAMMA0, lgA1 = sg * LG2_GAMMA1, lgB0 = sg * LG2_GAMMA2, lgB1 = sg * LG2_GAMMA3;
            const unsigned rlo = lf * 256u + j0 * 4u;
            f32x4 csv[2][4], snv[2][4];
#pragma unroll
            for (int ai = 0; ai < 2; ++ai)
#pragma unroll
                for (int m = 0; m < 4; ++m) { csv[ai][m] = *(const f32x4*)(rp + (ai * HALF + m * 16) * 256 + rlo); snv[ai][m] = *(const f32x4*)(rp + SEQ * 256 + (ai * HALF + m * 16) * 256 + rlo); }
            asm volatile("" ::: "memory");
#pragma unroll
            for (int ai = 0; ai < 2; ++ai)
#pragma unroll
                for (int m = 0; m < 4; ++m) {
                    const f32x4 cs = csv[ai][m], sn = snv[ai][m];
                    const float posf = (float)(pos0 + ai * HALF + m * 16) + (float)lf;
#pragma unroll
                    for (int bj = 0; bj < 2; ++bj) {
                        const float fac = rs[ai][m] * __builtin_amdgcn_exp2f(posf * ((pn & 1) ? (bj ? lgB1 : lgB0) : (bj ? lgA1 : lgA0)));
                        const f32x4 t1 = acc[ai][bj][m][0] * fac, t2 = acc[ai][bj][m][1] * fac;
                        const f32x4 o1 = t1 * cs - t2 * sn, o2 = t1 * sn + t2 * cs;
                        char* d = ub + ((ai * HALF + m * 16) * 1024 + bj * 128) * 2;
                        *(u32x2*)(d + lo) = pack4(o1); *(u32x2*)(d + 128 + lo) = pack4(o2);
                    }
                }
        } else if (pn < 24) {
            char* ub; int pitch; bool silu = false;
            const size_t tm = (size_t)(u.pm >> 3);
            if (pn < 8) { ub = (char*)(act + A_RV + tm * SKIP2K) + (pn - 4) * 512; pitch = 2048; }
            else if (pn < 12) { ub = (char*)(act + A_GS + tm * SKIP4K) + (pn - 8) * 512; pitch = 4096; silu = true; }
            else if (pn < 16) { ub = (char*)(act + A_GS + tm * SKIP4K) + 2048 + (pn - 12) * 512; pitch = 4096; }
            else if (pn < 20) { ub = (char*)(act + A_SK + tm * SKIP2K) + (pn - 16) * 512; pitch = 2048; }
            else { ub = (char*)(act + A_SV + tm * SKIP2K) + (pn - 20) * 512; pitch = 2048; }
            ub += (size_t)rlu * pitch;
            const unsigned lo = lf * (unsigned)pitch + ((unsigned)(wc * 32) + 8u * lq) * 2u;
#pragma unroll
            for (int ai = 0; ai < 2; ++ai)
#pragma unroll
                for (int m = 0; m < 4; ++m) {
                    char* rowp = ub + (size_t)(ai * HALF + m * 16) * pitch;
#pragma unroll
                    for (int bj = 0; bj < 2; ++bj) {
                        f32x4 v0 = acc[ai][bj][m][0] * rs[ai][m], v1 = acc[ai][bj][m][1] * rs[ai][m];
                        if (silu) { v0 = v0 * rcp4(exp4(-v0) + 1.0f); v1 = v1 * rcp4(exp4(-v1) + 1.0f); }
                        *(u32x4*)(rowp + bj * 256 + lo) = pack8(v0, v1);
                    }
                }
        } else {
            const size_t uo = ((size_t)rlu * 1024 + 128 * (pn - 24)) * 2;
            char* ga = (char*)(act + A_GA + (size_t)(u.pm >> 3) * SKIP2K) + uo; char* gb = (char*)(act + A_GB + (size_t)(u.pm >> 3) * SKIP2K) + uo;
            const unsigned lo = (lf * 1024u + (unsigned)(32 * wc) + 8u * lq) * 2u;
#pragma unroll
            for (int ai = 0; ai < 2; ++ai)
#pragma unroll
                for (int m = 0; m < 4; ++m) {
                    f32x4 ra[2], sb[2];
#pragma unroll
                    for (int n = 0; n < 2; ++n) {
                        const f32x4 ea = exp4(-(acc[ai][0][m][n] * rs[ai][m])) + 1.0f, eb = exp4(-(acc[ai][1][m][n] * rs[ai][m])) + 1.0f;
                        const f32x4 t = rcp4(ea * eb); sb[n] = t * ea; ra[n] = (t * eb) * eb;
                    }
                    *(u32x4*)(ga + (ai * HALF + m * 16) * 2048 + lo) = pack8(ra[0], ra[1]);
                    *(u32x4*)(gb + (ai * HALF + m * 16) * 2048 + lo) = pack8(sb[0], sb[1]);
                }
        }
    }
};
struct EpiP3 {
    static constexpr bool PERM = false, AFTER_DRAIN = false, MID = true, PRELOAD = false; static constexpr bool SLACK = false;
    __device__ __forceinline__ bool slack_ok() const { return false; }
    unsigned char* act; bool dry;
    __device__ __forceinline__ void mid(f32x4 (&acc)[2][2][4][2], const Unit& u, int wr, int wc, int fr, int fq) const {
        const char* g = (const char*)(act + A_GA + (size_t)(u.pm >> 3) * SKIP2K) + ((size_t)(u.pm * BM + wr * 64) * 1024 + u.pn * BM) * 2;
        unsigned lo = ((unsigned)fr * 1024u + (unsigned)(wc * 32 + 8 * fq)) * 2u; asm volatile("" : "+v"(lo));
        u32x4 w[2][4][2];
#pragma unroll
        for (int ai = 0; ai < 2; ++ai)
#pragma unroll
            for (int m = 0; m < 4; ++m)
#pragma unroll
                for (int bj = 0; bj < 2; ++bj) w[ai][m][bj] = *(const u32x4*)(g + ((ai * HALF + m * 16) * 2048 + bj * 256) + lo);
        asm volatile("" ::: "memory");
#pragma unroll
        for (int ai = 0; ai < 2; ++ai)
#pragma unroll
            for (int m = 0; m < 4; ++m)
#pragma unroll
                for (int bj = 0; bj < 2; ++bj) { acc[ai][bj][m][0] *= unpack_lo(w[ai][m][bj]); acc[ai][bj][m][1] *= unpack_hi(w[ai][m][bj]); }
    }
    __device__ __forceinline__ void operator()(const f32x4 (&acc)[2][2][4][2], const Unit& u, int wr, int wc, int fr, int fq) const {
        if (dry) return;
        const size_t uo = ((size_t)(u.pm * BM + wr * 64) * 1024 + u.pn * BM) * 2;
        const char* g = (const char*)(act + A_GB + (size_t)(u.pm >> 3) * SKIP2K) + uo; char* o = (char*)(act + A_MERGED + (size_t)(u.pm >> 3) * SKIP2K) + uo;
        unsigned lo = ((unsigned)fr * 1024u + (unsigned)(wc * 32 + 8 * fq)) * 2u; asm volatile("" : "+v"(lo));
        u32x4 w[2][4][2];
#pragma unroll
        for (int ai = 0; ai < 2; ++ai)
#pragma unroll
            for (int m = 0; m < 4; ++m)
#pragma unroll
                for (int bj = 0; bj < 2; ++bj) w[ai][m][bj] = *(const u32x4*)(g + ((ai * HALF + m * 16) * 2048 + bj * 256) + lo);
        asm volatile("" ::: "memory");
#pragma unroll
        for (int ai = 0; ai < 2; ++ai)
#pragma unroll
            for (int m = 0; m < 4; ++m)
#pragma unroll
                for (int bj = 0; bj < 2; ++bj) {
                    const int co = (ai * HALF + m * 16) * 2048 + bj * 256;
                    *(u32x4*)(o + co + lo) = pack8(acc[ai][bj][m][0] * unpack_lo(w[ai][m][bj]), acc[ai][bj][m][1] * unpack_hi(w[ai][m][bj]));
                }
    }
};
struct EpiX {
    static constexpr bool PERM = false, AFTER_DRAIN = false, MID = false, PRELOAD = true; static constexpr bool SLACK = false;
    __device__ __forceinline__ bool slack_ok() const { return false; }
    float* out; bf16_t* xb; float* ssq; int grow0; bool dry; bool feed;
    __device__ __forceinline__ void mid(f32x4 (&)[2][2][4][2], const Unit&, int, int, int, int) const {}
    __device__ __forceinline__ void preload(f32x4 (&acc)[2][2][4][2], const Unit& u, int wr, int wc, int fr, int fq) const {
        const size_t Ru = (size_t)(grow0 + u.pm * BM + wr * 64), cu = (size_t)(u.pn * BM + wc * 32);
        const char* xi = (const char*)out + (Ru * D + cu) * 4;
        unsigned lo4 = ((unsigned)fr * 1024u + 4u * (unsigned)fq) * 4u; asm volatile("" : "+v"(lo4));
#pragma unroll
        for (int ai = 0; ai < 2; ++ai)
#pragma unroll
            for (int m = 0; m < 4; ++m)
#pragma unroll
                for (int bj = 0; bj < 2; ++bj)
#pragma unroll
                    for (int n = 0; n < 2; ++n) acc[ai][bj][m][n] = *(const f32x4*)(xi + ((ai * HALF + m * 16) * 1024 + bj * HALF + n * 16) * 4 + lo4);
    }
    __device__ __forceinline__ void operator()(const f32x4 (&acc)[2][2][4][2], const Unit& u, int wr, int wc, int fr, int fq) const {
        if (dry) return;
        const size_t Ru = (size_t)(grow0 + u.pm * BM + wr * 64), cu = (size_t)(u.pn * BM + wc * 32);
        char* xo = (char*)out + (Ru * D + cu) * 4; char* xbo = (char*)xb + (Ru * D + cu) * 2; char* sq = (char*)ssq + Ru * 64 + (u.pn * 4 + wc) * 4;
        unsigned lo4 = ((unsigned)fr * 1024u + 4u * (unsigned)fq) * 4u, los = (unsigned)fr * 64u; asm volatile("" : "+v"(lo4), "+v"(los)); const unsigned lo2 = lo4 >> 1;
#pragma unroll
        for (int ai = 0; ai < 2; ++ai)
#pragma unroll
            for (int m = 0; m < 4; ++m) {
                float s = 0.f;
#pragma unroll
                for (int bj = 0; bj < 2; ++bj)
#pragma unroll
                    for (int n = 0; n < 2; ++n) {
                        const int co = (ai * HALF + m * 16) * 1024 + bj * HALF + n * 16;
                        const f32x4 xn = acc[ai][bj][m][n];
                        *(f32x4*)(xo + co * 4 + lo4) = xn; if (feed) *(u32x2*)(xbo + co * 2 + lo2) = pack4(xn);
                        s += (xn[0] * xn[0] + xn[1] * xn[1]) + (xn[2] * xn[2] + xn[3] * xn[3]);
                    }
                s += __shfl_xor(s, 16); s += __shfl_xor(s, 32);
                if (feed && fq == 0) *(float*)(sq + (ai * HALF + m * 16) * 64 + los) = s;
            }
    }
};
struct EpiP5 {
    static constexpr bool PERM = false, AFTER_DRAIN = false, MID = false, PRELOAD = false; static constexpr bool SLACK = true;
    __device__ __forceinline__ bool slack_ok() const { return (PROBE_K < 0) || !dry; }
    unsigned char* act; int grow0; bool dry; const PG8_LAS float* rst;
    __device__ __forceinline__ void mid(f32x4 (&)[2][2][4][2], const Unit&, int, int, int, int) const {}
    __device__ __forceinline__ void operator()(const f32x4 (&acc)[2][2][4][2], const Unit& u, int wr, int wc, int fr, int fq) const {
        if (dry) return;
        const int rlu = u.pm * BM + wr * 64;
        char* ub = (char*)(act + A_UP + (size_t)(u.pm >> 3) * SKIP8K) + ((size_t)rlu * DFF + u.pn * BM) * 2;
        unsigned lo = ((unsigned)fr * (unsigned)DFF + (unsigned)(wc * 32 + 8 * fq)) * 2u, lf = (unsigned)fr; asm volatile("" : "+v"(lo), "+v"(lf));
#pragma unroll
        for (int ai = 0; ai < 2; ++ai)
#pragma unroll
            for (int m = 0; m < 4; ++m) {
                const float rsv = rst[wr * 64 + ai * HALF + m * 16 + lf];
#pragma unroll
                for (int bj = 0; bj < 2; ++bj) {
                    f32x4 v0 = acc[ai][bj][m][0] * rsv, v1 = acc[ai][bj][m][1] * rsv;
#pragma unroll
                    for (int e = 0; e < 4; ++e) { const float a = fmaxf(v0[e], 0.f), b = fmaxf(v1[e], 0.f); v0[e] = a * a; v1[e] = b * b; }
                    *(u32x4*)(ub + ((ai * HALF + m * 16) * DFF + bj * HALF) * 2 + lo) = pack8(v0, v1);
                }
            }
    }
};

template <class Epi, class Sched, bool ALIGN_EPI = false, bool SP2 = false>
__device__ __forceinline__ void gemm_phase(PG8_LAS unsigned char* lds, const Gemm g, const Sched& S, const Epi& E) {
    int tid = threadIdx.x; asm volatile("" : "+v"(tid));
    const int wid = __builtin_amdgcn_readfirstlane(tid >> 6), lane = tid & 63, wr = wid >> 2, wc = wid & 3, fr = lane & 15, fq = lane >> 4;
    const int K = g.K, nt = g.Kloop / BK;
    unsigned voffA[2], voffB[2];
#pragma unroll
    for (int i = 0; i < 2; ++i) { int R, C; stage_rc(tid * 16 + i * 8192, R, C); const int Rb = Epi::PERM ? ((R & ~31) + perm32(R & 31)) : R;
        voffA[i] = (unsigned)(R * K + C) * 2u; voffB[i] = (unsigned)(Rb * K + C) * 2u; }
    const size_t kstep = (size_t)(BK * 2);
    const size_t hstep = (size_t)HALF * K * 2;
    const size_t tstep = 2 * hstep;
    const unsigned ldsw = (unsigned)wid * 1024u;
    const int aoff = lds_byte(wr * 64 + fr, fq * 8), boff = lds_byte(wc * 32 + fr, fq * 8);
#define PG8_SA(b, h) (((b) * 2 + (h)) * HTB)
#define PG8_SB(b, h) ((4 + (b) * 2 + (h)) * HTB)
#define PG8_STAGE(bufoff, gbase, voff) do { _Pragma("unroll") for (int _i = 0; _i < 2; ++_i) \
        __builtin_amdgcn_global_load_lds((const unsigned*)((const char*)(gbase) + (voff)[_i]), (PG8_LAS unsigned*)(lds + (bufoff) + ldsw + _i * 8192), 16, 0, 0); } while (0)
#define PG8_LDA(dst, b, h) do { _Pragma("unroll") for (int m = 0; m < 4; ++m) _Pragma("unroll") for (int k = 0; k < 2; ++k) dst[m][k] = *(const PG8_LAS bf16x8*)(lds + PG8_SA(b, h) + aoff + m * 2048 + k * 1024); } while (0)
#define PG8_LDB(dst, b, h) do { _Pragma("unroll") for (int n = 0; n < 2; ++n) _Pragma("unroll") for (int k = 0; k < 2; ++k) dst[n][k] = *(const PG8_LAS bf16x8*)(lds + PG8_SB(b, h) + boff + n * 2048 + k * 1024); } while (0)
#define PG8_MMA(ai, bj, At, Bt) do { __builtin_amdgcn_s_setprio(1); _Pragma("unroll") for (int m = 0; m < 4; ++m) _Pragma("unroll") for (int n = 0; n < 2; ++n) _Pragma("unroll") for (int k = 0; k < 2; ++k) \
        acc[ai][bj][m][n] = __builtin_amdgcn_mfma_f32_16x16x32_bf16(Bt[n][k], At[m][k], acc[ai][bj][m][n], 0, 0, 0); __builtin_amdgcn_s_setprio(0); } while (0)
#define PG8_WAIT_V(n) asm volatile("s_waitcnt vmcnt(" #n ")" ::: "memory")
#define PG8_WAIT_L(n) asm volatile("s_waitcnt lgkmcnt(" #n ")" ::: "memory")
#define PG8_BAR __builtin_amdgcn_s_barrier()
#define PG8_SCHED __builtin_amdgcn_sched_barrier(0)
    Unit cur, nxt; int ui = 0;
    if (!S.next(0, cur)) return;
    f32x4 acc[2][2][4][2];
#pragma unroll
    for (int a = 0; a < 2; ++a)
#pragma unroll
        for (int b = 0; b < 2; ++b)
#pragma unroll
            for (int m = 0; m < 4; ++m)
#pragma unroll
                for (int n = 0; n < 2; ++n) acc[a][b][m][n] = (f32x4){0.f, 0.f, 0.f, 0.f};
    bf16x8 At[4][2], B0[2][2], B1[2][2];
    const char* cA = (const char*)g.A + (size_t)cur.pm * tstep + (size_t)(cur.pm >> 3) * g.askip + (size_t)cur.kofs * 2; const char* cB = (const char*)g.Bt + (size_t)cur.pn * tstep + (size_t)cur.kofs * 2;
    S.a_ready(cur);
    if constexpr (SP2) {
        PG8_STAGE(PG8_SB(0, 0), cB, voffB); PG8_STAGE(PG8_SB(0, 1), cB + hstep, voffB); PG8_STAGE(PG8_SA(0, 0), cA, voffA); PG8_STAGE(PG8_SA(0, 1), cA + hstep, voffA);
        if (wr == 1) PG8_BAR;
        PG8_WAIT_V(2); PG8_BAR;
        PG8_STAGE(PG8_SB(1, 0), cB + kstep, voffB); PG8_STAGE(PG8_SA(1, 0), cA + kstep, voffA); PG8_STAGE(PG8_SB(1, 1), cB + hstep + kstep, voffB);
        PG8_WAIT_V(6); PG8_BAR;
    } else {
        PG8_STAGE(PG8_SB(0, 0), cB, voffB); PG8_STAGE(PG8_SA(0, 0), cA, voffA); PG8_STAGE(PG8_SB(0, 1), cB + hstep, voffB); PG8_STAGE(PG8_SA(0, 1), cA + hstep, voffA);
        if (wr == 1) PG8_BAR;
        PG8_WAIT_V(4); PG8_BAR;
        PG8_STAGE(PG8_SB(1, 0), cB + kstep, voffB); PG8_STAGE(PG8_SA(1, 0), cA + kstep, voffA); PG8_STAGE(PG8_SB(1, 1), cB + hstep + kstep, voffB);
        PG8_WAIT_V(6); PG8_BAR;
    }
    if constexpr (Epi::PRELOAD) E.preload(acc, cur, wr, wc, fr, fq);
    for (;;) {
        const bool has_next = S.next(ui + 1, nxt);
        const char* nA = has_next ? (const char*)g.A + (size_t)nxt.pm * tstep + (size_t)(nxt.pm >> 3) * g.askip + (size_t)nxt.kofs * 2 : cA; const char* nB = has_next ? (const char*)g.Bt + (size_t)nxt.pn * tstep + (size_t)nxt.kofs * 2 : cB;
        int t = 0;
#define PG8_SP2_TRIP(ST11, W1, W2, W3) do { \
            PG8_LDB(B0, 0, 0); PG8_LDB(B1, 0, 1); PG8_SCHED; PG8_LDA(At, 0, 0); if (ST11) PG8_STAGE(PG8_SA(1, 1), a1 + hstep, voffA); \
            PG8_WAIT_V(W1); PG8_WAIT_L(0); PG8_BAR; PG8_MMA(0, 0, At, B0); PG8_MMA(0, 1, At, B1); PG8_BAR; PG8_SCHED; \
            PG8_LDA(At, 0, 1); PG8_STAGE(PG8_SB(0, 0), b2, voffB); PG8_STAGE(PG8_SB(0, 1), b2 + hstep, voffB); PG8_STAGE(PG8_SA(0, 0), a2, voffA); \
            PG8_WAIT_V(W2); PG8_WAIT_L(0); PG8_BAR; PG8_MMA(1, 0, At, B0); PG8_MMA(1, 1, At, B1); PG8_BAR; PG8_SCHED; \
            PG8_LDB(B0, 1, 0); PG8_LDB(B1, 1, 1); PG8_SCHED; PG8_LDA(At, 1, 0); PG8_STAGE(PG8_SA(0, 1), a2 + hstep, voffA); \
            PG8_WAIT_V(W3); PG8_WAIT_L(0); PG8_BAR; PG8_MMA(0, 0, At, B0); PG8_MMA(0, 1, At, B1); PG8_BAR; PG8_SCHED; \
            PG8_LDA(At, 1, 1); PG8_STAGE(PG8_SB(1, 0), b3, voffB); PG8_STAGE(PG8_SB(1, 1), b3 + hstep, voffB); PG8_STAGE(PG8_SA(1, 0), a3, voffA); \
            PG8_WAIT_V(8); PG8_WAIT_L(0); PG8_BAR; PG8_MMA(1, 0, At, B0); PG8_MMA(1, 1, At, B1); PG8_BAR; PG8_SCHED; } while (0)
        if constexpr (SP2 && ALIGN_EPI && Epi::SLACK) {
            if (ui > 0 && E.slack_ok()) {
                const char* a1 = cA + kstep; const char* a2 = cA + 2 * kstep; const char* b2 = cB + 2 * kstep; const char* a3 = a2 + kstep; const char* b3 = b2 + kstep;
                PG8_SP2_TRIP(false, 24, 24, 24);
                t = 2;
            }
        }
        for (; t < nt; t += 2) {
            const bool last = (t == nt - 2);
            const char* a1 = cA + (size_t)(t + 1) * kstep;
            const char* a2 = last ? nA : cA + (size_t)(t + 2) * kstep; const char* b2 = last ? nB : cB + (size_t)(t + 2) * kstep;
            const char* a3 = a2 + kstep; const char* b3 = b2 + kstep;
            if (last && has_next) S.a_ready(nxt);
            if constexpr (SP2) {
            PG8_SP2_TRIP(true, 8, 8, 8);
            } else {
            PG8_LDB(B0, 0, 0); PG8_SCHED; PG8_LDA(At, 0, 0); PG8_STAGE(PG8_SA(1, 1), a1 + hstep, voffA);
            PG8_WAIT_L(8); PG8_BAR; PG8_WAIT_L(0); PG8_MMA(0, 0, At, B0); PG8_BAR; PG8_SCHED;
            PG8_LDB(B1, 0, 1); PG8_STAGE(PG8_SB(0, 0), b2, voffB);
            PG8_BAR; PG8_WAIT_L(0); PG8_MMA(0, 1, At, B1); PG8_BAR;
            PG8_LDA(At, 0, 1); PG8_STAGE(PG8_SA(0, 0), a2, voffA);
            PG8_BAR; PG8_WAIT_L(0); PG8_MMA(1, 0, At, B0); PG8_BAR; PG8_SCHED;
            PG8_STAGE(PG8_SB(0, 1), b2 + hstep, voffB);
            PG8_WAIT_V(6); PG8_BAR; PG8_MMA(1, 1, At, B1); PG8_BAR;
            PG8_LDB(B0, 1, 0); PG8_SCHED; PG8_LDA(At, 1, 0); PG8_STAGE(PG8_SA(0, 1), a2 + hstep, voffA);
            PG8_WAIT_L(8); PG8_BAR; PG8_WAIT_L(0); PG8_MMA(0, 0, At, B0); PG8_BAR; PG8_SCHED;
            PG8_LDB(B1, 1, 1); PG8_STAGE(PG8_SB(1, 0), b3, voffB);
            PG8_BAR; PG8_WAIT_L(0); PG8_MMA(0, 1, At, B1); PG8_BAR;
            PG8_LDA(At, 1, 1); PG8_STAGE(PG8_SA(1, 0), a3, voffA);
            PG8_BAR; PG8_WAIT_L(0); PG8_MMA(1, 0, At, B0); PG8_BAR; PG8_SCHED;
            PG8_STAGE(PG8_SB(1, 1), b3 + hstep, voffB);
            PG8_WAIT_V(6); PG8_BAR; PG8_MMA(1, 1, At, B1); PG8_BAR;
            }
        }
        if constexpr (ALIGN_EPI) { if (wr == 0) PG8_BAR; }
        if constexpr (SP2 && ALIGN_EPI && Epi::SLACK) { if (has_next && E.slack_ok()) PG8_STAGE(PG8_SA(1, 1), nA + kstep + hstep, voffA); }
        bool chain_first = false;
        if constexpr (Epi::MID) { chain_first = (cur.kofs == 0); }
        if constexpr (!Epi::AFTER_DRAIN) { if (chain_first) E.mid(acc, cur, wr, wc, fr, fq); else { E(acc, cur, wr, wc, fr, fq); S.done(cur); } }
        if (!has_next) break;
        if constexpr (Epi::PRELOAD) E.preload(acc, nxt, wr, wc, fr, fq);
        else if (!chain_first)
#pragma unroll
        for (int a = 0; a < 2; ++a)
#pragma unroll
            for (int b = 0; b < 2; ++b)
#pragma unroll
                for (int m = 0; m < 4; ++m)
#pragma unroll
                    for (int n = 0; n < 2; ++n) acc[a][b][m][n] = (f32x4){0.f, 0.f, 0.f, 0.f};
        cur = nxt; cA = nA; cB = nB; ++ui;
        if constexpr (ALIGN_EPI) { if (wr == 1) PG8_BAR; }
    }
    PG8_WAIT_V(0);
    if constexpr (!ALIGN_EPI) { if (wr == 0) PG8_BAR; }
    PG8_BAR;
    if constexpr (Epi::AFTER_DRAIN) { E.fused(acc, cur, wr, wc, fr, fq, lds, wid, lane); S.done(cur); }
#undef PG8_SP2_TRIP
#undef PG8_SA
#undef PG8_SB
#undef PG8_STAGE
#undef PG8_LDA
#undef PG8_LDB
#undef PG8_MMA
#undef PG8_WAIT_V
#undef PG8_WAIT_L
#undef PG8_BAR
#undef PG8_SCHED
}
}

namespace sba {
using bf16x8 = __attribute__((ext_vector_type(8))) short;
using s16x4  = __attribute__((ext_vector_type(4))) short;
using f32x16 = __attribute__((ext_vector_type(16))) float;
using u32x4  = __attribute__((ext_vector_type(4))) unsigned;
typedef _Float16 half8 __attribute__((ext_vector_type(8)));
typedef float f32x4 __attribute__((ext_vector_type(4)));
typedef _Float16 half2v __attribute__((ext_vector_type(2)));
typedef float float2v __attribute__((ext_vector_type(2)));
constexpr int KVBLK = 64;
constexpr int SHM_V = KVBLK * 128 * 2, SHM_K = KVBLK * 128 * 2;
constexpr int OFF_V = 0, OFF_K = 2 * SHM_V, OFF_FLAG = 2 * SHM_V + 2 * SHM_K;
#define KSWZ(row, colB) ((row) * 256 + ((colB) ^ (((row) & 7) << 4)))
#define SBAR() __builtin_amdgcn_sched_barrier(0)
__device__ __forceinline__ int crow(int r, int hi) { return (r & 3) + 8 * (r >> 2) + 4 * hi; }
__device__ __forceinline__ unsigned cvtpk(float lo, float hi) { unsigned r; asm volatile("v_cvt_pk_bf16_f32 %0, %1, %2" : "=v"(r) : "v"(lo), "v"(hi)); return r; }
__device__ __forceinline__ void qkt(f32x16& p0, f32x16& p1, const char* Ks, const bf16x8* qr, int r32, int hi) {
  p0 = f32x16{}; p1 = f32x16{};
#pragma unroll
  for (int d0 = 0; d0 < 8; ++d0) { const int cb = (d0 * 16 + hi * 8) * 2;
    const bf16x8 b0 = *reinterpret_cast<const bf16x8*>(Ks + KSWZ(r32, cb));
    const bf16x8 b1 = *reinterpret_cast<const bf16x8*>(Ks + KSWZ(32 + r32, cb));
    p0 = __builtin_amdgcn_mfma_f32_32x32x16_bf16(b0, qr[d0], p0, 0, 0, 0);
    p1 = __builtin_amdgcn_mfma_f32_32x32x16_bf16(b1, qr[d0], p1, 0, 0, 0); }
}
__device__ __forceinline__ int v_st(int k, int c) { const int kk = (k & ~0xC) | ((k & 4) << 1) | ((k & 8) >> 1); return ((kk >> 3) * 4 + (c >> 5)) * 512 + ((kk & 7) * 32 + (c & 31)) * 2; }
__device__ __forceinline__ int v_rd_base(int lane) { return ((lane & 3) << 3) | (((lane >> 2) & 3) << 6) | (((lane >> 4) & 1) << 5) | (((lane >> 5) & 1) << 8); }
constexpr int v_rd_off(int d0, int ks, int half) { return d0 * 512 + ks * 4096 + half * 2048; }
template <int OFF> __device__ __forceinline__ s16x4 tr_read(int vb) {
  s16x4 r; asm volatile("ds_read_b64_tr_b16 %0, %1 offset:%2" : "=&v"(r) : "v"(vb), "i"(OFF) : "memory"); return r;
}
template <int D0> __device__ __forceinline__ void pv_one(f32x16& od, int vb, bf16x8 pa0, bf16x8 pa1, bf16x8 pa2, bf16x8 pa3) {
  const s16x4 l0 = tr_read<v_rd_off(D0, 0, 0)>(vb), h0 = tr_read<v_rd_off(D0, 0, 1)>(vb), l1 = tr_read<v_rd_off(D0, 1, 0)>(vb), h1 = tr_read<v_rd_off(D0, 1, 1)>(vb);
  const s16x4 l2 = tr_read<v_rd_off(D0, 2, 0)>(vb), h2 = tr_read<v_rd_off(D0, 2, 1)>(vb), l3 = tr_read<v_rd_off(D0, 3, 0)>(vb), h3 = tr_read<v_rd_off(D0, 3, 1)>(vb);
  asm volatile("s_waitcnt lgkmcnt(0)" ::: "memory"); SBAR();
#define PK(L, H) (bf16x8){L[0], L[1], L[2], L[3], H[0], H[1], H[2], H[3]}
  od = __builtin_amdgcn_mfma_f32_32x32x16_bf16(pa0, PK(l0, h0), od, 0, 0, 0);
  od = __builtin_amdgcn_mfma_f32_32x32x16_bf16(pa1, PK(l1, h1), od, 0, 0, 0);
  od = __builtin_amdgcn_mfma_f32_32x32x16_bf16(pa2, PK(l2, h2), od, 0, 0, 0);
  od = __builtin_amdgcn_mfma_f32_32x32x16_bf16(pa3, PK(l3, h3), od, 0, 0, 0);
#undef PK
}
struct VFrag { s16x4 l0, h0, l1, h1, l2, h2, l3, h3; };
template <int OFFB> __device__ __forceinline__ void vf_read(VFrag& f, int vb) {
  f.l0 = tr_read<OFFB + v_rd_off(0, 0, 0)>(vb); f.h0 = tr_read<OFFB + v_rd_off(0, 0, 1)>(vb); f.l1 = tr_read<OFFB + v_rd_off(0, 1, 0)>(vb); f.h1 = tr_read<OFFB + v_rd_off(0, 1, 1)>(vb);
  f.l2 = tr_read<OFFB + v_rd_off(0, 2, 0)>(vb); f.h2 = tr_read<OFFB + v_rd_off(0, 2, 1)>(vb); f.l3 = tr_read<OFFB + v_rd_off(0, 3, 0)>(vb); f.h3 = tr_read<OFFB + v_rd_off(0, 3, 1)>(vb);
}
__device__ __forceinline__ void vf_mma(f32x16& od, const VFrag& f, bf16x8 pa0, bf16x8 pa1, bf16x8 pa2, bf16x8 pa3) {
#define PK(L, H) (bf16x8){L[0], L[1], L[2], L[3], H[0], H[1], H[2], H[3]}
  od = __builtin_amdgcn_mfma_f32_32x32x16_bf16(pa0, PK(f.l0, f.h0), od, 0, 0, 0);
  od = __builtin_amdgcn_mfma_f32_32x32x16_bf16(pa1, PK(f.l1, f.h1), od, 0, 0, 0);
  od = __builtin_amdgcn_mfma_f32_32x32x16_bf16(pa2, PK(f.l2, f.h2), od, 0, 0, 0);
  od = __builtin_amdgcn_mfma_f32_32x32x16_bf16(pa3, PK(f.l3, f.h3), od, 0, 0, 0);
#undef PK
}
#define LGK_WAIT(n) do { asm volatile("s_waitcnt lgkmcnt(" #n ")" ::: "memory"); SBAR(); } while (0)
__device__ __forceinline__ void pv_pipe4(f32x16* o, int vb, bf16x8 pa0, bf16x8 pa1, bf16x8 pa2, bf16x8 pa3) {
  VFrag fa, fb;
  vf_read<0>(fa, vb);
  vf_read<512>(fb, vb);  LGK_WAIT(8); vf_mma(o[0], fa, pa0, pa1, pa2, pa3);
  vf_read<1024>(fa, vb); LGK_WAIT(8); vf_mma(o[1], fb, pa0, pa1, pa2, pa3);
  vf_read<1536>(fb, vb); LGK_WAIT(8); vf_mma(o[2], fa, pa0, pa1, pa2, pa3);
  LGK_WAIT(0); vf_mma(o[3], fb, pa0, pa1, pa2, pa3);
}
__device__ __forceinline__ void pv_pipe8(f32x16* o, int vb, bf16x8 pa0, bf16x8 pa1, bf16x8 pa2, bf16x8 pa3) {
  VFrag fa, fb;
  vf_read<0>(fa, vb);
  vf_read<512>(fb, vb);  LGK_WAIT(8); vf_mma(o[0], fa, pa0, pa1, pa2, pa3);
  vf_read<1024>(fa, vb); LGK_WAIT(8); vf_mma(o[1], fb, pa0, pa1, pa2, pa3);
  vf_read<1536>(fb, vb); LGK_WAIT(8); vf_mma(o[2], fa, pa0, pa1, pa2, pa3);
  vf_read<SHM_V + 0>(fa, vb);    LGK_WAIT(8); vf_mma(o[3], fb, pa0, pa1, pa2, pa3);
  vf_read<SHM_V + 512>(fb, vb);  LGK_WAIT(8); vf_mma(o[4], fa, pa0, pa1, pa2, pa3);
  vf_read<SHM_V + 1024>(fa, vb); LGK_WAIT(8); vf_mma(o[5], fb, pa0, pa1, pa2, pa3);
  vf_read<SHM_V + 1536>(fb, vb); LGK_WAIT(8); vf_mma(o[6], fa, pa0, pa1, pa2, pa3);
  LGK_WAIT(0); vf_mma(o[7], fb, pa0, pa1, pa2, pa3);
}
__device__ __forceinline__ void pv_d0(f32x16* o, int vb, bf16x8 pa0, bf16x8 pa1, bf16x8 pa2, bf16x8 pa3) {
  pv_one<0>(o[0], vb, pa0, pa1, pa2, pa3); pv_one<1>(o[1], vb, pa0, pa1, pa2, pa3); pv_one<2>(o[2], vb, pa0, pa1, pa2, pa3); pv_one<3>(o[3], vb, pa0, pa1, pa2, pa3);
}
__device__ __forceinline__ half8 pack_h8(const f32x16& l, int base) {
  half8 r;
#pragma unroll
  for (int j = 0; j < 8; j += 2) { const float2v f = {l[base + j], l[base + j + 1]}; const half2v hh = __builtin_convertvector(f, half2v); r[j] = hh[0]; r[j + 1] = hh[1]; }
  return r;
}
template <bool BAND>
__device__ __forceinline__ void sb_half(f32x16& p, float& R, const half8 U0, const half8 U1, int kbase, int row_rel, int hi) {
  f32x16 l;
#pragma unroll
  for (int r = 0; r < 16; ++r) {
    const float z = fminf(p[r], 80.0f); p[r] = z;
    float lv = -__builtin_amdgcn_logf(1.0f + __builtin_amdgcn_exp2f(z));
    if (BAND) lv = (kbase + crow(r, hi) < row_rel) ? lv : 0.0f;
    l[r] = lv;
  }
  const half8 lf0 = pack_h8(l, 0), lf1 = pack_h8(l, 8);
  f32x16 E = __builtin_amdgcn_mfma_f32_32x32x16_f16(U0, lf0, f32x16{}, 0, 0, 0);
  E = __builtin_amdgcn_mfma_f32_32x32x16_f16(U1, lf1, E, 0, 0, 0);
#pragma unroll
  for (int r = 0; r < 16; ++r) {
    float w = __builtin_amdgcn_exp2f((p[r] + R) + (l[r] + E[r]));
    if (BAND) w = (kbase + crow(r, hi) < row_rel) ? w : 0.0f;
    p[r] = w;
  }
  const float tot = E[0] + l[0];
  const auto rr = __builtin_amdgcn_permlane32_swap(__float_as_uint(tot), __float_as_uint(tot), false, false);
  R += __uint_as_float(rr[0]);
}
#define PK4(P, BASE, OUT) do { unsigned a0 = cvtpk(P[BASE + 0], P[BASE + 1]), a1 = cvtpk(P[BASE + 2], P[BASE + 3]);   \
    unsigned b0 = cvtpk(P[BASE + 4], P[BASE + 5]), b1 = cvtpk(P[BASE + 6], P[BASE + 7]);                              \
    auto r0 = __builtin_amdgcn_permlane32_swap(a0, b0, false, false); auto r1 = __builtin_amdgcn_permlane32_swap(a1, b1, false, false); \
    u32x4 w = {r0[0], r1[0], r0[1], r1[1]}; OUT = *reinterpret_cast<bf16x8*>(&w); } while (0)

__device__ __forceinline__ void glds16(const void* g, unsigned lds_base) {
  unsigned sv; asm volatile("s_mov_b32 %0, m0\n\ts_mov_b32 m0, %2\n\ts_nop 0\n\tglobal_load_lds_dwordx4 %1, off\n\ts_mov_b32 m0, %0" : "=&s"(sv) : "v"(g), "s"(lds_base) : "memory"); }
#define VM_WAIT(n) do { asm volatile("s_waitcnt vmcnt(" #n ")" ::: "memory"); SBAR(); } while (0)
constexpr int R_SHM_V = 2 * SHM_V, R_OFF_V = 0, R_OFF_K = 2 * R_SHM_V;
__device__ __forceinline__ void ret_unit(int b, int h, int qb, unsigned char* act, char* lds, bool dry) {
  int tid = threadIdx.x; asm volatile("" : "+v"(tid));
  const int wid = __builtin_amdgcn_readfirstlane(tid >> 6), lane = tid & 63, r32 = lane & 31, hi = lane >> 5;
  const bf16* RQK = (const bf16*)(act + A_RQK + (size_t)b * SKIP2K); const bf16* RV = (const bf16*)(act + A_RV + (size_t)b * SKIP2K); bf16* GS = (bf16*)(act + A_GS + (size_t)b * SKIP4K);
  char* V_lds = lds + R_OFF_V; char* K_lds = lds + R_OFF_K;
  const int q0 = qb * 256;
  bf16x8 qr[8];
  { const bf16* Qw = RQK + (size_t)(b * SEQ + q0 + wid * 32 + r32) * 1024 + h * 128 + hi * 8;
#pragma unroll
    for (int d0 = 0; d0 < 8; ++d0) qr[d0] = *reinterpret_cast<const bf16x8*>(Qw + d0 * 16); }
  const bf16* Kh = RQK + (size_t)(b * SEQ) * 1024 + 512 + h * 128; const bf16* Vh = RV + (size_t)(b * SEQ) * 1024 + h * 256;
  const int vb0 = (int)(uintptr_t)V_lds + v_rd_base(lane);
  const unsigned lds0 = (unsigned)__builtin_amdgcn_readfirstlane((int)(uintptr_t)lds);
  const int krow = lane >> 4, kch = lane & 15;
  const bf16* ksrcE = Kh + (size_t)(8 * wid + krow) * 1024 + (((kch * 16) ^ (krow << 4)) >> 1);
  const bf16* ksrcO = Kh + (size_t)(8 * wid + 4 + krow) * 1024 + (((kch * 16) ^ ((4 + krow) << 4)) >> 1);
  const int kkv = 8 * wid + ((lane & 31) >> 2), kv = (kkv & ~0xC) | ((kkv & 4) << 1) | ((kkv & 8) >> 1);
  const bf16* vsrc = Vh + (size_t)kv * 1024 + (lane >> 5) * 32 + (lane & 3) * 8;
#define SDMA(k0, bb) do { const size_t ro_ = (size_t)(k0) * 1024; const unsigned kd_ = lds0 + R_OFF_K + (bb) * SHM_K + wid * 2048, vd_ = lds0 + R_OFF_V + (bb) * R_SHM_V + wid * 2048; \
    glds16(ksrcE + ro_, kd_); glds16(ksrcO + ro_, kd_ + 1024); \
    glds16(vsrc + ro_, vd_); glds16(vsrc + ro_ + 64, vd_ + 1024); glds16(vsrc + ro_ + 128, vd_ + SHM_V); glds16(vsrc + ro_ + 192, vd_ + SHM_V + 1024); } while (0)
  f32x16 o[8] = {};
  const int NT = 4 * qb + 4, row_rel = 32 * wid + r32;
  SDMA((NT - 1) * KVBLK, 0);
  VM_WAIT(0); __syncthreads();
  int cur = 0;
  for (int jt = NT - 1; jt >= 0; --jt) {
    const int kb = 64 * (jt - 4 * qb);
    if (jt >= 1) SDMA((jt - 1) * KVBLK, cur ^ 1);
    {
      f32x16 p0, p1; bf16x8 pa0, pa1, pa2, pa3;
      SBAR(); qkt(p0, p1, K_lds + cur * SHM_K, qr, r32, hi);
      if (kb >= 0) {
#pragma unroll
        for (int r = 0; r < 16; ++r) { const int kr = kb + crow(r, hi); p0[r] = (kr <= row_rel) ? p0[r] : 0.0f; p1[r] = (kr + 32 <= row_rel) ? p1[r] : 0.0f; }
      }
      PK4(p0, 0, pa0); PK4(p0, 8, pa1); PK4(p1, 0, pa2); PK4(p1, 8, pa3);
      LGK_WAIT(0); pv_pipe8(o, vb0 + cur * R_SHM_V, pa0, pa1, pa2, pa3);
    }
    VM_WAIT(0);
    __syncthreads();
    cur ^= 1;
  }
#undef SDMA
  { float* stg = (float*)(lds + wid * 16384);
    const int row = lane >> 1, hc = lane & 1;
    f32x4 x[32]; float sm = 0.f, sq = 0.f;
#pragma unroll
    for (int hf = 0; hf < 2; ++hf) {
#pragma unroll
      for (int r = 0; r < 16; ++r) { const int orow = crow(r, hi);
#pragma unroll
        for (int d0 = 0; d0 < 4; ++d0) stg[orow * 128 + d0 * 32 + r32] = o[hf * 4 + d0][r]; }
      asm volatile("s_waitcnt lgkmcnt(0)" ::: "memory");
#pragma unroll
      for (int i = 0; i < 16; ++i) { const f32x4 v = *(const f32x4*)(stg + row * 128 + hc * 64 + i * 4); x[hf * 16 + i] = v;
        sm += (v[0] + v[1]) + (v[2] + v[3]); sq += (v[0] * v[0] + v[1] * v[1]) + (v[2] * v[2] + v[3] * v[3]); }
      asm volatile("s_waitcnt lgkmcnt(0)" ::: "memory");
    }
    sm += __shfl_xor(sm, 1); sq += __shfl_xor(sq, 1);
    const float mean = sm * (1.0f / 256.0f), var = fmaxf(sq * (1.0f / 256.0f) - mean * mean, 0.0f), rstd = rsqrtf(var + GN_EPS);
    bf16* gp = GS + (size_t)(b * SEQ + q0 + wid * 32 + row) * 2048 + h * 256 + hc * 64;
    u32x4 gwv[2][8];
#pragma unroll
    for (int hf = 0; hf < 2; ++hf)
#pragma unroll
      for (int i = 0; i < 8; ++i) gwv[hf][i] = *(const u32x4*)(gp + hf * 128 + i * 8);
    asm volatile("" ::: "memory");
#pragma unroll
    for (int hf = 0; hf < 2; ++hf)
#pragma unroll
      for (int i = 0; i < 8; ++i) {
        bf16* gq = gp + hf * 128 + i * 8;
        const u32x4 gw = gwv[hf][i];
        const f32x4 a = x[hf * 16 + 2 * i], c = x[hf * 16 + 2 * i + 1];
        u32x4 ow;
        ow[0] = cvtpk((a[0] - mean) * rstd * __builtin_bit_cast(float, gw[0] << 16), (a[1] - mean) * rstd * __builtin_bit_cast(float, gw[0] & 0xffff0000u));
        ow[1] = cvtpk((a[2] - mean) * rstd * __builtin_bit_cast(float, gw[1] << 16), (a[3] - mean) * rstd * __builtin_bit_cast(float, gw[1] & 0xffff0000u));
        ow[2] = cvtpk((c[0] - mean) * rstd * __builtin_bit_cast(float, gw[2] << 16), (c[1] - mean) * rstd * __builtin_bit_cast(float, gw[2] & 0xffff0000u));
        ow[3] = cvtpk((c[2] - mean) * rstd * __builtin_bit_cast(float, gw[3] << 16), (c[3] - mean) * rstd * __builtin_bit_cast(float, gw[3] & 0xffff0000u));
        if (!dry) *(u32x4*)gq = ow;
      }
  }
  __syncthreads();
}
__device__ __forceinline__ void ret_phase(unsigned char* act, char* lds, bool dry, int bx) {
  const int NU = BG * 4 * 8;
  for (int u = bx; u < NU; u += gridDim.x) {
    const int qb = 7 - u / (NU / 8), b = u & 7, h = (u >> 3) & 3;
    ret_unit(b, h, qb, act, lds, dry);
  }
}
template <int D0> __device__ __forceinline__ void pv32_read(s16x4 (&f)[4], int vb) {
  f[0] = tr_read<v_rd_off(D0, 0, 0)>(vb); f[1] = tr_read<v_rd_off(D0, 0, 1)>(vb); f[2] = tr_read<v_rd_off(D0, 1, 0)>(vb); f[3] = tr_read<v_rd_off(D0, 1, 1)>(vb);
}
__device__ __forceinline__ void pv32_mma(f32x16& od, const s16x4 (&f)[4], bf16x8 pa0, bf16x8 pa1) {
  od = __builtin_amdgcn_mfma_f32_32x32x16_bf16(pa0, (bf16x8){f[0][0], f[0][1], f[0][2], f[0][3], f[1][0], f[1][1], f[1][2], f[1][3]}, od, 0, 0, 0);
  od = __builtin_amdgcn_mfma_f32_32x32x16_bf16(pa1, (bf16x8){f[2][0], f[2][1], f[2][2], f[2][3], f[3][0], f[3][1], f[3][2], f[3][3]}, od, 0, 0, 0);
}
__device__ __forceinline__ void sbw_unit(int b, int h, int rb, unsigned char* act, char* wlds, bool dry) {
  int tid = threadIdx.x; asm volatile("" : "+v"(tid));
  const int lane = tid & 63, r32 = lane & 31, hi = lane >> 5;
  const bf16* GS = (const bf16*)(act + A_GS + (size_t)b * SKIP4K); const bf16* SK = (const bf16*)(act + A_SK + (size_t)b * SKIP2K); const bf16* SV = (const bf16*)(act + A_SV + (size_t)b * SKIP2K);
  char* K_l = wlds;
  const unsigned k_lds = (unsigned)__builtin_amdgcn_readfirstlane((int)(uintptr_t)wlds), v_lds = k_lds + 8192u;
  const int q0 = rb * 32;
  half8 U0, U1;
#pragma unroll
  for (int j = 0; j < 8; ++j) { const int kp = 8 * (j >> 2) + 4 * hi + (j & 3); U0[j] = (kp > r32) ? (_Float16)1.0f : (_Float16)0.0f; U1[j] = (16 + kp > r32) ? (_Float16)1.0f : (_Float16)0.0f; }
  bf16x8 qr[8];
  { const bf16* Qw = GS + (size_t)(b * SEQ + q0 + r32) * 2048 + 1024 + h * 128 + hi * 8;
#pragma unroll
    for (int d0 = 0; d0 < 8; ++d0) qr[d0] = *reinterpret_cast<const bf16x8*>(Qw + d0 * 16); }
  const bf16* Kh = SK + (size_t)(b * SEQ) * 1024 + h * 128; const bf16* Vh = SV + (size_t)(b * SEQ) * 1024 + h * 128;
  const int krow = lane >> 4, kch = lane & 15;
  const bf16* ksrc0 = Kh + (size_t)krow * 1024 + (((kch * 16) ^ (krow << 4)) >> 1);
  const bf16* ksrc1 = Kh + (size_t)(4 + krow) * 1024 + (((kch * 16) ^ ((4 + krow) << 4)) >> 1);
  const int vkl = (lane & 31) >> 2, vcc = (lane & 3) * 8, vhalf = lane >> 5;
#define KDMA(kt) do { const bf16* s0_ = ksrc0 + (size_t)(kt) * 32 * 1024; const bf16* s1_ = ksrc1 + (size_t)(kt) * 32 * 1024; \
    _Pragma("unroll") for (int q_ = 0; q_ < 4; ++q_) { glds16(s0_ + (size_t)q_ * 8 * 1024, k_lds + q_ * 2048); glds16(s1_ + (size_t)q_ * 8 * 1024, k_lds + q_ * 2048 + 1024); } } while (0)
#define VDMA(kt) do { const bf16* vb_ = Vh + (size_t)(kt) * 32 * 1024 + vcc; \
    _Pragma("unroll") for (int q_ = 0; q_ < 8; ++q_) { const int kk_ = 8 * (q_ >> 1) + vkl, k_ = (kk_ & ~0xC) | ((kk_ & 4) << 1) | ((kk_ & 8) >> 1); \
      glds16(vb_ + (size_t)k_ * 1024 + (2 * (q_ & 1) + vhalf) * 32, v_lds + q_ * 1024); } } while (0)
  const int vb = (int)v_lds + v_rd_base(lane);
  f32x16 o[4] = {}; float R = 0.f;
  KDMA(rb); VDMA(rb);
  for (int kt = rb; kt >= 0; --kt) {
    VM_WAIT(8);
    f32x16 p = {};
#pragma unroll
    for (int d0 = 0; d0 < 8; ++d0) { const bf16x8 kf = *reinterpret_cast<const bf16x8*>(K_l + KSWZ(r32, (d0 * 16 + hi * 8) * 2)); p = __builtin_amdgcn_mfma_f32_32x32x16_bf16(kf, qr[d0], p, 0, 0, 0); }
    LGK_WAIT(0);
    if (kt > 0) KDMA(kt - 1);
    if (kt == rb) sb_half<true>(p, R, U0, U1, 0, r32, hi); else sb_half<false>(p, R, U0, U1, 0, 0, hi);
    bf16x8 pa0, pa1; PK4(p, 0, pa0); PK4(p, 8, pa1);
    if (kt > 0) VM_WAIT(8); else VM_WAIT(0);
    { s16x4 f0[4], f1[4], f2[4], f3[4];
      pv32_read<0>(f0, vb); pv32_read<1>(f1, vb); pv32_read<2>(f2, vb); pv32_read<3>(f3, vb);
      LGK_WAIT(0);
      if (kt > 0) VDMA(kt - 1);
      pv32_mma(o[0], f0, pa0, pa1); pv32_mma(o[1], f1, pa0, pa1); pv32_mma(o[2], f2, pa0, pa1); pv32_mma(o[3], f3, pa0, pa1); }
    if (__all(R < -160.0f)) break;
  }
  VM_WAIT(0);
  { bf16* stg = (bf16*)wlds;
#pragma unroll
    for (int r = 0; r < 16; ++r) { const int orow = crow(r, hi);
#pragma unroll
      for (int d0 = 0; d0 < 4; ++d0) stg[orow * 128 + d0 * 32 + r32] = (bf16)f2bf(o[d0][r]); }
    asm volatile("s_waitcnt lgkmcnt(0)" ::: "memory");
    bf16* Ow = (bf16*)GS + (size_t)(b * SEQ + q0) * 2048 + 1024 + h * 128;
#pragma unroll
    for (int i = 0; i < 8; ++i) { const int row = i * 4 + (lane >> 4), ch = lane & 15; const u32x4 v = *(const u32x4*)(stg + row * 128 + ch * 8); if (!dry) *(u32x4*)(Ow + (size_t)row * 2048 + ch * 8) = v; }
    asm volatile("s_waitcnt lgkmcnt(0)" ::: "memory");
  }
#undef KDMA
#undef VDMA
}
__device__ __forceinline__ void sb_phase(unsigned char* act, char* lds, bool dry, unsigned* ctr, int bx) {
  const int NU = BG * 8 * 64;
  int tid = threadIdx.x; asm volatile("" : "+v"(tid));
  const int wid = __builtin_amdgcn_readfirstlane(tid >> 6), lane = tid & 63;
  char* wlds = lds + wid * 16384;
  const int x = bx & 7, v = (bx >> 3) * 8 + wid;
  int u = (8 * x + (v >> 6)) * 64 + (v & 63);
  unsigned* myctr = ctr + 64 * 16 * (1 + x);
  while (u < NU) {
    unsigned nx = 0u;
    if (lane == 0) nx = __hip_atomic_fetch_add(myctr, 1u, __ATOMIC_RELAXED, __HIP_MEMORY_SCOPE_AGENT);
    const int rb = 63 - (u & 63), bh = u >> 6;
    sbw_unit(bh >> 3, bh & 7, rb, act, wlds, dry);
    const int n = (int)__builtin_amdgcn_readfirstlane(nx);
    u = (n < 256) ? (8 * x + 4 + (n >> 6)) * 64 + (n & 63) : NU;
  }
}
#undef VM_WAIT
#undef PK4
#undef KSWZ
#undef LGK_WAIT
#undef SBAR
}

#define LAS __attribute__((address_space(3)))
typedef unsigned v4u __attribute__((ext_vector_type(4)));
#define LDS_WAIT() asm volatile("s_waitcnt lgkmcnt(0)" ::: "memory")
constexpr int NWAVES = 8;
constexpr int LDS_BYTES = 147456;

__device__ __forceinline__ int rho32(int l) { return 16 * ((l >> 2) & 1) + 4 * (l >> 3) + (l & 3); }
__device__ __forceinline__ int pos_win(int c) {
    if (c < 1024) { const int hh = c >> 7, j = c & 127, n = j >> 6, jj = j & 63; return 256 * (hh >> 1) + 128 * (hh & 1) + 32 * (jj >> 4) + 16 * n + (jj & 15); }
    if (c < 6144) return (c & ~31) + rho32(c & 31);
    const int isb = (c >= 7168) ? 1 : 0, ch = (c - 6144) & 1023, j = ch >> 7, w = ch & 127;
    return 256 * (24 + j) + 128 * isb + (w & ~31) + rho32(w & 31);
}
enum { KIND_NAT = 0, KIND_P32 = 1, KIND_WIN = 2 };
__device__ __forceinline__ void tr_item(const float* __restrict__ W, int N, bf16* __restrict__ WT, int ldt, int koff, int kind, const float* __restrict__ gain, LAS float* scr, int item, int lane) {
    const int nblk = N / 32, kb = item / nblk, nb = item % nblk, k0 = 64 * kb, n0 = 32 * nb;
    float wv[32];
#pragma unroll
    for (int i = 0; i < 32; ++i) wv[i] = W[(size_t)(k0 + 2 * i + (lane >> 5)) * N + n0 + (lane & 31)];
#pragma unroll
    for (int i = 0; i < 32; ++i) scr[(2 * i + (lane >> 5)) * 33 + (lane & 31)] = wv[i];
    LDS_WAIT(); asm volatile("" ::: "memory");
    const int c = lane & 7;
    float gn[8];
#pragma unroll
    for (int i = 0; i < 8; ++i) gn[i] = gain ? gain[k0 + 8 * c + i] : 1.0f;
#pragma unroll
    for (int j = 0; j < 4; ++j) {
        const int n = (lane >> 3) + 8 * j, cl = n0 + n; int pos = cl; float sc = 1.0f;
        if (kind == KIND_P32) pos = (cl & ~31) + rho32(cl & 31);
        else if (kind == KIND_WIN) { pos = pos_win(cl); if (cl >= 512 && cl < 1024) sc = KR_SCALE; else if (cl >= 3072 && cl < 4096) sc = QS_SCALE; }
        const LAS float* s = scr + (8 * c) * 33 + n;
        v4u o; o.x = pk2(s[0 * 33] * gn[0] * sc, s[1 * 33] * gn[1] * sc); o.y = pk2(s[2 * 33] * gn[2] * sc, s[3 * 33] * gn[3] * sc);
        o.z = pk2(s[4 * 33] * gn[4] * sc, s[5 * 33] * gn[5] * sc); o.w = pk2(s[6 * 33] * gn[6] * sc, s[7 * 33] * gn[7] * sc);
        *(v4u*)(WT + (size_t)pos * ldt + koff + k0 + 8 * c) = o;
    }
    LDS_WAIT(); asm volatile("" ::: "memory");
}

#define RLX_AGENT __ATOMIC_RELAXED, __HIP_MEMORY_SCOPE_AGENT
constexpr int RSTD_OFF = 131072 + 8192;
constexpr int MISC_OFF = 131072 + 4096;
constexpr size_t CTL_ZERO_BYTES = 65536;
#define XB_TMO      128
#define XB_XCNT(j)  (256  + 64 * (j))
#define XB_XSUB(j)  (1280 + 64 * (j))
#define XB_XGEN(j)  (2304 + 64 * (j))
#define XB_TOP      3328
#define XB_TOPGEN   3392
#define XCD_BAR_WORDS 3456
#define XB_SPIN_CAP (1u << 18)

__device__ __forceinline__ unsigned xb_ld(unsigned* p)              { return __hip_atomic_load(p, __ATOMIC_RELAXED, __HIP_MEMORY_SCOPE_AGENT); }
__device__ __forceinline__ unsigned xb_add(unsigned* p, unsigned v) { return __hip_atomic_fetch_add(p, v, __ATOMIC_RELAXED, __HIP_MEMORY_SCOPE_AGENT); }
__device__ __forceinline__ unsigned xb_xcc_id() { return (unsigned)__builtin_amdgcn_s_getreg((3 << 11) | 20) & 0xFu; }
#define XB_SPIN(cond, bar) do { unsigned _sp = 0; while (cond) { __builtin_amdgcn_s_sleep(1); \
    if ((++_sp & 255u) == 0u) { if (xb_ld(&(bar)[XB_TMO])) break; if (_sp > XB_SPIN_CAP) { atomicAdd(&(bar)[XB_TMO], 1u); break; } } } } while (0)

struct XcdBarrier {
    unsigned* bar; unsigned x;
    volatile LAS unsigned* st;
};

__device__ __forceinline__ XcdBarrier xcd_barrier_post(unsigned* bar, volatile LAS unsigned* st) {
    XcdBarrier b; b.bar = bar; b.x = xb_xcc_id(); b.st = st;
    if (threadIdx.x == 0) st[2] = xb_add(&bar[XB_XCNT(b.x)], 1u);
    return b;
}
__device__ __forceinline__ void xcd_barrier_complete(unsigned* bar, unsigned x, unsigned& nloc, unsigned& nx, unsigned& uni) {
    const unsigned G = gridDim.x * gridDim.y * gridDim.z;
    unsigned sum, cnt, mine, sp = 0u;
    for (;;) {
        sum = 0u; cnt = 0u; mine = 0u; uni = (G == 256u) ? 1u : 0u;
#pragma unroll
        for (unsigned j = 0; j < 16; ++j) { const unsigned c = xb_ld(&bar[XB_XCNT(j)]); sum += c; cnt += (c > 0u) ? 1u : 0u; mine = (j == x) ? c : mine; if (c != (j < 8u ? 32u : 0u)) uni = 0u; }
        if (sum == G) break;
        __builtin_amdgcn_s_sleep(1);
        if ((++sp & 255u) == 0u) { if (xb_ld(&bar[XB_TMO])) break; if (sp > XB_SPIN_CAP) { atomicAdd(&bar[XB_TMO], 1u); break; } }
    }
    nloc = mine > 0u ? mine : 1u; nx = cnt > 0u ? cnt : 1u;
}

__device__ __forceinline__ void xcd_barrier(const XcdBarrier& b, bool local = false) {
    asm volatile("s_waitcnt vmcnt(0)" ::: "memory");
    __syncthreads();
    if (threadIdx.x == 0) {
        unsigned* bar = b.bar;
        __builtin_amdgcn_s_waitcnt(0);
        unsigned nloc = b.st[0], nx = b.st[1];
        if (nloc == 0u) { unsigned uni; xcd_barrier_complete(bar, b.x, nloc, nx, uni); b.st[0] = nloc; b.st[1] = nx; b.st[3] = uni;
            if (uni) b.st[4] = b.st[2] * 8u + b.x; }
        const bool full = !(local && b.st[3] != 0u);
        const unsigned old = xb_add(&bar[XB_XSUB(b.x)], 1u);
        const unsigned gen = old / nloc;
        if (old + 1u == (gen + 1u) * nloc) {
          if (full) {
            __builtin_amdgcn_fence(__ATOMIC_RELEASE, "agent");
            asm volatile("s_waitcnt vmcnt(0)" ::: "memory");
            const unsigned og = xb_add(&bar[XB_TOP], 1u);
            const unsigned tg = og / nx;
            if (og + 1u == (tg + 1u) * nx) xb_add(&bar[XB_TOPGEN], 1u);
            else XB_SPIN(xb_ld(&bar[XB_TOPGEN]) == tg, bar);
          }
            __builtin_amdgcn_fence(__ATOMIC_ACQUIRE, "agent");
            xb_add(&bar[XB_XGEN(b.x)], 1u);
            asm volatile("s_waitcnt vmcnt(0)" ::: "memory");
        } else {
            XB_SPIN(xb_ld(&bar[XB_XGEN(b.x)]) == gen, bar);
            __builtin_amdgcn_fence(__ATOMIC_ACQUIRE, "agent");
            asm volatile("s_waitcnt vmcnt(0)" ::: "memory");
        }
    }
    __syncthreads();
}

struct Args { const float* in[10]; float* out; unsigned char* ws; int ph_lo, ph_hi; };
constexpr int PH_PRO = 0, PH_FINAL = 1 + 6 * DEPTH * NGRP;

__device__ __forceinline__ void prologue_phase(const Args& a, unsigned char* lds) {
    int tid_ = threadIdx.x; asm volatile("" : "+v"(tid_));
    const int lane = tid_ & 63, wave = __builtin_amdgcn_readfirstlane(tid_ >> 6);
    const float* x = a.in[0]; float* out = a.out; bf16* xb = (bf16*)(a.ws + WS_XB); float* ssq = (float*)(a.ws + WS_SSQ); float* rope = (float*)(a.ws + WS_ROPE);
    const int gw = blockIdx.x * NWAVES + wave, NGW = gridDim.x * NWAVES;
    LAS float* scr = (LAS float*)((LAS unsigned char*)lds + wave * 16384);
    constexpr int I_IN = 16 * 256, I_SQ = 16 * 32, I_UP = 16 * 128, I_DN = 64 * 32, I_LAYER = I_IN + 3 * I_SQ + I_UP + I_DN;
    for (int it = gw; it < DEPTH * I_LAYER; it += NGW) {
        const int l = it / I_LAYER; int r = it % I_LAYER;
        unsigned char* wl = a.ws + WS_W + (size_t)l * WL_STRIDE;
        if (r < I_IN) { tr_item(a.in[1] + (size_t)l * D * DIN, DIN, (bf16*)(wl + WL_WIN), D, 0, KIND_WIN, a.in[7] + l * D, scr, r, lane); continue; } r -= I_IN;
        if (r < I_SQ) { tr_item(a.in[2] + (size_t)l * D * D, D, (bf16*)(wl + WL_PCAT), 2 * D, 0, KIND_P32, nullptr, scr, r, lane); continue; } r -= I_SQ;
        if (r < I_SQ) { tr_item(a.in[3] + (size_t)l * D * D, D, (bf16*)(wl + WL_PCAT), 2 * D, D, KIND_P32, nullptr, scr, r, lane); continue; } r -= I_SQ;
        if (r < I_SQ) { tr_item(a.in[4] + (size_t)l * D * D, D, (bf16*)(wl + WL_WOUT), D, 0, KIND_NAT, nullptr, scr, r, lane); continue; } r -= I_SQ;
        if (r < I_UP) { tr_item(a.in[5] + (size_t)l * D * DFF, DFF, (bf16*)(wl + WL_WUP), D, 0, KIND_P32, a.in[8] + l * D, scr, r, lane); continue; } r -= I_UP;
        tr_item(a.in[6] + (size_t)l * DFF * D, D, (bf16*)(wl + WL_WDN), DFF, 0, KIND_NAT, nullptr, scr, r, lane);
    }
    for (int r = gw; r < M; r += NGW) {
        float s = 0.f; float4 xv[4];
#pragma unroll
        for (int j = 0; j < 4; ++j) xv[j] = *(const float4*)(x + (size_t)r * D + j * 256 + lane * 4);
#pragma unroll
        for (int j = 0; j < 4; ++j) {
            const int c = j * 256 + lane * 4;
            const float4 v = xv[j];
            *(float4*)(out + (size_t)r * D + c) = v;
            s += v.x * v.x + v.y * v.y + v.z * v.z + v.w * v.w;
            uint2 w; w.x = pk2(v.x, v.y); w.y = pk2(v.z, v.w);
            *(uint2*)(xb + (size_t)r * D + c) = w;
        }
#pragma unroll
        for (int o = 1; o < 64; o <<= 1) s += __shfl_xor(s, o);
        if (lane < 16) ssq[(size_t)r * 16 + lane] = (lane == 0) ? s : 0.f;
    }
    for (int i = blockIdx.x * 512 + tid_; i < SEQ * 64; i += gridDim.x * 512) {
        const int pos = i >> 6, j = i & 63;
        const float inv = powf(10000.0f, -(float)j / 64.0f);
        const float ang = (float)pos * inv;
        rope[i] = cosf(ang); rope[SEQ * 64 + i] = sinf(ang);
    }
}
__device__ __forceinline__ void final_phase(const Args& a) {
    int tid_ = threadIdx.x; asm volatile("" : "+v"(tid_));
    const int lane = tid_ & 63, wave = __builtin_amdgcn_readfirstlane(tid_ >> 6);
    float* out = a.out; const float* g = a.in[9];
    const int gw = blockIdx.x * NWAVES + wave, NGW = gridDim.x * NWAVES;
    for (int r = gw; r < M; r += NGW) {
        float4 v[4]; float s = 0.f;
#pragma unroll
        for (int j = 0; j < 4; ++j) { v[j] = *(const float4*)(out + (size_t)r * D + j * 256 + lane * 4); s += v[j].x * v[j].x + v[j].y * v[j].y + v[j].z * v[j].z + v[j].w * v[j].w; }
#pragma unroll
        for (int o = 1; o < 64; o <<= 1) s += __shfl_xor(s, o);
        const float rs = rsqrtf(s * (1.0f / D) + NORM_EPS);
#pragma unroll
        for (int j = 0; j < 4; ++j) { const float4 gg = *(const float4*)(g + j * 256 + lane * 4);
            float4 o; o.x = v[j].x * rs * gg.x; o.y = v[j].y * rs * gg.y; o.z = v[j].z * rs * gg.z; o.w = v[j].w * rs * gg.w;
            *(float4*)(out + (size_t)r * D + j * 256 + lane * 4) = o; }
    }
}

#ifndef RET_NAIVE
#define RET_NAIVE 0
#endif
#ifndef PHMASK
#define PHMASK 31
#endif
#ifndef MK_ONE_LAUNCH
#define MK_ONE_LAUNCH 1
#endif
__global__ void __launch_bounds__(NWAVES * 64, 2) mega(Args a) {
    extern __shared__ __attribute__((aligned(16))) unsigned char lds[];
    const int G = gridDim.x;
    PG8_LAS unsigned char* ring = (PG8_LAS unsigned char*)lds;
#if MK_ONE_LAUNCH
    volatile LAS unsigned* MISC = (volatile LAS unsigned*)((LAS unsigned char*)lds + MISC_OFF);
    if (threadIdx.x < 4) MISC[threadIdx.x] = 0u;
    if (threadIdx.x == 4) MISC[4] = blockIdx.x;
    __syncthreads();
    const XcdBarrier bar = xcd_barrier_post((unsigned*)(a.ws + WS_CTL), MISC);
#define GRID_SYNC() xcd_barrier(bar)
#define TEAM_SYNC(local) xcd_barrier(bar, (local))
#else
#define GRID_SYNC() do {} while (0)
#define TEAM_SYNC(local) do {} while (0)
#endif
    volatile LAS unsigned* MISCT = (volatile LAS unsigned*)((LAS unsigned char*)lds + MISC_OFF + 64);
    if (TIME_K >= 0 && threadIdx.x == 0) { MISCT[4] = 0u; const unsigned long long t_ = __builtin_amdgcn_s_memrealtime(); MISCT[2] = (unsigned)t_; MISCT[3] = (unsigned)(t_ >> 32); }
    int ph = a.ph_lo; const int ph_hi = a.ph_hi;
    if (ph == PH_PRO) { prologue_phase(a, lds); ++ph;
#if MK_ONE_LAUNCH
        if (ph < ph_hi) { if (a.ph_lo < 0) cg::this_grid().sync(); else GRID_SYNC(); }
#endif
        TSTAMP(6);
    }
    const int ph_end = ph_hi < PH_FINAL ? ph_hi : PH_FINAL;
    const bool rt_true = (PROBE_K >= 0) && (a.ph_hi > 0);
    for (; ph < ph_end; ++ph) {
#if MK_ONE_LAUNCH
        unsigned ma_ = (unsigned)MISC_OFF + 16u; asm volatile("" : "+v"(ma_));
        int bx = __builtin_amdgcn_readfirstlane((int)*(volatile LAS unsigned*)((LAS unsigned char*)lds + ma_));
#else
        int bx = (int)blockIdx.x; asm volatile("" : "+s"(bx));
#endif
        size_t zofs = 0; asm volatile("" : "+s"(zofs));
        unsigned char* ws = a.ws + zofs; float* outp = (float*)((unsigned char*)a.out + zofs);
        unsigned char* act = ws + WS_ACT; float* ssq = (float*)(ws + WS_SSQ); const float* rope = (const float*)(ws + WS_ROPE); bf16* xb = (bf16*)(ws + WS_XB);
        {
            const int q = ph - 1, k = q % 6, lg = q / 6, l = lg / NGRP, g = lg % NGRP, grow0 = g * MG;
            const unsigned char* wl = ws + WS_W + (size_t)l * WL_STRIDE;
            if (k == 0 && (PHMASK & 1)) {
                pg8::Gemm gm{xb + (size_t)grow0 * D, (const bf16*)(wl + WL_WIN), MG, DIN, D, D}; pg8::StaticOrder S; S.init(MG, DIN, G, bx);
                pg8::EpiP1 E{act, rope, grow0, false, (const PG8_LAS float*)(ring + RSTD_OFF)};
                { pg8::Unit u0; S.next(0, u0); pg8::panel_rstd((PG8_LAS float*)(ring + RSTD_OFF), ssq, grow0, u0.pm); }
                for (int rep = (PROBE_K == 0 ? 0 : 1); rep < 2; ++rep) { E.dry = (rep == 0) && rt_true; pg8::gemm_phase<pg8::EpiP1, pg8::StaticOrder, true, true>(ring, gm, S, E); }
            } else if (k == 1) {
                TSTAMP(100);
                for (int rep = (PROBE_K == 6 ? 0 : 1); rep < 2; ++rep) sba::ret_phase(act, (char*)lds, (rep == 0) && rt_true, bx);
                TSTAMP(8);
                for (int rep = (PROBE_K == 7 ? 0 : 1); rep < 2; ++rep) sba::sb_phase(act, (char*)lds, (rep == 0) && rt_true, (unsigned*)(ws + WS_CTL + 16384) + (size_t)(2 * lg + rep) * 64, bx);
                TSTAMP(9);
            } else if (k == 2 && (PHMASK & 2)) {
                pg8::Gemm gm{(const bf16*)(act + A_GS), (const bf16*)(wl + WL_PCAT), MG, D, 2 * D, D, SKIP4K}; pg8::ChainOrder S; S.init(MG, D, G, bx); S.kh = D;
                pg8::EpiP3 E{act, false};
                for (int rep = (PROBE_K == 2 ? 0 : 1); rep < 2; ++rep) { E.dry = (rep == 0) && rt_true; pg8::gemm_phase<pg8::EpiP3, pg8::ChainOrder, true, true>(ring, gm, S, E); }
            } else if (k == 3 && (PHMASK & 4)) {
                pg8::Gemm gm{(const bf16*)(act + A_MERGED), (const bf16*)(wl + WL_WOUT), MG, D, D, D, SKIP2K}; pg8::StaticOrder S; S.init(MG, D, G, bx);
                pg8::EpiX E{outp, xb, ssq, grow0, false, true};
                for (int rep = (PROBE_K == 3 ? 0 : 1); rep < 2; ++rep) { E.dry = (rep == 0) && rt_true; pg8::gemm_phase<pg8::EpiX, pg8::StaticOrder, true, true>(ring, gm, S, E); }
            } else if (k == 4 && (PHMASK & 8)) {
                pg8::Gemm gm{xb + (size_t)grow0 * D, (const bf16*)(wl + WL_WUP), MG, DFF, D, D}; pg8::StaticOrder S; S.init(MG, DFF, G, bx);
                pg8::EpiP5 E{act, grow0, false, (const PG8_LAS float*)(ring + RSTD_OFF)};
                { pg8::Unit u0; S.next(0, u0); pg8::panel_rstd((PG8_LAS float*)(ring + RSTD_OFF), ssq, grow0, u0.pm); }
                for (int rep = (PROBE_K == 4 ? 0 : 1); rep < 2; ++rep) { E.dry = (rep == 0) && rt_true; pg8::gemm_phase<pg8::EpiP5, pg8::StaticOrder, true, true>(ring, gm, S, E); }
            } else if (k == 5 && (PHMASK & 16)) {
                pg8::Gemm gm{(const bf16*)(act + A_UP), (const bf16*)(wl + WL_WDN), MG, D, DFF, DFF, SKIP8K}; pg8::StaticOrder S; S.init(MG, D, G, bx);
                pg8::EpiX E{outp, xb, ssq, grow0, false, l + 1 < DEPTH};
                for (int rep = (PROBE_K == 5 ? 0 : 1); rep < 2; ++rep) { E.dry = (rep == 0) && rt_true; pg8::gemm_phase<pg8::EpiX, pg8::StaticOrder, true, true>(ring, gm, S, E); }
            }
        }
        if (ph + 1 < ph_hi) TEAM_SYNC(ph + 1 < PH_FINAL);
        TSTAMP((ph - 1) % 6);
    }
    if (ph_hi > PH_FINAL) final_phase(a);
    TSTAMP(7);
    if (TIME_K >= 0 && blockIdx.x == 0 && threadIdx.x == 0) { const unsigned long long t0_ = __builtin_amdgcn_s_memrealtime(); const unsigned span_ = MISCT[4]; while (__builtin_amdgcn_s_memrealtime() - t0_ < span_) __builtin_amdgcn_s_sleep(8); }
}

extern "C" void kernel_launch(void* const* d_in, const int* in_sizes, int n_in, void* d_out, int out_size, void* d_ws, size_t ws_size, hipStream_t stream) {
    static int grid = 0;
    if (grid == 0) {
        if (n_in != 10 || in_sizes[0] != M * D || out_size != M * D || ws_size < WS_END) { fprintf(stderr, "kernel_launch: unexpected shapes (n_in %d, ws %zu)\n", n_in, ws_size); grid = -1; return; }
        int dev = 0, cus = 0;
        if (hipGetDevice(&dev) != hipSuccess || hipDeviceGetAttribute(&cus, hipDeviceAttributeMultiprocessorCount, dev) != hipSuccess) { grid = -1; return; }
        if (hipFuncSetAttribute((const void*)mega, hipFuncAttributeMaxDynamicSharedMemorySize, LDS_BYTES) != hipSuccess) { fprintf(stderr, "kernel_launch: hipFuncSetAttribute failed\n"); grid = -1; return; }
        int per_cu = 0;
        if (hipOccupancyMaxActiveBlocksPerMultiprocessor(&per_cu, (const void*)mega, NWAVES * 64, LDS_BYTES) != hipSuccess || per_cu < 1) { fprintf(stderr, "kernel_launch: occupancy query says %d blocks per CU\n", per_cu); (void)hipGetLastError(); per_cu = 1; }
        if (cus < 256) { fprintf(stderr, "kernel_launch: built for a 256-CU device (got %d CUs)\n", cus); grid = -1; return; }
        grid = 256;
    }
    if (grid < 0) return;
    Args a{};
    for (int i = 0; i < 10; ++i) a.in[i] = (const float*)d_in[i];
    a.out = (float*)d_out; a.ws = (unsigned char*)d_ws;
#if MK_ONE_LAUNCH
    if (hipMemsetAsync((char*)d_ws + WS_CTL, 0, CTL_ZERO_BYTES, stream) != hipSuccess) { fprintf(stderr, "kernel_launch: hipMemsetAsync failed\n"); return; }
    a.ph_lo = 0; a.ph_hi = PH_FINAL + 1;
    void* kargs[] = {&a};
    const hipError_t le = hipLaunchCooperativeKernel((const void*)mega, dim3(grid), dim3(NWAVES * 64), kargs, LDS_BYTES, stream);
    if (le != hipSuccess) fprintf(stderr, "kernel_launch: cooperative launch failed: %s (grid %d)\n", hipGetErrorString(le), grid);
#else
    auto run = [&](int lo, int hi) { a.ph_lo = lo; a.ph_hi = hi; hipLaunchKernelGGL(mega, dim3(grid), dim3(NWAVES * 64), LDS_BYTES, stream, a); };
    for (int p = 0; p <= PH_FINAL; ++p) run(p, p + 1);
#endif
}
```

```cpp
#include <hip/hip_runtime.h>
#include <hip/hip_cooperative_groups.h>
#include <cstdio>
#include <cstdint>
namespace cg = cooperative_groups;

constexpr int D = 1024, BATCH = 16, SEQ = 2048, DEPTH = 4, M = BATCH * SEQ;
constexpr int DIN = 8192, DFF = 4096;
constexpr int NGRP = 2, BG = BATCH / NGRP, MG = BG * SEQ;
constexpr float NORM_EPS = 1e-6f, GN_EPS = 1e-5f;
constexpr float LOG2E = 1.4426950408889634f, LN2 = 0.6931471805599453f;
constexpr float QS_SCALE = 0.08838834764831845f * LOG2E;
constexpr float KR_SCALE = 0.08838834764831845f;
constexpr float LG2_GAMMA0 = -0.045803689613124954f, LG2_GAMMA1 = -0.022720076500083545f, LG2_GAMMA2 = -0.011315313227834146f, LG2_GAMMA3 = -0.005646563141142062f;

#ifndef PROBE_K
#define PROBE_K (-1)
#endif
#ifndef TIME_K
#define TIME_K (-1)
#endif
#define TSTAMP(type) do { if (TIME_K >= 0 && blockIdx.x == 0 && threadIdx.x == 0) { const unsigned long long t_ = __builtin_amdgcn_s_memrealtime(); \
    const unsigned long long p_ = ((unsigned long long)MISCT[3] << 32) | MISCT[2]; if ((type) == TIME_K) MISCT[4] += (unsigned)(t_ - p_); MISCT[2] = (unsigned)t_; MISCT[3] = (unsigned)(t_ >> 32); } } while (0)
typedef unsigned short bf16;
constexpr size_t MiB = 1u << 20;
constexpr size_t WS_CTL = 0;
constexpr size_t WS_ROPE = 1 * MiB;
constexpr size_t WS_SSQ = 2 * MiB;
constexpr size_t WS_XB = 4 * MiB;
constexpr size_t WS_W = 68 * MiB;
constexpr size_t WL_WIN = 0, WL_PCAT = 16 * MiB, WL_WOUT = 20 * MiB, WL_WUP = 22 * MiB, WL_WDN = 30 * MiB, WL_STRIDE = 38 * MiB;
constexpr size_t WS_ACT = 220 * MiB;
constexpr size_t WS_U = 476 * MiB;
constexpr size_t WS_END = 504 * MiB;
constexpr size_t SLAB = 32 * MiB, SKIP2K = SLAB - 2048 * 2048, SKIP4K = SLAB - 2048 * 4096, SKIP8K = SLAB - (size_t)2048 * 8192;
constexpr size_t A_RQK = 0, A_RV = 4 * MiB, A_GS = 8 * MiB, A_SK = 16 * MiB, A_SV = 20 * MiB, A_GA = 24 * MiB, A_GB = 28 * MiB;
constexpr size_t A_MERGED = 0, A_UP = 0;

__device__ __forceinline__ unsigned f2bf(float f) { unsigned u = __builtin_bit_cast(unsigned, f); return (u + 0x7fffu + ((u >> 16) & 1u)) >> 16; }
__device__ __forceinline__ float bf2f(unsigned h) { return __builtin_bit_cast(float, h << 16); }
__device__ __forceinline__ unsigned pk2(float lo, float hi) { return f2bf(lo) | (f2bf(hi) << 16); }

namespace pg8 {
#define PG8_LAS __attribute__((address_space(3)))
typedef unsigned short bf16_t;
typedef short bf16x8 __attribute__((ext_vector_type(8)));
typedef float f32x4 __attribute__((ext_vector_type(4)));
typedef unsigned u32x4 __attribute__((ext_vector_type(4)));
constexpr int BM = 256, BK = 64, HALF = 128, HTB = HALF * BK * 2  , STAGE_BYTES = 8 * HTB, NXCD = 8, WGM = 8;

__host__ __device__ __forceinline__ int lds_byte(int r, int c) { const int st = (r >> 4) * 2 + (c >> 5), rr = r & 15, cc = c & 31, ob = rr * 64 + cc * 2; return st * 1024 + (ob ^ (((ob >> 9) & 1) << 5)); }
__host__ __device__ __forceinline__ void stage_rc(int b, int& R, int& C) { const int st = b / 1024, sb = b % 1024, swz = sb ^ (((sb >> 9) & 1) << 5); R = (st >> 1) * 16 + swz / 64; C = (st & 1) * 32 + (swz % 64) / 2; }
__host__ __device__ __forceinline__ int perm32(int rho) { const int n = rho >> 4, i = rho & 15; return 8 * (i >> 2) + 4 * n + (i & 3); }

struct Unit { int pm, pn, kofs; };
struct Gemm { const bf16_t* A; const bf16_t* Bt; int M, N, K, Kloop; size_t askip = 0; };

struct StaticOrder {
    int nM, nN, nwg, G, c;
    __host__ __device__ void init(int M, int N, int G_, int c_) { nM = M / BM; nN = N / BM; nwg = nM * nN; G = G_; c = c_; }
    __host__ __device__ bool next(int i, Unit& u) const {
        const long L = (long)i * G + c; if (L >= nwg) return false;
        int wgid = (int)L; { const int q = nwg / NXCD, r = nwg % NXCD, xcd = wgid % NXCD, off = wgid / NXCD; wgid = (xcd < r ? xcd * (q + 1) : r * (q + 1) + (xcd - r) * q) + off; }
        const int nig = WGM * nN, gid = wgid / nig, fm = gid * WGM, gsz = (nM - fm) < WGM ? (nM - fm) : WGM;
        u.pm = fm + ((wgid % nig) % gsz); u.pn = (wgid % nig) / gsz; u.kofs = 0; return true;
    }
    __device__ __forceinline__ void a_ready(const Unit&) const {}
    __device__ __forceinline__ void done(const Unit&) const {}
};
struct ChainOrder : StaticOrder {
    int kh;
    __host__ __device__ bool next(int i, Unit& u) const { if (!StaticOrder::next(i >> 1, u)) return false; u.kofs = (i & 1) * kh; return true; }
};


typedef unsigned u32x2 __attribute__((ext_vector_type(2)));
__device__ __forceinline__ unsigned cvt_pk_bf16(float lo, float hi) { unsigned r; asm volatile("v_cvt_pk_bf16_f32 %0, %1, %2" : "=v"(r) : "v"(lo), "v"(hi)); return r; }
__device__ __forceinline__ u32x2 pack4(const f32x4 v) { u32x2 w; w.x = cvt_pk_bf16(v[0], v[1]); w.y = cvt_pk_bf16(v[2], v[3]); return w; }
__device__ __forceinline__ u32x4 pack8(const f32x4 a, const f32x4 b) { u32x4 w; w.x = cvt_pk_bf16(a[0], a[1]); w.y = cvt_pk_bf16(a[2], a[3]); w.z = cvt_pk_bf16(b[0], b[1]); w.w = cvt_pk_bf16(b[2], b[3]); return w; }
__device__ __forceinline__ f32x4 unpack_lo(const u32x4 w) { f32x4 r; r[0] = __builtin_bit_cast(float, w.x << 16); r[1] = __builtin_bit_cast(float, w.x & 0xffff0000u); r[2] = __builtin_bit_cast(float, w.y << 16); r[3] = __builtin_bit_cast(float, w.y & 0xffff0000u); return r; }
__device__ __forceinline__ f32x4 unpack_hi(const u32x4 w) { f32x4 r; r[0] = __builtin_bit_cast(float, w.z << 16); r[1] = __builtin_bit_cast(float, w.z & 0xffff0000u); r[2] = __builtin_bit_cast(float, w.w << 16); r[3] = __builtin_bit_cast(float, w.w & 0xffff0000u); return r; }
__device__ __forceinline__ float row_rstd(const char* ub, unsigned lo) {
    const f32x4* p = (const f32x4*)(ub + lo);
    const f32x4 a = p[0], b = p[1], c = p[2], d = p[3];
    const float s = (((a[0] + a[1]) + (a[2] + a[3])) + ((b[0] + b[1]) + (b[2] + b[3]))) + (((c[0] + c[1]) + (c[2] + c[3])) + ((d[0] + d[1]) + (d[2] + d[3])));
    return rsqrtf(s * (1.0f / 1024.0f) + NORM_EPS);
}
__device__ __forceinline__ f32x4 exp4(const f32x4 v) { f32x4 r; r[0] = __expf(v[0]); r[1] = __expf(v[1]); r[2] = __expf(v[2]); r[3] = __expf(v[3]); return r; }
__device__ __forceinline__ f32x4 rcp4(const f32x4 v) { f32x4 r; r[0] = __builtin_amdgcn_rcpf(v[0]); r[1] = __builtin_amdgcn_rcpf(v[1]); r[2] = __builtin_amdgcn_rcpf(v[2]); r[3] = __builtin_amdgcn_rcpf(v[3]); return r; }

__device__ __forceinline__ void panel_rstd(PG8_LAS float* rst, const float* ssq, int grow0, int pm) {
    int tid = threadIdx.x; asm volatile("" : "+v"(tid));
    if (tid < 256) rst[tid] = row_rstd((const char*)ssq + (size_t)(grow0 + pm * BM) * 64, (unsigned)tid * 64u);
    __syncthreads();
}
struct EpiP1 {
    static constexpr bool PERM = false, AFTER_DRAIN = false, MID = false, PRELOAD = false; static constexpr bool SLACK = true;
    __device__ __forceinline__ bool slack_ok() const { return (PROBE_K < 0) || !dry; }
    unsigned char* act; const float* rope; int grow0; bool dry; const PG8_LAS float* rst;
    __device__ __forceinline__ void mid(f32x4 (&)[2][2][4][2], const Unit&, int, int, int, int) const {}
    __device__ __forceinline__ void operator()(const f32x4 (&acc)[2][2][4][2], const Unit& u, int wr, int wc, int fr, int fq) const {
        if (dry) return;
        const int pn = u.pn, rlu = u.pm * BM + wr * 64;
        unsigned lf = (unsigned)fr, lq = (unsigned)fq; asm volatile("" : "+v"(lf), "+v"(lq));
        float rs[2][4];
#pragma unroll
        for (int ai = 0; ai < 2; ++ai)
#pragma unroll
            for (int m = 0; m < 4; ++m) rs[ai][m] = rst[wr * 64 + ai * HALF + m * 16 + lf];
        if (pn < 4) {
            const unsigned j0 = 16 * wc + 4 * lq;
            char* ub = (char*)(act + A_RQK + (size_t)(u.pm >> 3) * SKIP2K) + ((size_t)rlu * 1024 + (pn >> 1) * 512 + (pn & 1) * 256) * 2;
            const unsigned lo = (lf * 1024u + j0) * 2u;
            const int pos0 = (grow0 + rlu) & (SEQ - 1);
            const char* rp = (const char*)rope + (size_t)pos0 * 256;
            const float sg = (pn < 2) ? 1.0f : -1.0f;
            const float lgA0 = sg * LG2_GAMMA0, lgA1 = sg * LG2_GAMMA1, lgB0 = sg * LG2_GAMMA2, lgB1 = sg * LG2_GAMMA3;
            const unsigned rlo = lf * 256u + j0 * 4u;
            f32x4 csv[2][4], snv[2][4];
#pragma unroll
            for (int ai = 0; ai < 2; ++ai)
#pragma unroll
                for (int m = 0; m < 4; ++m) { csv[ai][m] = *(const f32x4*)(rp + (ai * HALF + m * 16) * 256 + rlo); snv[ai][m] = *(const f32x4*)(rp + SEQ * 256 + (ai * HALF + m * 16) * 256 + rlo); }
            asm volatile("" ::: "memory");
#pragma unroll
            for (int ai = 0; ai < 2; ++ai)
#pragma unroll
                for (int m = 0; m < 4; ++m) {
                    const f32x4 cs = csv[ai][m], sn = snv[ai][m];
                    const float posf = (float)(pos0 + ai * HALF + m * 16) + (float)lf;
#pragma unroll
                    for (int bj = 0; bj < 2; ++bj) {
                        const float fac = rs[ai][m] * __builtin_amdgcn_exp2f(posf * ((pn & 1) ? (bj ? lgB1 : lgB0) : (bj ? lgA1 : lgA0)));
                        const f32x4 t1 = acc[ai][bj][m][0] * fac, t2 = acc[ai][bj][m][1] * fac;
                        const f32x4 o1 = t1 * cs - t2 * sn, o2 = t1 * sn + t2 * cs;
                        char* d = ub + ((ai * HALF + m * 16) * 1024 + bj * 128) * 2;
                        *(u32x2*)(d + lo) = pack4(o1); *(u32x2*)(d + 128 + lo) = pack4(o2);
                    }
                }
        } else if (pn < 24) {
            char* ub; int pitch; bool silu = false;
            const size_t tm = (size_t)(u.pm >> 3);
            if (pn < 8) { ub = (char*)(act + A_RV + tm * SKIP2K) + (pn - 4) * 512; pitch = 2048; }
            else if (pn < 12) { ub = (char*)(act + A_GS + tm * SKIP4K) + (pn - 8) * 512; pitch = 4096; silu = true; }
            else if (pn < 16) { ub = (char*)(act + A_GS + tm * SKIP4K) + 2048 + (pn - 12) * 512; pitch = 4096; }
            else if (pn < 20) { ub = (char*)(act + A_SK + tm * SKIP2K) + (pn - 16) * 512; pitch = 2048; }
            else { ub = (char*)(act + A_SV + tm * SKIP2K) + (pn - 20) * 512; pitch = 2048; }
            ub += (size_t)rlu * pitch;
            const unsigned lo = lf * (unsigned)pitch + ((unsigned)(wc * 32) + 8u * lq) * 2u;
#pragma unroll
            for (int ai = 0; ai < 2; ++ai)
#pragma unroll
                for (int m = 0; m < 4; ++m) {
                    char* rowp = ub + (size_t)(ai * HALF + m * 16) * pitch;
#pragma unroll
                    for (int bj = 0; bj < 2; ++bj) {
                        f32x4 v0 = acc[ai][bj][m][0] * rs[ai][m], v1 = acc[ai][bj][m][1] * rs[ai][m];
                        if (silu) { v0 = v0 * rcp4(exp4(-v0) + 1.0f); v1 = v1 * rcp4(exp4(-v1) + 1.0f); }
                        *(u32x4*)(rowp + bj * 256 + lo) = pack8(v0, v1);
                    }
                }
        } else {
            const size_t uo = ((size_t)rlu * 1024 + 128 * (pn - 24)) * 2;
            char* ga = (char*)(act + A_GA + (size_t)(u.pm >> 3) * SKIP2K) + uo; char* gb = (char*)(act + A_GB + (size_t)(u.pm >> 3) * SKIP2K) + uo;
            const unsigned lo = (lf * 1024u + (unsigned)(32 * wc) + 8u * lq) * 2u;
#pragma unroll
            for (int ai = 0; ai < 2; ++ai)
#pragma unroll
                for (int m = 0; m < 4; ++m) {
                    f32x4 ra[2], sb[2];
#pragma unroll
                    for (int n = 0; n < 2; ++n) {
                        const f32x4 ea = exp4(-(acc[ai][0][m][n] * rs[ai][m])) + 1.0f, eb = exp4(-(acc[ai][1][m][n] * rs[ai][m])) + 1.0f;
                        const f32x4 t = rcp4(ea * eb); sb[n] = t * ea; ra[n] = (t * eb) * eb;
                    }
                    *(u32x4*)(ga + (ai * HALF + m * 16) * 2048 + lo) = pack8(ra[0], ra[1]);
                    *(u32x4*)(gb + (ai * HALF + m * 16) * 2048 + lo) = pack8(sb[0], sb[1]);
                }
        }
    }
};
struct EpiP3 {
    static constexpr bool PERM = false, AFTER_DRAIN = false, MID = true, PRELOAD = false; static constexpr bool SLACK = false;
    __device__ __forceinline__ bool slack_ok() const { return false; }
    unsigned char* act; bool dry;
    __device__ __forceinline__ void mid(f32x4 (&acc)[2][2][4][2], const Unit& u, int wr, int wc, int fr, int fq) const {
        const char* g = (const char*)(act + A_GA + (size_t)(u.pm >> 3) * SKIP2K) + ((size_t)(u.pm * BM + wr * 64) * 1024 + u.pn * BM) * 2;
        unsigned lo = ((unsigned)fr * 1024u + (unsigned)(wc * 32 + 8 * fq)) * 2u; asm volatile("" : "+v"(lo));
        u32x4 w[2][4][2];
#pragma unroll
        for (int ai = 0; ai < 2; ++ai)
#pragma unroll
            for (int m = 0; m < 4; ++m)
#pragma unroll
                for (int bj = 0; bj < 2; ++bj) w[ai][m][bj] = *(const u32x4*)(g + ((ai * HALF + m * 16) * 2048 + bj * 256) + lo);
        asm volatile("" ::: "memory");
#pragma unroll
        for (int ai = 0; ai < 2; ++ai)
#pragma unroll
            for (int m = 0; m < 4; ++m)
#pragma unroll
                for (int bj = 0; bj < 2; ++bj) { acc[ai][bj][m][0] *= unpack_lo(w[ai][m][bj]); acc[ai][bj][m][1] *= unpack_hi(w[ai][m][bj]); }
    }
    __device__ __forceinline__ void operator()(const f32x4 (&acc)[2][2][4][2], const Unit& u, int wr, int wc, int fr, int fq) const {
        if (dry) return;
        const size_t uo = ((size_t)(u.pm * BM + wr * 64) * 1024 + u.pn * BM) * 2;
        const char* g = (const char*)(act + A_GB + (size_t)(u.pm >> 3) * SKIP2K) + uo; char* o = (char*)(act + A_MERGED + (size_t)(u.pm >> 3) * SKIP2K) + uo;
        unsigned lo = ((unsigned)fr * 1024u + (unsigned)(wc * 32 + 8 * fq)) * 2u; asm volatile("" : "+v"(lo));
        u32x4 w[2][4][2];
#pragma unroll
        for (int ai = 0; ai < 2; ++ai)
#pragma unroll
            for (int m = 0; m < 4; ++m)
#pragma unroll
                for (int bj = 0; bj < 2; ++bj) w[ai][m][bj] = *(const u32x4*)(g + ((ai * HALF + m * 16) * 2048 + bj * 256) + lo);
        asm volatile("" ::: "memory");
#pragma unroll
        for (int ai = 0; ai < 2; ++ai)
#pragma unroll
            for (int m = 0; m < 4; ++m)
#pragma unroll
                for (int bj = 0; bj < 2; ++bj) {
                    const int co = (ai * HALF + m * 16) * 2048 + bj * 256;
                    *(u32x4*)(o + co + lo) = pack8(acc[ai][bj][m][0] * unpack_lo(w[ai][m][bj]), acc[ai][bj][m][1] * unpack_hi(w[ai][m][bj]));
                }
    }
};
struct EpiX {
    static constexpr bool PERM = false, AFTER_DRAIN = false, MID = false, PRELOAD = true; static constexpr bool SLACK = false;
    __device__ __forceinline__ bool slack_ok() const { return false; }
    float* out; bf16_t* xb; float* ssq; int grow0; bool dry; bool feed;
    __device__ __forceinline__ void mid(f32x4 (&)[2][2][4][2], const Unit&, int, int, int, int) const {}
    __device__ __forceinline__ void preload(f32x4 (&acc)[2][2][4][2], const Unit& u, int wr, int wc, int fr, int fq) const {
        const size_t Ru = (size_t)(grow0 + u.pm * BM + wr * 64), cu = (size_t)(u.pn * BM + wc * 32);
        const char* xi = (const char*)out + (Ru * D + cu) * 4;
        unsigned lo4 = ((unsigned)fr * 1024u + 4u * (unsigned)fq) * 4u; asm volatile("" : "+v"(lo4));
#pragma unroll
        for (int ai = 0; ai < 2; ++ai)
#pragma unroll
            for (int m = 0; m < 4; ++m)
#pragma unroll
                for (int bj = 0; bj < 2; ++bj)
#pragma unroll
                    for (int n = 0; n < 2; ++n) acc[ai][bj][m][n] = *(const f32x4*)(xi + ((ai * HALF + m * 16) * 1024 + bj * HALF + n * 16) * 4 + lo4);
    }
    __device__ __forceinline__ void operator()(const f32x4 (&acc)[2][2][4][2], const Unit& u, int wr, int wc, int fr, int fq) const {
        if (dry) return;
        const size_t Ru = (size_t)(grow0 + u.pm * BM + wr * 64), cu = (size_t)(u.pn * BM + wc * 32);
        char* xo = (char*)out + (Ru * D + cu) * 4; char* xbo = (char*)xb + (Ru * D + cu) * 2; char* sq = (char*)ssq + Ru * 64 + (u.pn * 4 + wc) * 4;
        unsigned lo4 = ((unsigned)fr * 1024u + 4u * (unsigned)fq) * 4u, los = (unsigned)fr * 64u; asm volatile("" : "+v"(lo4), "+v"(los)); const unsigned lo2 = lo4 >> 1;
#pragma unroll
        for (int ai = 0; ai < 2; ++ai)
#pragma unroll
            for (int m = 0; m < 4; ++m) {
                float s = 0.f;
#pragma unroll
                for (int bj = 0; bj < 2; ++bj)
#pragma unroll
                    for (int n = 0; n < 2; ++n) {
                        const int co = (ai * HALF + m * 16) * 1024 + bj * HALF + n * 16;
                        const f32x4 xn = acc[ai][bj][m][n];
                        *(f32x4*)(xo + co * 4 + lo4) = xn; if (feed) *(u32x2*)(xbo + co * 2 + lo2) = pack4(xn);
                        s += (xn[0] * xn[0] + xn[1] * xn[1]) + (xn[2] * xn[2] + xn[3] * xn[3]);
                    }
                s += __shfl_xor(s, 16); s += __shfl_xor(s, 32);
                if (feed && fq == 0) *(float*)(sq + (ai * HALF + m * 16) * 64 + los) = s;
            }
    }
};
struct EpiP5 {
    static constexpr bool PERM = false, AFTER_DRAIN = false, MID = false, PRELOAD = false; static constexpr bool SLACK = true;
    __device__ __forceinline__ bool slack_ok() const { return (PROBE_K < 0) || !dry; }
    unsigned char* act; int grow0; bool dry; const PG8_LAS float* rst;
    __device__ __forceinline__ void mid(f32x4 (&)[2][2][4][2], const Unit&, int, int, int, int) const {}
    __device__ __forceinline__ void operator()(const f32x4 (&acc)[2][2][4][2], const Unit& u, int wr, int wc, int fr, int fq) const {
        if (dry) return;
        const int rlu = u.pm * BM + wr * 64;
        char* ub = (char*)(act + A_UP + (size_t)(u.pm >> 3) * SKIP8K) + ((size_t)rlu * DFF + u.pn * BM) * 2;
        unsigned lo = ((unsigned)fr * (unsigned)DFF + (unsigned)(wc * 32 + 8 * fq)) * 2u, lf = (unsigned)fr; asm volatile("" : "+v"(lo), "+v"(lf));
#pragma unroll
        for (int ai = 0; ai < 2; ++ai)
#pragma unroll
            for (int m = 0; m < 4; ++m) {
                const float rsv = rst[wr * 64 + ai * HALF + m * 16 + lf];
#pragma unroll
                for (int bj = 0; bj < 2; ++bj) {
                    f32x4 v0 = acc[ai][bj][m][0] * rsv, v1 = acc[ai][bj][m][1] * rsv;
#pragma unroll
                    for (int e = 0; e < 4; ++e) { const float a = fmaxf(v0[e], 0.f), b = fmaxf(v1[e], 0.f); v0[e] = a * a; v1[e] = b * b; }
                    *(u32x4*)(ub + ((ai * HALF + m * 16) * DFF + bj * HALF) * 2 + lo) = pack8(v0, v1);
                }
            }
    }
};

template <class Epi, class Sched, bool ALIGN_EPI = false, bool SP2 = false>
__device__ __forceinline__ void gemm_phase(PG8_LAS unsigned char* lds, const Gemm g, const Sched& S, const Epi& E) {
    int tid = threadIdx.x; asm volatile("" : "+v"(tid));
    const int wid = __builtin_amdgcn_readfirstlane(tid >> 6), lane = tid & 63, wr = wid >> 2, wc = wid & 3, fr = lane & 15, fq = lane >> 4;
    const int K = g.K, nt = g.Kloop / BK;
    unsigned voffA[2], voffB[2];
#pragma unroll
    for (int i = 0; i < 2; ++i) { int R, C; stage_rc(tid * 16 + i * 8192, R, C); const int Rb = Epi::PERM ? ((R & ~31) + perm32(R & 31)) : R;
        voffA[i] = (unsigned)(R * K + C) * 2u; voffB[i] = (unsigned)(Rb * K + C) * 2u; }
    const size_t kstep = (size_t)(BK * 2);
    const size_t hstep = (size_t)HALF * K * 2;
    const size_t tstep = 2 * hstep;
    const unsigned ldsw = (unsigned)wid * 1024u;
    const int aoff = lds_byte(wr * 64 + fr, fq * 8), boff = lds_byte(wc * 32 + fr, fq * 8);
#define PG8_SA(b, h) (((b) * 2 + (h)) * HTB)
#define PG8_SB(b, h) ((4 + (b) * 2 + (h)) * HTB)
#define PG8_STAGE(bufoff, gbase, voff) do { _Pragma("unroll") for (int _i = 0; _i < 2; ++_i) \
        __builtin_amdgcn_global_load_lds((const unsigned*)((const char*)(gbase) + (voff)[_i]), (PG8_LAS unsigned*)(lds + (bufoff) + ldsw + _i * 8192), 16, 0, 0); } while (0)
#define PG8_LDA(dst, b, h) do { _Pragma("unroll") for (int m = 0; m < 4; ++m) _Pragma("unroll") for (int k = 0; k < 2; ++k) dst[m][k] = *(const PG8_LAS bf16x8*)(lds + PG8_SA(b, h) + aoff + m * 2048 + k * 1024); } while (0)
#define PG8_LDB(dst, b, h) do { _Pragma("unroll") for (int n = 0; n < 2; ++n) _Pragma("unroll") for (int k = 0; k < 2; ++k) dst[n][k] = *(const PG8_LAS bf16x8*)(lds + PG8_SB(b, h) + boff + n * 2048 + k * 1024); } while (0)
#define PG8_MMA(ai, bj, At, Bt) do { __builtin_amdgcn_s_setprio(1); _Pragma("unroll") for (int m = 0; m < 4; ++m) _Pragma("unroll") for (int n = 0; n < 2; ++n) _Pragma("unroll") for (int k = 0; k < 2; ++k) \
        acc[ai][bj][m][n] = __builtin_amdgcn_mfma_f32_16x16x32_bf16(Bt[n][k], At[m][k], acc[ai][bj][m][n], 0, 0, 0); __builtin_amdgcn_s_setprio(0); } while (0)
#define PG8_WAIT_V(n) asm volatile("s_waitcnt vmcnt(" #n ")" ::: "memory")
#define PG8_WAIT_L(n) asm volatile("s_waitcnt lgkmcnt(" #n ")" ::: "memory")
#define PG8_BAR __builtin_amdgcn_s_barrier()
#define PG8_SCHED __builtin_amdgcn_sched_barrier(0)
    Unit cur, nxt; int ui = 0;
    if (!S.next(0, cur)) return;
    f32x4 acc[2][2][4][2];
#pragma unroll
    for (int a = 0; a < 2; ++a)
#pragma unroll
        for (int b = 0; b < 2; ++b)
#pragma unroll
            for (int m = 0; m < 4; ++m)
#pragma unroll
                for (int n = 0; n < 2; ++n) acc[a][b][m][n] = (f32x4){0.f, 0.f, 0.f, 0.f};
    bf16x8 At[4][2], B0[2][2], B1[2][2];
    const char* cA = (const char*)g.A + (size_t)cur.pm * tstep + (size_t)(cur.pm >> 3) * g.askip + (size_t)cur.kofs * 2; const char* cB = (const char*)g.Bt + (size_t)cur.pn * tstep + (size_t)cur.kofs * 2;
    S.a_ready(cur);
    if constexpr (SP2) {
        PG8_STAGE(PG8_SB(0, 0), cB, voffB); PG8_STAGE(PG8_SB(0, 1), cB + hstep, voffB); PG8_STAGE(PG8_SA(0, 0), cA, voffA); PG8_STAGE(PG8_SA(0, 1), cA + hstep, voffA);
        if (wr == 1) PG8_BAR;
        PG8_WAIT_V(2); PG8_BAR;
        PG8_STAGE(PG8_SB(1, 0), cB + kstep, voffB); PG8_STAGE(PG8_SA(1, 0), cA + kstep, voffA); PG8_STAGE(PG8_SB(1, 1), cB + hstep + kstep, voffB);
        PG8_WAIT_V(6); PG8_BAR;
    } else {
        PG8_STAGE(PG8_SB(0, 0), cB, voffB); PG8_STAGE(PG8_SA(0, 0), cA, voffA); PG8_STAGE(PG8_SB(0, 1), cB + hstep, voffB); PG8_STAGE(PG8_SA(0, 1), cA + hstep, voffA);
        if (wr == 1) PG8_BAR;
        PG8_WAIT_V(4); PG8_BAR;
        PG8_STAGE(PG8_SB(1, 0), cB + kstep, voffB); PG8_STAGE(PG8_SA(1, 0), cA + kstep, voffA); PG8_STAGE(PG8_SB(1, 1), cB + hstep + kstep, voffB);
        PG8_WAIT_V(6); PG8_BAR;
    }
    if constexpr (Epi::PRELOAD) E.preload(acc, cur, wr, wc, fr, fq);
    for (;;) {
        const bool has_next = S.next(ui + 1, nxt);
        const char* nA = has_next ? (const char*)g.A + (size_t)nxt.pm * tstep + (size_t)(nxt.pm >> 3) * g.askip + (size_t)nxt.kofs * 2 : cA; const char* nB = has_next ? (const char*)g.Bt + (size_t)nxt.pn * tstep + (size_t)nxt.kofs * 2 : cB;
        int t = 0;
#define PG8_SP2_TRIP(ST11, W1, W2, W3) do { \
            PG8_LDB(B0, 0, 0); PG8_LDB(B1, 0, 1); PG8_SCHED; PG8_LDA(At, 0, 0); if (ST11) PG8_STAGE(PG8_SA(1, 1), a1 + hstep, voffA); \
            PG8_WAIT_V(W1); PG8_WAIT_L(0); PG8_BAR; PG8_MMA(0, 0, At, B0); PG8_MMA(0, 1, At, B1); PG8_BAR; PG8_SCHED; \
            PG8_LDA(At, 0, 1); PG8_STAGE(PG8_SB(0, 0), b2, voffB); PG8_STAGE(PG8_SB(0, 1), b2 + hstep, voffB); PG8_STAGE(PG8_SA(0, 0), a2, voffA); \
            PG8_WAIT_V(W2); PG8_WAIT_L(0); PG8_BAR; PG8_MMA(1, 0, At, B0); PG8_MMA(1, 1, At, B1); PG8_BAR; PG8_SCHED; \
            PG8_LDB(B0, 1, 0); PG8_LDB(B1, 1, 1); PG8_SCHED; PG8_LDA(At, 1, 0); PG8_STAGE(PG8_SA(0, 1), a2 + hstep, voffA); \
            PG8_WAIT_V(W3); PG8_WAIT_L(0); PG8_BAR; PG8_MMA(0, 0, At, B0); PG8_MMA(0, 1, At, B1); PG8_BAR; PG8_SCHED; \
            PG8_LDA(At, 1, 1); PG8_STAGE(PG8_SB(1, 0), b3, voffB); PG8_STAGE(PG8_SB(1, 1), b3 + hstep, voffB); PG8_STAGE(PG8_SA(1, 0), a3, voffA); \
            PG8_WAIT_V(8); PG8_WAIT_L(0); PG8_BAR; PG8_MMA(1, 0, At, B0); PG8_MMA(1, 1, At, B1); PG8_BAR; PG8_SCHED; } while (0)
        if constexpr (SP2 && ALIGN_EPI && Epi::SLACK) {
            if (ui > 0 && E.slack_ok()) {
                const char* a1 = cA + kstep; const char* a2 = cA + 2 * kstep; const char* b2 = cB + 2 * kstep; const char* a3 = a2 + kstep; const char* b3 = b2 + kstep;
                PG8_SP2_TRIP(false, 24, 24, 24);
                t = 2;
            }
        }
        for (; t < nt; t += 2) {
            const bool last = (t == nt - 2);
            const char* a1 = cA + (size_t)(t + 1) * kstep;
            const char* a2 = last ? nA : cA + (size_t)(t + 2) * kstep; const char* b2 = last ? nB : cB + (size_t)(t + 2) * kstep;
            const char* a3 = a2 + kstep; const char* b3 = b2 + kstep;
            if (last && has_next) S.a_ready(nxt);
            if constexpr (SP2) {
            PG8_SP2_TRIP(true, 8, 8, 8);
            } else {
            PG8_LDB(B0, 0, 0); PG8_SCHED; PG8_LDA(At, 0, 0); PG8_STAGE(PG8_SA(1, 1), a1 + hstep, voffA);
            PG8_WAIT_L(8); PG8_BAR; PG8_WAIT_L(0); PG8_MMA(0, 0, At, B0); PG8_BAR; PG8_SCHED;
            PG8_LDB(B1, 0, 1); PG8_STAGE(PG8_SB(0, 0), b2, voffB);
            PG8_BAR; PG8_WAIT_L(0); PG8_MMA(0, 1, At, B1); PG8_BAR;
            PG8_LDA(At, 0, 1); PG8_STAGE(PG8_SA(0, 0), a2, voffA);
            PG8_BAR; PG8_WAIT_L(0); PG8_MMA(1, 0, At, B0); PG8_BAR; PG8_SCHED;
            PG8_STAGE(PG8_SB(0, 1), b2 + hstep, voffB);
            PG8_WAIT_V(6); PG8_BAR; PG8_MMA(1, 1, At, B1); PG8_BAR;
            PG8_LDB(B0, 1, 0); PG8_SCHED; PG8_LDA(At, 1, 0); PG8_STAGE(PG8_SA(0, 1), a2 + hstep, voffA);
            PG8_WAIT_L(8); PG8_BAR; PG8_WAIT_L(0); PG8_MMA(0, 0, At, B0); PG8_BAR; PG8_SCHED;
            PG8_LDB(B1, 1, 1); PG8_STAGE(PG8_SB(1, 0), b3, voffB);
            PG8_BAR; PG8_WAIT_L(0); PG8_MMA(0, 1, At, B1); PG8_BAR;
            PG8_LDA(At, 1, 1); PG8_STAGE(PG8_SA(1, 0), a3, voffA);
            PG8_BAR; PG8_WAIT_L(0); PG8_MMA(1, 0, At, B0); PG8_BAR; PG8_SCHED;
            PG8_STAGE(PG8_SB(1, 1), b3 + hstep, voffB);
            PG8_WAIT_V(6); PG8_BAR; PG8_MMA(1, 1, At, B1); PG8_BAR;
            }
        }
        if constexpr (ALIGN_EPI) { if (wr == 0) PG8_BAR; }
        if constexpr (SP2 && ALIGN_EPI && Epi::SLACK) { if (has_next && E.slack_ok()) PG8_STAGE(PG8_SA(1, 1), nA + kstep + hstep, voffA); }
        bool chain_first = false;
        if constexpr (Epi::MID) { chain_first = (cur.kofs == 0); }
        if constexpr (!Epi::AFTER_DRAIN) { if (chain_first) E.mid(acc, cur, wr, wc, fr, fq); else { E(acc, cur, wr, wc, fr, fq); S.done(cur); } }
        if (!has_next) break;
        if constexpr (Epi::PRELOAD) E.preload(acc, nxt, wr, wc, fr, fq);
        else if (!chain_first)
#pragma unroll
        for (int a = 0; a < 2; ++a)
#pragma unroll
            for (int b = 0; b < 2; ++b)
#pragma unroll
                for (int m = 0; m < 4; ++m)
#pragma unroll
                    for (int n = 0; n < 2; ++n) acc[a][b][m][n] = (f32x4){0.f, 0.f, 0.f, 0.f};
        cur = nxt; cA = nA; cB = nB; ++ui;
        if constexpr (ALIGN_EPI) { if (wr == 1) PG8_BAR; }
    }
    PG8_WAIT_V(0);
    if constexpr (!ALIGN_EPI) { if (wr == 0) PG8_BAR; }
    PG8_BAR;
    if constexpr (Epi::AFTER_DRAIN) { E.fused(acc, cur, wr, wc, fr, fq, lds, wid, lane); S.done(cur); }
#undef PG8_SP2_TRIP
#undef PG8_SA
#undef PG8_SB
#undef PG8_STAGE
#undef PG8_LDA
#undef PG8_LDB
#undef PG8_MMA
#undef PG8_WAIT_V
#undef PG8_WAIT_L
#undef PG8_BAR
#undef PG8_SCHED
}
}

namespace sba {
using bf16x8 = __attribute__((ext_vector_type(8))) short;
using s16x4  = __attribute__((ext_vector_type(4))) short;
using f32x16 = __attribute__((ext_vector_type(16))) float;
using u32x4  = __attribute__((ext_vector_type(4))) unsigned;
typedef _Float16 half8 __attribute__((ext_vector_type(8)));
typedef float f32x4 __attribute__((ext_vector_type(4)));
typedef _Float16 half2v __attribute__((ext_vector_type(2)));
typedef float float2v __attribute__((ext_vector_type(2)));
constexpr int KVBLK = 64;
constexpr int SHM_V = KVBLK * 128 * 2, SHM_K = KVBLK * 128 * 2;
constexpr int OFF_V = 0, OFF_K = 2 * SHM_V, OFF_FLAG = 2 * SHM_V + 2 * SHM_K;
#define KSWZ(row, colB) ((row) * 256 + ((colB) ^ (((row) & 7) << 4)))
#define SBAR() __builtin_amdgcn_sched_barrier(0)
__device__ __forceinline__ int crow(int r, int hi) { return (r & 3) + 8 * (r >> 2) + 4 * hi; }
__device__ __forceinline__ unsigned cvtpk(float lo, float hi) { unsigned r; asm volatile("v_cvt_pk_bf16_f32 %0, %1, %2" : "=v"(r) : "v"(lo), "v"(hi)); return r; }
__device__ __forceinline__ void qkt(f32x16& p0, f32x16& p1, const char* Ks, const bf16x8* qr, int r32, int hi) {
  p0 = f32x16{}; p1 = f32x16{};
#pragma unroll
  for (int d0 = 0; d0 < 8; ++d0) { const int cb = (d0 * 16 + hi * 8) * 2;
    const bf16x8 b0 = *reinterpret_cast<const bf16x8*>(Ks + KSWZ(r32, cb));
    const bf16x8 b1 = *reinterpret_cast<const bf16x8*>(Ks + KSWZ(32 + r32, cb));
    p0 = __builtin_amdgcn_mfma_f32_32x32x16_bf16(b0, qr[d0], p0, 0, 0, 0);
    p1 = __builtin_amdgcn_mfma_f32_32x32x16_bf16(b1, qr[d0], p1, 0, 0, 0); }
}
__device__ __forceinline__ int v_st(int k, int c) { const int kk = (k & ~0xC) | ((k & 4) << 1) | ((k & 8) >> 1); return ((kk >> 3) * 4 + (c >> 5)) * 512 + ((kk & 7) * 32 + (c & 31)) * 2; }
__device__ __forceinline__ int v_rd_base(int lane) { return ((lane & 3) << 3) | (((lane >> 2) & 3) << 6) | (((lane >> 4) & 1) << 5) | (((lane >> 5) & 1) << 8); }
constexpr int v_rd_off(int d0, int ks, int half) { return d0 * 512 + ks * 4096 + half * 2048; }
template <int OFF> __device__ __forceinline__ s16x4 tr_read(int vb) {
  s16x4 r; asm volatile("ds_read_b64_tr_b16 %0, %1 offset:%2" : "=&v"(r) : "v"(vb), "i"(OFF) : "memory"); return r;
}
template <int D0> __device__ __forceinline__ void pv_one(f32x16& od, int vb, bf16x8 pa0, bf16x8 pa1, bf16x8 pa2, bf16x8 pa3) {
  const s16x4 l0 = tr_read<v_rd_off(D0, 0, 0)>(vb), h0 = tr_read<v_rd_off(D0, 0, 1)>(vb), l1 = tr_read<v_rd_off(D0, 1, 0)>(vb), h1 = tr_read<v_rd_off(D0, 1, 1)>(vb);
  const s16x4 l2 = tr_read<v_rd_off(D0, 2, 0)>(vb), h2 = tr_read<v_rd_off(D0, 2, 1)>(vb), l3 = tr_read<v_rd_off(D0, 3, 0)>(vb), h3 = tr_read<v_rd_off(D0, 3, 1)>(vb);
  asm volatile("s_waitcnt lgkmcnt(0)" ::: "memory"); SBAR();
#define PK(L, H) (bf16x8){L[0], L[1], L[2], L[3], H[0], H[1], H[2], H[3]}
  od = __builtin_amdgcn_mfma_f32_32x32x16_bf16(pa0, PK(l0, h0), od, 0, 0, 0);
  od = __builtin_amdgcn_mfma_f32_32x32x16_bf16(pa1, PK(l1, h1), od, 0, 0, 0);
  od = __builtin_amdgcn_mfma_f32_32x32x16_bf16(pa2, PK(l2, h2), od, 0, 0, 0);
  od = __builtin_amdgcn_mfma_f32_32x32x16_bf16(pa3, PK(l3, h3), od, 0, 0, 0);
#undef PK
}
struct VFrag { s16x4 l0, h0, l1, h1, l2, h2, l3, h3; };
template <int OFFB> __device__ __forceinline__ void vf_read(VFrag& f, int vb) {
  f.l0 = tr_read<OFFB + v_rd_off(0, 0, 0)>(vb); f.h0 = tr_read<OFFB + v_rd_off(0, 0, 1)>(vb); f.l1 = tr_read<OFFB + v_rd_off(0, 1, 0)>(vb); f.h1 = tr_read<OFFB + v_rd_off(0, 1, 1)>(vb);
  f.l2 = tr_read<OFFB + v_rd_off(0, 2, 0)>(vb); f.h2 = tr_read<OFFB + v_rd_off(0, 2, 1)>(vb); f.l3 = tr_read<OFFB + v_rd_off(0, 3, 0)>(vb); f.h3 = tr_read<OFFB + v_rd_off(0, 3, 1)>(vb);
}
__device__ __forceinline__ void vf_mma(f32x16& od, const VFrag& f, bf16x8 pa0, bf16x8 pa1, bf16x8 pa2, bf16x8 pa3) {
#define PK(L, H) (bf16x8){L[0], L[1], L[2], L[3], H[0], H[1], H[2], H[3]}
  od = __builtin_amdgcn_mfma_f32_32x32x16_bf16(pa0, PK(f.l0, f.h0), od, 0, 0, 0);
  od = __builtin_amdgcn_mfma_f32_32x32x16_bf16(pa1, PK(f.l1, f.h1), od, 0, 0, 0);
  od = __builtin_amdgcn_mfma_f32_32x32x16_bf16(pa2, PK(f.l2, f.h2), od, 0, 0, 0);
  od = __builtin_amdgcn_mfma_f32_32x32x16_bf16(pa3, PK(f.l3, f.h3), od, 0, 0, 0);
#undef PK
}
#define LGK_WAIT(n) do { asm volatile("s_waitcnt lgkmcnt(" #n ")" ::: "memory"); SBAR(); } while (0)
__device__ __forceinline__ void pv_pipe4(f32x16* o, int vb, bf16x8 pa0, bf16x8 pa1, bf16x8 pa2, bf16x8 pa3) {
  VFrag fa, fb;
  vf_read<0>(fa, vb);
  vf_read<512>(fb, vb);  LGK_WAIT(8); vf_mma(o[0], fa, pa0, pa1, pa2, pa3);
  vf_read<1024>(fa, vb); LGK_WAIT(8); vf_mma(o[1], fb, pa0, pa1, pa2, pa3);
  vf_read<1536>(fb, vb); LGK_WAIT(8); vf_mma(o[2], fa, pa0, pa1, pa2, pa3);
  LGK_WAIT(0); vf_mma(o[3], fb, pa0, pa1, pa2, pa3);
}
__device__ __forceinline__ void pv_pipe8(f32x16* o, int vb, bf16x8 pa0, bf16x8 pa1, bf16x8 pa2, bf16x8 pa3) {
  VFrag fa, fb;
  vf_read<0>(fa, vb);
  vf_read<512>(fb, vb);  LGK_WAIT(8); vf_mma(o[0], fa, pa0, pa1, pa2, pa3);
  vf_read<1024>(fa, vb); LGK_WAIT(8); vf_mma(o[1], fb, pa0, pa1, pa2, pa3);
  vf_read<1536>(fb, vb); LGK_WAIT(8); vf_mma(o[2], fa, pa0, pa1, pa2, pa3);
  vf_read<SHM_V + 0>(fa, vb);    LGK_WAIT(8); vf_mma(o[3], fb, pa0, pa1, pa2, pa3);
  vf_read<SHM_V + 512>(fb, vb);  LGK_WAIT(8); vf_mma(o[4], fa, pa0, pa1, pa2, pa3);
  vf_read<SHM_V + 1024>(fa, vb); LGK_WAIT(8); vf_mma(o[5], fb, pa0, pa1, pa2, pa3);
  vf_read<SHM_V + 1536>(fb, vb); LGK_WAIT(8); vf_mma(o[6], fa, pa0, pa1, pa2, pa3);
  LGK_WAIT(0); vf_mma(o[7], fb, pa0, pa1, pa2, pa3);
}
__device__ __forceinline__ void pv_d0(f32x16* o, int vb, bf16x8 pa0, bf16x8 pa1, bf16x8 pa2, bf16x8 pa3) {
  pv_one<0>(o[0], vb, pa0, pa1, pa2, pa3); pv_one<1>(o[1], vb, pa0, pa1, pa2, pa3); pv_one<2>(o[2], vb, pa0, pa1, pa2, pa3); pv_one<3>(o[3], vb, pa0, pa1, pa2, pa3);
}
__device__ __forceinline__ half8 pack_h8(const f32x16& l, int base) {
  half8 r;
#pragma unroll
  for (int j = 0; j < 8; j += 2) { const float2v f = {l[base + j], l[base + j + 1]}; const half2v hh = __builtin_convertvector(f, half2v); r[j] = hh[0]; r[j + 1] = hh[1]; }
  return r;
}
template <bool BAND>
__device__ __forceinline__ void sb_half(f32x16& p, float& R, const half8 U0, const half8 U1, int kbase, int row_rel, int hi) {
  f32x16 l;
#pragma unroll
  for (int r = 0; r < 16; ++r) {
    const float z = fminf(p[r], 80.0f); p[r] = z;
    float lv = -__builtin_amdgcn_logf(1.0f + __builtin_amdgcn_exp2f(z));
    if (BAND) lv = (kbase + crow(r, hi) < row_rel) ? lv : 0.0f;
    l[r] = lv;
  }
  const half8 lf0 = pack_h8(l, 0), lf1 = pack_h8(l, 8);
  f32x16 E = __builtin_amdgcn_mfma_f32_32x32x16_f16(U0, lf0, f32x16{}, 0, 0, 0);
  E = __builtin_amdgcn_mfma_f32_32x32x16_f16(U1, lf1, E, 0, 0, 0);
#pragma unroll
  for (int r = 0; r < 16; ++r) {
    float w = __builtin_amdgcn_exp2f((p[r] + R) + (l[r] + E[r]));
    if (BAND) w = (kbase + crow(r, hi) < row_rel) ? w : 0.0f;
    p[r] = w;
  }
  const float tot = E[0] + l[0];
  const auto rr = __builtin_amdgcn_permlane32_swap(__float_as_uint(tot), __float_as_uint(tot), false, false);
  R += __uint_as_float(rr[0]);
}
#define PK4(P, BASE, OUT) do { unsigned a0 = cvtpk(P[BASE + 0], P[BASE + 1]), a1 = cvtpk(P[BASE + 2], P[BASE + 3]);   \
    unsigned b0 = cvtpk(P[BASE + 4], P[BASE + 5]), b1 = cvtpk(P[BASE + 6], P[BASE + 7]);                              \
    auto r0 = __builtin_amdgcn_permlane32_swap(a0, b0, false, false); auto r1 = __builtin_amdgcn_permlane32_swap(a1, b1, false, false); \
    u32x4 w = {r0[0], r1[0], r0[1], r1[1]}; OUT = *reinterpret_cast<bf16x8*>(&w); } while (0)

__device__ __forceinline__ void glds16(const void* g, unsigned lds_base) {
  unsigned sv; asm volatile("s_mov_b32 %0, m0\n\ts_mov_b32 m0, %2\n\ts_nop 0\n\tglobal_load_lds_dwordx4 %1, off\n\ts_mov_b32 m0, %0" : "=&s"(sv) : "v"(g), "s"(lds_base) : "memory"); }
#define VM_WAIT(n) do { asm volatile("s_waitcnt vmcnt(" #n ")" ::: "memory"); SBAR(); } while (0)
constexpr int R_SHM_V = 2 * SHM_V, R_OFF_V = 0, R_OFF_K = 2 * R_SHM_V;
__device__ __forceinline__ void retU_unit(int b, int h, int j, unsigned char* act, float* U, char* lds) {
  int tid = threadIdx.x; asm volatile("" : "+v"(tid));
  const int wid = __builtin_amdgcn_readfirstlane(tid >> 6), lane = tid & 63, r32 = lane & 31, hi = lane >> 5;
  const bf16* RQK = (const bf16*)(act + A_RQK + (size_t)b * SKIP2K); const bf16* RV = (const bf16*)(act + A_RV + (size_t)b * SKIP2K);
  const bf16* Kh = RQK + (size_t)(b * SEQ + j * 256) * 1024 + 512 + h * 128; const bf16* Vh = RV + (size_t)(b * SEQ + j * 256) * 1024 + h * 256;
  const int vb0 = (int)(uintptr_t)(lds + R_OFF_V) + v_rd_base(lane), kb0 = (int)(uintptr_t)(lds + R_OFF_K) + v_rd_base(lane) + (wid & 3) * 512;
  const unsigned lds0 = (unsigned)__builtin_amdgcn_readfirstlane((int)(uintptr_t)lds);
  const int kkv = 8 * wid + ((lane & 31) >> 2), kv = (kkv & ~0xC) | ((kkv & 4) << 1) | ((kkv & 8) >> 1);
  const bf16* vsrc = Vh + (size_t)kv * 1024 + (lane >> 5) * 32 + (lane & 3) * 8;
  const bf16* ksrc = Kh + (size_t)kv * 1024 + (lane >> 5) * 32 + (lane & 3) * 8;
#define UDMA(k0, bb) do { const size_t ro_ = (size_t)(k0) * 1024; const unsigned kd_ = lds0 + R_OFF_K + (bb) * SHM_K + wid * 2048, vd_ = lds0 + R_OFF_V + (bb) * R_SHM_V + wid * 2048; \
    glds16(ksrc + ro_, kd_); glds16(ksrc + ro_ + 64, kd_ + 1024); \
    glds16(vsrc + ro_, vd_); glds16(vsrc + ro_ + 64, vd_ + 1024); glds16(vsrc + ro_ + 128, vd_ + SHM_V); glds16(vsrc + ro_ + 192, vd_ + SHM_V + 1024); } while (0)
  f32x16 o[4] = {};
  UDMA(0, 0);
  VM_WAIT(0); __syncthreads();
  int cur = 0;
#pragma unroll 1
  for (int t = 0; t < 4; ++t) {
    if (t < 3) UDMA((t + 1) * KVBLK, cur ^ 1);
    {
      VFrag fk; SBAR(); vf_read<0>(fk, kb0 + cur * SHM_K); LGK_WAIT(0);
#define PK(L, H) (bf16x8){L[0], L[1], L[2], L[3], H[0], H[1], H[2], H[3]}
      const bf16x8 pa0 = PK(fk.l0, fk.h0), pa1 = PK(fk.l1, fk.h1), pa2 = PK(fk.l2, fk.h2), pa3 = PK(fk.l3, fk.h3);
#undef PK
      pv_pipe4(o, vb0 + cur * R_SHM_V + (wid >> 2) * SHM_V, pa0, pa1, pa2, pa3);
    }
    VM_WAIT(0);
    __syncthreads();
    cur ^= 1;
  }
#undef UDMA
  float* up = U + (size_t)(32 * (wid & 3)) * 256 + 128 * (wid >> 2) + r32;
#pragma unroll
  for (int d = 0; d < 4; ++d)
#pragma unroll
    for (int r = 0; r < 16; ++r) up[crow(r, hi) * 256 + d * 32] = o[d][r];
}
__device__ __forceinline__ float* ret_ubuf(unsigned char* ws, int b, int h, int j) { return (float*)(ws + WS_U) + (size_t)((b * 4 + h) * 7 + j) * (128 * 256); }
__device__ __forceinline__ void retU_phase(unsigned char* act, unsigned char* ws, char* lds, int bx) {
  const int NU = BG * 4 * 8;
  for (int u = bx; u < NU; u += gridDim.x) {
    const int qb = 7 - u / (NU / 8), b = u & 7, h = (u >> 3) & 3;
    if (qb < 7) retU_unit(b, h, qb, act, ret_ubuf(ws, b, h, qb), lds);
  }
}
__device__ __forceinline__ void ret_unit(int b, int h, int qb, unsigned char* act, const float* U0, char* lds, bool dry) {
  int tid = threadIdx.x; asm volatile("" : "+v"(tid));
  const int wid = __builtin_amdgcn_readfirstlane(tid >> 6), lane = tid & 63, r32 = lane & 31, hi = lane >> 5;
  const bf16* RQK = (const bf16*)(act + A_RQK + (size_t)b * SKIP2K); const bf16* RV = (const bf16*)(act + A_RV + (size_t)b * SKIP2K); bf16* GS = (bf16*)(act + A_GS + (size_t)b * SKIP4K);
  char* V_lds = lds + R_OFF_V; char* K_lds = lds + R_OFF_K;
  const int q0 = qb * 256;
  bf16x8 qr[8];
  { const bf16* Qw = RQK + (size_t)(b * SEQ + q0 + wid * 32 + r32) * 1024 + h * 128 + hi * 8;
#pragma unroll
    for (int d0 = 0; d0 < 8; ++d0) qr[d0] = *reinterpret_cast<const bf16x8*>(Qw + d0 * 16); }
  const bf16* Kh = RQK + (size_t)(b * SEQ) * 1024 + 512 + h * 128; const bf16* Vh = RV + (size_t)(b * SEQ) * 1024 + h * 256;
  const int vb0 = (int)(uintptr_t)V_lds + v_rd_base(lane);
  const unsigned lds0 = (unsigned)__builtin_amdgcn_readfirstlane((int)(uintptr_t)lds);
  const int krow = lane >> 4, kch = lane & 15;
  const bf16* ksrcE = Kh + (size_t)(8 * wid + krow) * 1024 + (((kch * 16) ^ (krow << 4)) >> 1);
  const bf16* ksrcO = Kh + (size_t)(8 * wid + 4 + krow) * 1024 + (((kch * 16) ^ ((4 + krow) << 4)) >> 1);
  const int kkv = 8 * wid + ((lane & 31) >> 2), kv = (kkv & ~0xC) | ((kkv & 4) << 1) | ((kkv & 8) >> 1);
  const bf16* vsrc = Vh + (size_t)kv * 1024 + (lane >> 5) * 32 + (lane & 3) * 8;
#define SDMA(k0, bb) do { const size_t ro_ = (size_t)(k0) * 1024; const unsigned kd_ = lds0 + R_OFF_K + (bb) * SHM_K + wid * 2048, vd_ = lds0 + R_OFF_V + (bb) * R_SHM_V + wid * 2048; \
    glds16(ksrcE + ro_, kd_); glds16(ksrcO + ro_, kd_ + 1024); \
    glds16(vsrc + ro_, vd_); glds16(vsrc + ro_ + 64, vd_ + 1024); glds16(vsrc + ro_ + 128, vd_ + SHM_V); glds16(vsrc + ro_ + 192, vd_ + SHM_V + 1024); } while (0)
  f32x16 o[8] = {};
  const int NT = 4 * qb + 4, row_rel = 32 * wid + r32;
  SDMA((NT - 1) * KVBLK, 0);
  VM_WAIT(0); __syncthreads();
  int cur = 0;
  for (int jt = NT - 1; jt >= 4 * qb; --jt) {
    const int kb = 64 * (jt - 4 * qb);
    if (jt > 4 * qb) SDMA((jt - 1) * KVBLK, cur ^ 1);
    {
      f32x16 p0, p1; bf16x8 pa0, pa1, pa2, pa3;
      SBAR(); qkt(p0, p1, K_lds + cur * SHM_K, qr, r32, hi);
      if (kb >= 0) {
#pragma unroll
        for (int r = 0; r < 16; ++r) { const int kr = kb + crow(r, hi); p0[r] = (kr <= row_rel) ? p0[r] : 0.0f; p1[r] = (kr + 32 <= row_rel) ? p1[r] : 0.0f; }
      }
      PK4(p0, 0, pa0); PK4(p0, 8, pa1); PK4(p1, 0, pa2); PK4(p1, 8, pa3);
      LGK_WAIT(0); pv_pipe8(o, vb0 + cur * R_SHM_V, pa0, pa1, pa2, pa3);
    }
    VM_WAIT(0);
    __syncthreads();
    cur ^= 1;
  }
#undef SDMA
  if (qb > 0) {
#pragma unroll 1
    for (int half = 0; half < 2; ++half) {
      f32x4 a[4][2];
#pragma unroll
      for (int i = 0; i < 4; ++i) { a[i][0] = (f32x4){0.f, 0.f, 0.f, 0.f}; a[i][1] = (f32x4){0.f, 0.f, 0.f, 0.f}; }
      const float* up = U0 + (size_t)(half * 2048 + tid) * 8;
#pragma unroll 1
      for (int jj = 0; jj < qb; ++jj) {
        f32x4 t[4][2];
#pragma unroll
        for (int i = 0; i < 4; ++i) { t[i][0] = *(const f32x4*)(up + i * 4096); t[i][1] = *(const f32x4*)(up + i * 4096 + 4); }
#pragma unroll
        for (int i = 0; i < 4; ++i) { a[i][0] += t[i][0]; a[i][1] += t[i][1]; }
        up += 128 * 256;
      }
#pragma unroll
      for (int i = 0; i < 4; ++i) {
        const int idx = half * 2048 + i * 512 + tid, k = idx >> 5, c = (idx & 31) * 8;
        u32x4 w; w[0] = cvtpk(a[i][0][0], a[i][0][1]); w[1] = cvtpk(a[i][0][2], a[i][0][3]); w[2] = cvtpk(a[i][1][0], a[i][1][1]); w[3] = cvtpk(a[i][1][2], a[i][1][3]);
        *(u32x4*)(V_lds + (k >> 6) * R_SHM_V + (c >> 7) * SHM_V + v_st(k & 63, c & 127)) = w;
      }
    }
    __syncthreads();
    pv_pipe8(o, vb0, qr[0], qr[1], qr[2], qr[3]);
    pv_pipe8(o, vb0 + R_SHM_V, qr[4], qr[5], qr[6], qr[7]);
    __syncthreads();
  }
  { float* stg = (float*)(lds + wid * 16384);
    const int row = lane >> 1, hc = lane & 1;
    f32x4 x[32]; float sm = 0.f, sq = 0.f;
#pragma unroll
    for (int hf = 0; hf < 2; ++hf) {
#pragma unroll
      for (int r = 0; r < 16; ++r) { const int orow = crow(r, hi);
#pragma unroll
        for (int d0 = 0; d0 < 4; ++d0) stg[orow * 128 + d0 * 32 + r32] = o[hf * 4 + d0][r]; }
      asm volatile("s_waitcnt lgkmcnt(0)" ::: "memory");
#pragma unroll
      for (int i = 0; i < 16; ++i) { const f32x4 v = *(const f32x4*)(stg + row * 128 + hc * 64 + i * 4); x[hf * 16 + i] = v;
        sm += (v[0] + v[1]) + (v[2] + v[3]); sq += (v[0] * v[0] + v[1] * v[1]) + (v[2] * v[2] + v[3] * v[3]); }
      asm volatile("s_waitcnt lgkmcnt(0)" ::: "memory");
    }
    sm += __shfl_xor(sm, 1); sq += __shfl_xor(sq, 1);
    const float mean = sm * (1.0f / 256.0f), var = fmaxf(sq * (1.0f / 256.0f) - mean * mean, 0.0f), rstd = rsqrtf(var + GN_EPS);
    bf16* gp = GS + (size_t)(b * SEQ + q0 + wid * 32 + row) * 2048 + h * 256 + hc * 64;
    u32x4 gwv[2][8];
#pragma unroll
    for (int hf = 0; hf < 2; ++hf)
#pragma unroll
      for (int i = 0; i < 8; ++i) gwv[hf][i] = *(const u32x4*)(gp + hf * 128 + i * 8);
    asm volatile("" ::: "memory");
#pragma unroll
    for (int hf = 0; hf < 2; ++hf)
#pragma unroll
      for (int i = 0; i < 8; ++i) {
        bf16* gq = gp + hf * 128 + i * 8;
        const u32x4 gw = gwv[hf][i];
        const f32x4 a = x[hf * 16 + 2 * i], c = x[hf * 16 + 2 * i + 1];
        u32x4 ow;
        ow[0] = cvtpk((a[0] - mean) * rstd * __builtin_bit_cast(float, gw[0] << 16), (a[1] - mean) * rstd * __builtin_bit_cast(float, gw[0] & 0xffff0000u));
        ow[1] = cvtpk((a[2] - mean) * rstd * __builtin_bit_cast(float, gw[1] << 16), (a[3] - mean) * rstd * __builtin_bit_cast(float, gw[1] & 0xffff0000u));
        ow[2] = cvtpk((c[0] - mean) * rstd * __builtin_bit_cast(float, gw[2] << 16), (c[1] - mean) * rstd * __builtin_bit_cast(float, gw[2] & 0xffff0000u));
        ow[3] = cvtpk((c[2] - mean) * rstd * __builtin_bit_cast(float, gw[3] << 16), (c[3] - mean) * rstd * __builtin_bit_cast(float, gw[3] & 0xffff0000u));
        if (!dry) *(u32x4*)gq = ow;
      }
  }
  __syncthreads();
}
__device__ __forceinline__ void ret_phase(unsigned char* act, unsigned char* ws, char* lds, bool dry, int bx) {
  const int NU = BG * 4 * 8;
  for (int u = bx; u < NU; u += gridDim.x) {
    const int qb = 7 - u / (NU / 8), b = u & 7, h = (u >> 3) & 3;
    ret_unit(b, h, qb, act, ret_ubuf(ws, b, h, 0), lds, dry);
  }
}
template <int D0> __device__ __forceinline__ void pv32_read(s16x4 (&f)[4], int vb) {
  f[0] = tr_read<v_rd_off(D0, 0, 0)>(vb); f[1] = tr_read<v_rd_off(D0, 0, 1)>(vb); f[2] = tr_read<v_rd_off(D0, 1, 0)>(vb); f[3] = tr_read<v_rd_off(D0, 1, 1)>(vb);
}
__device__ __forceinline__ void pv32_mma(f32x16& od, const s16x4 (&f)[4], bf16x8 pa0, bf16x8 pa1) {
  od = __builtin_amdgcn_mfma_f32_32x32x16_bf16(pa0, (bf16x8){f[0][0], f[0][1], f[0][2], f[0][3], f[1][0], f[1][1], f[1][2], f[1][3]}, od, 0, 0, 0);
  od = __builtin_amdgcn_mfma_f32_32x32x16_bf16(pa1, (bf16x8){f[2][0], f[2][1], f[2][2], f[2][3], f[3][0], f[3][1], f[3][2], f[3][3]}, od, 0, 0, 0);
}
__device__ __forceinline__ void sbw_unit(int b, int h, int rb, unsigned char* act, char* wlds, bool dry) {
  int tid = threadIdx.x; asm volatile("" : "+v"(tid));
  const int lane = tid & 63, r32 = lane & 31, hi = lane >> 5;
  const bf16* GS = (const bf16*)(act + A_GS + (size_t)b * SKIP4K); const bf16* SK = (const bf16*)(act + A_SK + (size_t)b * SKIP2K); const bf16* SV = (const bf16*)(act + A_SV + (size_t)b * SKIP2K);
  char* K_l = wlds;
  const unsigned k_lds = (unsigned)__builtin_amdgcn_readfirstlane((int)(uintptr_t)wlds), v_lds = k_lds + 8192u;
  const int q0 = rb * 32;
  half8 U0, U1;
#pragma unroll
  for (int j = 0; j < 8; ++j) { const int kp = 8 * (j >> 2) + 4 * hi + (j & 3); U0[j] = (kp > r32) ? (_Float16)1.0f : (_Float16)0.0f; U1[j] = (16 + kp > r32) ? (_Float16)1.0f : (_Float16)0.0f; }
  bf16x8 qr[8];
  { const bf16* Qw = GS + (size_t)(b * SEQ + q0 + r32) * 2048 + 1024 + h * 128 + hi * 8;
#pragma unroll
    for (int d0 = 0; d0 < 8; ++d0) qr[d0] = *reinterpret_cast<const bf16x8*>(Qw + d0 * 16); }
  const bf16* Kh = SK + (size_t)(b * SEQ) * 1024 + h * 128; const bf16* Vh = SV + (size_t)(b * SEQ) * 1024 + h * 128;
  const int krow = lane >> 4, kch = lane & 15;
  const bf16* ksrc0 = Kh + (size_t)krow * 1024 + (((kch * 16) ^ (krow << 4)) >> 1);
  const bf16* ksrc1 = Kh + (size_t)(4 + krow) * 1024 + (((kch * 16) ^ ((4 + krow) << 4)) >> 1);
  const int vkl = (lane & 31) >> 2, vcc = (lane & 3) * 8, vhalf = lane >> 5;
#define KDMA(kt) do { const bf16* s0_ = ksrc0 + (size_t)(kt) * 32 * 1024; const bf16* s1_ = ksrc1 + (size_t)(kt) * 32 * 1024; \
    _Pragma("unroll") for (int q_ = 0; q_ < 4; ++q_) { glds16(s0_ + (size_t)q_ * 8 * 1024, k_lds + q_ * 2048); glds16(s1_ + (size_t)q_ * 8 * 1024, k_lds + q_ * 2048 + 1024); } } while (0)
#define VDMA(kt) do { const bf16* vb_ = Vh + (size_t)(kt) * 32 * 1024 + vcc; \
    _Pragma("unroll") for (int q_ = 0; q_ < 8; ++q_) { const int kk_ = 8 * (q_ >> 1) + vkl, k_ = (kk_ & ~0xC) | ((kk_ & 4) << 1) | ((kk_ & 8) >> 1); \
      glds16(vb_ + (size_t)k_ * 1024 + (2 * (q_ & 1) + vhalf) * 32, v_lds + q_ * 1024); } } while (0)
  const int vb = (int)v_lds + v_rd_base(lane);
  f32x16 o[4] = {}; float R = 0.f;
  KDMA(rb); VDMA(rb);
  for (int kt = rb; kt >= 0; --kt) {
    VM_WAIT(8);
    f32x16 p = {};
#pragma unroll
    for (int d0 = 0; d0 < 8; ++d0) { const bf16x8 kf = *reinterpret_cast<const bf16x8*>(K_l + KSWZ(r32, (d0 * 16 + hi * 8) * 2)); p = __builtin_amdgcn_mfma_f32_32x32x16_bf16(kf, qr[d0], p, 0, 0, 0); }
    LGK_WAIT(0);
    if (kt > 0) KDMA(kt - 1);
    if (kt == rb) sb_half<true>(p, R, U0, U1, 0, r32, hi); else sb_half<false>(p, R, U0, U1, 0, 0, hi);
    bf16x8 pa0, pa1; PK4(p, 0, pa0); PK4(p, 8, pa1);
    if (kt > 0) VM_WAIT(8); else VM_WAIT(0);
    { s16x4 f0[4], f1[4], f2[4], f3[4];
      pv32_read<0>(f0, vb); pv32_read<1>(f1, vb); pv32_read<2>(f2, vb); pv32_read<3>(f3, vb);
      LGK_WAIT(0);
      if (kt > 0) VDMA(kt - 1);
      pv32_mma(o[0], f0, pa0, pa1); pv32_mma(o[1], f1, pa0, pa1); pv32_mma(o[2], f2, pa0, pa1); pv32_mma(o[3], f3, pa0, pa1); }
    if (__all(R < -160.0f)) break;
  }
  VM_WAIT(0);
  { bf16* stg = (bf16*)wlds;
#pragma unroll
    for (int r = 0; r < 16; ++r) { const int orow = crow(r, hi);
#pragma unroll
      for (int d0 = 0; d0 < 4; ++d0) stg[orow * 128 + d0 * 32 + r32] = (bf16)f2bf(o[d0][r]); }
    asm volatile("s_waitcnt lgkmcnt(0)" ::: "memory");
    bf16* Ow = (bf16*)GS + (size_t)(b * SEQ + q0) * 2048 + 1024 + h * 128;
#pragma unroll
    for (int i = 0; i < 8; ++i) { const int row = i * 4 + (lane >> 4), ch = lane & 15; const u32x4 v = *(const u32x4*)(stg + row * 128 + ch * 8); if (!dry) *(u32x4*)(Ow + (size_t)row * 2048 + ch * 8) = v; }
    asm volatile("s_waitcnt lgkmcnt(0)" ::: "memory");
  }
#undef KDMA
#undef VDMA
}
__device__ __forceinline__ void sb_phase(unsigned char* act, char* lds, bool dry, unsigned* ctr, int bx) {
  const int NU = BG * 8 * 64;
  int tid = threadIdx.x; asm volatile("" : "+v"(tid));
  const int wid = __builtin_amdgcn_readfirstlane(tid >> 6), lane = tid & 63;
  char* wlds = lds + wid * 16384;
  const int x = bx & 7, v = (bx >> 3) * 8 + wid;
  int u = (8 * x + (v >> 6)) * 64 + (v & 63);
  unsigned* myctr = ctr + 64 * 16 * (1 + x);
  while (u < NU) {
    unsigned nx = 0u;
    if (lane == 0) nx = __hip_atomic_fetch_add(myctr, 1u, __ATOMIC_RELAXED, __HIP_MEMORY_SCOPE_AGENT);
    const int rb = 63 - (u & 63), bh = u >> 6;
    sbw_unit(bh >> 3, bh & 7, rb, act, wlds, dry);
    const int n = (int)__builtin_amdgcn_readfirstlane(nx);
    u = (n < 256) ? (8 * x + 4 + (n >> 6)) * 64 + (n & 63) : NU;
  }
}
#undef VM_WAIT
#undef PK4
#undef KSWZ
#undef LGK_WAIT
#undef SBAR
}

#define LAS __attribute__((address_space(3)))
typedef unsigned v4u __attribute__((ext_vector_type(4)));
#define LDS_WAIT() asm volatile("s_waitcnt lgkmcnt(0)" ::: "memory")
constexpr int NWAVES = 8;
constexpr int LDS_BYTES = 147456;

__device__ __forceinline__ int rho32(int l) { return 16 * ((l >> 2) & 1) + 4 * (l >> 3) + (l & 3); }
__device__ __forceinline__ int pos_win(int c) {
    if (c < 1024) { const int hh = c >> 7, j = c & 127, n = j >> 6, jj = j & 63; return 256 * (hh >> 1) + 128 * (hh & 1) + 32 * (jj >> 4) + 16 * n + (jj & 15); }
    if (c < 6144) return (c & ~31) + rho32(c & 31);
    const int isb = (c >= 7168) ? 1 : 0, ch = (c - 6144) & 1023, j = ch >> 7, w = ch & 127;
    return 256 * (24 + j) + 128 * isb + (w & ~31) + rho32(w & 31);
}
enum { KIND_NAT = 0, KIND_P32 = 1, KIND_WIN = 2 };
__device__ __forceinline__ void tr_item(const float* __restrict__ W, int N, bf16* __restrict__ WT, int ldt, int koff, int kind, const float* __restrict__ gain, LAS float* scr, int item, int lane) {
    const int nblk = N / 32, kb = item / nblk, nb = item % nblk, k0 = 64 * kb, n0 = 32 * nb;
    float wv[32];
#pragma unroll
    for (int i = 0; i < 32; ++i) wv[i] = W[(size_t)(k0 + 2 * i + (lane >> 5)) * N + n0 + (lane & 31)];
#pragma unroll
    for (int i = 0; i < 32; ++i) scr[(2 * i + (lane >> 5)) * 33 + (lane & 31)] = wv[i];
    LDS_WAIT(); asm volatile("" ::: "memory");
    const int c = lane & 7;
    float gn[8];
#pragma unroll
    for (int i = 0; i < 8; ++i) gn[i] = gain ? gain[k0 + 8 * c + i] : 1.0f;
#pragma unroll
    for (int j = 0; j < 4; ++j) {
        const int n = (lane >> 3) + 8 * j, cl = n0 + n; int pos = cl; float sc = 1.0f;
        if (kind == KIND_P32) pos = (cl & ~31) + rho32(cl & 31);
        else if (kind == KIND_WIN) { pos = pos_win(cl); if (cl >= 512 && cl < 1024) sc = KR_SCALE; else if (cl >= 3072 && cl < 4096) sc = QS_SCALE; }
        const LAS float* s = scr + (8 * c) * 33 + n;
        v4u o; o.x = pk2(s[0 * 33] * gn[0] * sc, s[1 * 33] * gn[1] * sc); o.y = pk2(s[2 * 33] * gn[2] * sc, s[3 * 33] * gn[3] * sc);
        o.z = pk2(s[4 * 33] * gn[4] * sc, s[5 * 33] * gn[5] * sc); o.w = pk2(s[6 * 33] * gn[6] * sc, s[7 * 33] * gn[7] * sc);
        *(v4u*)(WT + (size_t)pos * ldt + koff + k0 + 8 * c) = o;
    }
    LDS_WAIT(); asm volatile("" ::: "memory");
}

#define RLX_AGENT __ATOMIC_RELAXED, __HIP_MEMORY_SCOPE_AGENT
constexpr int RSTD_OFF = 131072 + 8192;
constexpr int MISC_OFF = 131072 + 4096;
constexpr size_t CTL_ZERO_BYTES = 65536;
#define XB_TMO      128
#define XB_XCNT(j)  (256  + 64 * (j))
#define XB_XSUB(j)  (1280 + 64 * (j))
#define XB_XGEN(j)  (2304 + 64 * (j))
#define XB_TOP      3328
#define XB_TOPGEN   3392
#define XCD_BAR_WORDS 3456
#define XB_SPIN_CAP (1u << 18)

__device__ __forceinline__ unsigned xb_ld(unsigned* p)              { return __hip_atomic_load(p, __ATOMIC_RELAXED, __HIP_MEMORY_SCOPE_AGENT); }
__device__ __forceinline__ unsigned xb_add(unsigned* p, unsigned v) { return __hip_atomic_fetch_add(p, v, __ATOMIC_RELAXED, __HIP_MEMORY_SCOPE_AGENT); }
__device__ __forceinline__ unsigned xb_xcc_id() { return (unsigned)__builtin_amdgcn_s_getreg((3 << 11) | 20) & 0xFu; }
#define XB_SPIN(cond, bar) do { unsigned _sp = 0; while (cond) { __builtin_amdgcn_s_sleep(1); \
    if ((++_sp & 255u) == 0u) { if (xb_ld(&(bar)[XB_TMO])) break; if (_sp > XB_SPIN_CAP) { atomicAdd(&(bar)[XB_TMO], 1u); break; } } } } while (0)

struct XcdBarrier {
    unsigned* bar; unsigned x;
    volatile LAS unsigned* st;
};

__device__ __forceinline__ XcdBarrier xcd_barrier_post(unsigned* bar, volatile LAS unsigned* st) {
    XcdBarrier b; b.bar = bar; b.x = xb_xcc_id(); b.st = st;
    if (threadIdx.x == 0) st[2] = xb_add(&bar[XB_XCNT(b.x)], 1u);
    return b;
}
__device__ __forceinline__ void xcd_barrier_complete(unsigned* bar, unsigned x, unsigned& nloc, unsigned& nx, unsigned& uni) {
    const unsigned G = gridDim.x * gridDim.y * gridDim.z;
    unsigned sum, cnt, mine, sp = 0u;
    for (;;) {
        sum = 0u; cnt = 0u; mine = 0u; uni = (G == 256u) ? 1u : 0u;
#pragma unroll
        for (unsigned j = 0; j < 16; ++j) { const unsigned c = xb_ld(&bar[XB_XCNT(j)]); sum += c; cnt += (c > 0u) ? 1u : 0u; mine = (j == x) ? c : mine; if (c != (j < 8u ? 32u : 0u)) uni = 0u; }
        if (sum == G) break;
        __builtin_amdgcn_s_sleep(1);
        if ((++sp & 255u) == 0u) { if (xb_ld(&bar[XB_TMO])) break; if (sp > XB_SPIN_CAP) { atomicAdd(&bar[XB_TMO], 1u); break; } }
    }
    nloc = mine > 0u ? mine : 1u; nx = cnt > 0u ? cnt : 1u;
}

__device__ __forceinline__ void xcd_barrier(const XcdBarrier& b, bool local = false) {
    asm volatile("s_waitcnt vmcnt(0)" ::: "memory");
    __syncthreads();
    if (threadIdx.x == 0) {
        unsigned* bar = b.bar;
        __builtin_amdgcn_s_waitcnt(0);
        unsigned nloc = b.st[0], nx = b.st[1];
        if (nloc == 0u) { unsigned uni; xcd_barrier_complete(bar, b.x, nloc, nx, uni); b.st[0] = nloc; b.st[1] = nx; b.st[3] = uni;
            if (uni) b.st[4] = b.st[2] * 8u + b.x; }
        const bool full = !(local && b.st[3] != 0u);
        const unsigned old = xb_add(&bar[XB_XSUB(b.x)], 1u);
        const unsigned gen = old / nloc;
        if (old + 1u == (gen + 1u) * nloc) {
          if (full) {
            __builtin_amdgcn_fence(__ATOMIC_RELEASE, "agent");
            asm volatile("s_waitcnt vmcnt(0)" ::: "memory");
            const unsigned og = xb_add(&bar[XB_TOP], 1u);
            const unsigned tg = og / nx;
            if (og + 1u == (tg + 1u) * nx) xb_add(&bar[XB_TOPGEN], 1u);
            else XB_SPIN(xb_ld(&bar[XB_TOPGEN]) == tg, bar);
          }
            __builtin_amdgcn_fence(__ATOMIC_ACQUIRE, "agent");
            xb_add(&bar[XB_XGEN(b.x)], 1u);
            asm volatile("s_waitcnt vmcnt(0)" ::: "memory");
        } else {
            XB_SPIN(xb_ld(&bar[XB_XGEN(b.x)]) == gen, bar);
            __builtin_amdgcn_fence(__ATOMIC_ACQUIRE, "agent");
            asm volatile("s_waitcnt vmcnt(0)" ::: "memory");
        }
    }
    __syncthreads();
}

struct Args { const float* in[10]; float* out; unsigned char* ws; int ph_lo, ph_hi; };
constexpr int PH_PRO = 0, PH_FINAL = 1 + 6 * DEPTH * NGRP;

__device__ __forceinline__ void prologue_phase(const Args& a, unsigned char* lds) {
    int tid_ = threadIdx.x; asm volatile("" : "+v"(tid_));
    const int lane = tid_ & 63, wave = __builtin_amdgcn_readfirstlane(tid_ >> 6);
    const float* x = a.in[0]; float* out = a.out; bf16* xb = (bf16*)(a.ws + WS_XB); float* ssq = (float*)(a.ws + WS_SSQ); float* rope = (float*)(a.ws + WS_ROPE);
    const int gw = blockIdx.x * NWAVES + wave, NGW = gridDim.x * NWAVES;
    LAS float* scr = (LAS float*)((LAS unsigned char*)lds + wave * 16384);
    constexpr int I_IN = 16 * 256, I_SQ = 16 * 32, I_UP = 16 * 128, I_DN = 64 * 32, I_LAYER = I_IN + 3 * I_SQ + I_UP + I_DN;
    for (int it = gw; it < DEPTH * I_LAYER; it += NGW) {
        const int l = it / I_LAYER; int r = it % I_LAYER;
        unsigned char* wl = a.ws + WS_W + (size_t)l * WL_STRIDE;
        if (r < I_IN) { tr_item(a.in[1] + (size_t)l * D * DIN, DIN, (bf16*)(wl + WL_WIN), D, 0, KIND_WIN, a.in[7] + l * D, scr, r, lane); continue; } r -= I_IN;
        if (r < I_SQ) { tr_item(a.in[2] + (size_t)l * D * D, D, (bf16*)(wl + WL_PCAT), 2 * D, 0, KIND_P32, nullptr, scr, r, lane); continue; } r -= I_SQ;
        if (r < I_SQ) { tr_item(a.in[3] + (size_t)l * D * D, D, (bf16*)(wl + WL_PCAT), 2 * D, D, KIND_P32, nullptr, scr, r, lane); continue; } r -= I_SQ;
        if (r < I_SQ) { tr_item(a.in[4] + (size_t)l * D * D, D, (bf16*)(wl + WL_WOUT), D, 0, KIND_NAT, nullptr, scr, r, lane); continue; } r -= I_SQ;
        if (r < I_UP) { tr_item(a.in[5] + (size_t)l * D * DFF, DFF, (bf16*)(wl + WL_WUP), D, 0, KIND_P32, a.in[8] + l * D, scr, r, lane); continue; } r -= I_UP;
        tr_item(a.in[6] + (size_t)l * DFF * D, D, (bf16*)(wl + WL_WDN), DFF, 0, KIND_NAT, nullptr, scr, r, lane);
    }
    for (int r = gw; r < M; r += NGW) {
        float s = 0.f; float4 xv[4];
#pragma unroll
        for (int j = 0; j < 4; ++j) xv[j] = *(const float4*)(x + (size_t)r * D + j * 256 + lane * 4);
#pragma unroll
        for (int j = 0; j < 4; ++j) {
            const int c = j * 256 + lane * 4;
            const float4 v = xv[j];
            *(float4*)(out + (size_t)r * D + c) = v;
            s += v.x * v.x + v.y * v.y + v.z * v.z + v.w * v.w;
            uint2 w; w.x = pk2(v.x, v.y); w.y = pk2(v.z, v.w);
            *(uint2*)(xb + (size_t)r * D + c) = w;
        }
#pragma unroll
        for (int o = 1; o < 64; o <<= 1) s += __shfl_xor(s, o);
        if (lane < 16) ssq[(size_t)r * 16 + lane] = (lane == 0) ? s : 0.f;
    }
    for (int i = blockIdx.x * 512 + tid_; i < SEQ * 64; i += gridDim.x * 512) {
        const int pos = i >> 6, j = i & 63;
        const float inv = powf(10000.0f, -(float)j / 64.0f);
        const float ang = (float)pos * inv;
        rope[i] = cosf(ang); rope[SEQ * 64 + i] = sinf(ang);
    }
}
__device__ __forceinline__ void final_phase(const Args& a) {
    int tid_ = threadIdx.x; asm volatile("" : "+v"(tid_));
    const int lane = tid_ & 63, wave = __builtin_amdgcn_readfirstlane(tid_ >> 6);
    float* out = a.out; const float* g = a.in[9];
    const int gw = blockIdx.x * NWAVES + wave, NGW = gridDim.x * NWAVES;
    for (int r = gw; r < M; r += NGW) {
        float4 v[4]; float s = 0.f;
#pragma unroll
        for (int j = 0; j < 4; ++j) { v[j] = *(const float4*)(out + (size_t)r * D + j * 256 + lane * 4); s += v[j].x * v[j].x + v[j].y * v[j].y + v[j].z * v[j].z + v[j].w * v[j].w; }
#pragma unroll
        for (int o = 1; o < 64; o <<= 1) s += __shfl_xor(s, o);
        const float rs = rsqrtf(s * (1.0f / D) + NORM_EPS);
#pragma unroll
        for (int j = 0; j < 4; ++j) { const float4 gg = *(const float4*)(g + j * 256 + lane * 4);
            float4 o; o.x = v[j].x * rs * gg.x; o.y = v[j].y * rs * gg.y; o.z = v[j].z * rs * gg.z; o.w = v[j].w * rs * gg.w;
            *(float4*)(out + (size_t)r * D + j * 256 + lane * 4) = o; }
    }
}

#ifndef RET_NAIVE
#define RET_NAIVE 0
#endif
#ifndef PHMASK
#define PHMASK 31
#endif
#ifndef MK_ONE_LAUNCH
#define MK_ONE_LAUNCH 1
#endif
__global__ void __launch_bounds__(NWAVES * 64, 2) mega(Args a) {
    extern __shared__ __attribute__((aligned(16))) unsigned char lds[];
    const int G = gridDim.x;
    PG8_LAS unsigned char* ring = (PG8_LAS unsigned char*)lds;
#if MK_ONE_LAUNCH
    volatile LAS unsigned* MISC = (volatile LAS unsigned*)((LAS unsigned char*)lds + MISC_OFF);
    if (threadIdx.x < 4) MISC[threadIdx.x] = 0u;
    if (threadIdx.x == 4) MISC[4] = blockIdx.x;
    __syncthreads();
    const XcdBarrier bar = xcd_barrier_post((unsigned*)(a.ws + WS_CTL), MISC);
#define GRID_SYNC() xcd_barrier(bar)
#define TEAM_SYNC(local) xcd_barrier(bar, (local))
#else
#define GRID_SYNC() do {} while (0)
#define TEAM_SYNC(local) do {} while (0)
#endif
    volatile LAS unsigned* MISCT = (volatile LAS unsigned*)((LAS unsigned char*)lds + MISC_OFF + 64);
    if (TIME_K >= 0 && threadIdx.x == 0) { MISCT[4] = 0u; const unsigned long long t_ = __builtin_amdgcn_s_memrealtime(); MISCT[2] = (unsigned)t_; MISCT[3] = (unsigned)(t_ >> 32); }
    int ph = a.ph_lo; const int ph_hi = a.ph_hi;
    if (ph == PH_PRO) { prologue_phase(a, lds); ++ph;
#if MK_ONE_LAUNCH
        if (ph < ph_hi) { if (a.ph_lo < 0) cg::this_grid().sync(); else GRID_SYNC(); }
#endif
        TSTAMP(6);
    }
    const int ph_end = ph_hi < PH_FINAL ? ph_hi : PH_FINAL;
    const bool rt_true = (PROBE_K >= 0) && (a.ph_hi > 0);
    for (; ph < ph_end; ++ph) {
#if MK_ONE_LAUNCH
        unsigned ma_ = (unsigned)MISC_OFF + 16u; asm volatile("" : "+v"(ma_));
        int bx = __builtin_amdgcn_readfirstlane((int)*(volatile LAS unsigned*)((LAS unsigned char*)lds + ma_));
#else
        int bx = (int)blockIdx.x; asm volatile("" : "+s"(bx));
#endif
        size_t zofs = 0; asm volatile("" : "+s"(zofs));
        unsigned char* ws = a.ws + zofs; float* outp = (float*)((unsigned char*)a.out + zofs);
        unsigned char* act = ws + WS_ACT; float* ssq = (float*)(ws + WS_SSQ); const float* rope = (const float*)(ws + WS_ROPE); bf16* xb = (bf16*)(ws + WS_XB);
        {
            const int q = ph - 1, k = q % 6, lg = q / 6, l = lg / NGRP, g = lg % NGRP, grow0 = g * MG;
            const unsigned char* wl = ws + WS_W + (size_t)l * WL_STRIDE;
            if (k == 0 && (PHMASK & 1)) {
                pg8::Gemm gm{xb + (size_t)grow0 * D, (const bf16*)(wl + WL_WIN), MG, DIN, D, D}; pg8::StaticOrder S; S.init(MG, DIN, G, bx);
                pg8::EpiP1 E{act, rope, grow0, false, (const PG8_LAS float*)(ring + RSTD_OFF)};
                { pg8::Unit u0; S.next(0, u0); pg8::panel_rstd((PG8_LAS float*)(ring + RSTD_OFF), ssq, grow0, u0.pm); }
                for (int rep = (PROBE_K == 0 ? 0 : 1); rep < 2; ++rep) { E.dry = (rep == 0) && rt_true; pg8::gemm_phase<pg8::EpiP1, pg8::StaticOrder, true, true>(ring, gm, S, E); }
            } else if (k == 1) {
                TSTAMP(100);
                sba::retU_phase(act, ws, (char*)lds, bx);
                TEAM_SYNC(true);
                sba::ret_phase(act, ws, (char*)lds, false, bx);
                TSTAMP(8);
                for (int rep = (PROBE_K == 7 ? 0 : 1); rep < 2; ++rep) sba::sb_phase(act, (char*)lds, (rep == 0) && rt_true, (unsigned*)(ws + WS_CTL + 16384) + (size_t)(2 * lg + rep) * 64, bx);
                TSTAMP(9);
            } else if (k == 2 && (PHMASK & 2)) {
                pg8::Gemm gm{(const bf16*)(act + A_GS), (const bf16*)(wl + WL_PCAT), MG, D, 2 * D, D, SKIP4K}; pg8::ChainOrder S; S.init(MG, D, G, bx); S.kh = D;
                pg8::EpiP3 E{act, false};
                for (int rep = (PROBE_K == 2 ? 0 : 1); rep < 2; ++rep) { E.dry = (rep == 0) && rt_true; pg8::gemm_phase<pg8::EpiP3, pg8::ChainOrder, true, true>(ring, gm, S, E); }
            } else if (k == 3 && (PHMASK & 4)) {
                pg8::Gemm gm{(const bf16*)(act + A_MERGED), (const bf16*)(wl + WL_WOUT), MG, D, D, D, SKIP2K}; pg8::StaticOrder S; S.init(MG, D, G, bx);
                pg8::EpiX E{outp, xb, ssq, grow0, false, true};
                for (int rep = (PROBE_K == 3 ? 0 : 1); rep < 2; ++rep) { E.dry = (rep == 0) && rt_true; pg8::gemm_phase<pg8::EpiX, pg8::StaticOrder, true, true>(ring, gm, S, E); }
            } else if (k == 4 && (PHMASK & 8)) {
                pg8::Gemm gm{xb + (size_t)grow0 * D, (const bf16*)(wl + WL_WUP), MG, DFF, D, D}; pg8::StaticOrder S; S.init(MG, DFF, G, bx);
                pg8::EpiP5 E{act, grow0, false, (const PG8_LAS float*)(ring + RSTD_OFF)};
                { pg8::Unit u0; S.next(0, u0); pg8::panel_rstd((PG8_LAS float*)(ring + RSTD_OFF), ssq, grow0, u0.pm); }
                for (int rep = (PROBE_K == 4 ? 0 : 1); rep < 2; ++rep) { E.dry = (rep == 0) && rt_true; pg8::gemm_phase<pg8::EpiP5, pg8::StaticOrder, true, true>(ring, gm, S, E); }
            } else if (k == 5 && (PHMASK & 16)) {
                pg8::Gemm gm{(const bf16*)(act + A_UP), (const bf16*)(wl + WL_WDN), MG, D, DFF, DFF, SKIP8K}; pg8::StaticOrder S; S.init(MG, D, G, bx);
                pg8::EpiX E{outp, xb, ssq, grow0, false, l + 1 < DEPTH};
                for (int rep = (PROBE_K == 5 ? 0 : 1); rep < 2; ++rep) { E.dry = (rep == 0) && rt_true; pg8::gemm_phase<pg8::EpiX, pg8::StaticOrder, true, true>(ring, gm, S, E); }
            }
        }
        if (ph + 1 < ph_hi) TEAM_SYNC(ph + 1 < PH_FINAL);
        TSTAMP((ph - 1) % 6);
    }
    if (ph_hi > PH_FINAL) final_phase(a);
    TSTAMP(7);
    if (TIME_K >= 0 && blockIdx.x == 0 && threadIdx.x == 0) { const unsigned long long t0_ = __builtin_amdgcn_s_memrealtime(); const unsigned span_ = MISCT[4]; while (__builtin_amdgcn_s_memrealtime() - t0_ < span_) __builtin_amdgcn_s_sleep(8); }
}

extern "C" void kernel_launch(void* const* d_in, const int* in_sizes, int n_in, void* d_out, int out_size, void* d_ws, size_t ws_size, hipStream_t stream) {
    static int grid = 0;
    if (grid == 0) {
        if (n_in != 10 || in_sizes[0] != M * D || out_size != M * D || ws_size < WS_END) { fprintf(stderr, "kernel_launch: unexpected shapes (n_in %d, ws %zu)\n", n_in, ws_size); grid = -1; return; }
        int dev = 0, cus = 0;
        if (hipGetDevice(&dev) != hipSuccess || hipDeviceGetAttribute(&cus, hipDeviceAttributeMultiprocessorCount, dev) != hipSuccess) { grid = -1; return; }
        if (hipFuncSetAttribute((const void*)mega, hipFuncAttributeMaxDynamicSharedMemorySize, LDS_BYTES) != hipSuccess) { fprintf(stderr, "kernel_launch: hipFuncSetAttribute failed\n"); grid = -1; return; }
        int per_cu = 0;
        if (hipOccupancyMaxActiveBlocksPerMultiprocessor(&per_cu, (const void*)mega, NWAVES * 64, LDS_BYTES) != hipSuccess || per_cu < 1) { fprintf(stderr, "kernel_launch: occupancy query says %d blocks per CU\n", per_cu); (void)hipGetLastError(); per_cu = 1; }
        if (cus < 256) { fprintf(stderr, "kernel_launch: built for a 256-CU device (got %d CUs)\n", cus); grid = -1; return; }
        grid = 256;
    }
    if (grid < 0) return;
    Args a{};
    for (int i = 0; i < 10; ++i) a.in[i] = (const float*)d_in[i];
    a.out = (float*)d_out; a.ws = (unsigned char*)d_ws;
#if MK_ONE_LAUNCH
    if (hipMemsetAsync((char*)d_ws + WS_CTL, 0, CTL_ZERO_BYTES, stream) != hipSuccess) { fprintf(stderr, "kernel_launch: hipMemsetAsync failed\n"); return; }
    a.ph_lo = 0; a.ph_hi = PH_FINAL + 1;
    void* kargs[] = {&a};
    const hipError_t le = hipLaunchCooperativeKernel((const void*)mega, dim3(grid), dim3(NWAVES * 64), kargs, LDS_BYTES, stream);
    if (le != hipSuccess) fprintf(stderr, "kernel_launch: cooperative launch failed: %s (grid %d)\n", hipGetErrorString(le), grid);
#else
    auto run = [&](int lo, int hi) { a.ph_lo = lo; a.ph_hi = hi; hipLaunchKernelGGL(mega, dim3(grid), dim3(NWAVES * 64), LDS_BYTES, stream, a); };
    for (int p = 0; p <= PH_FINAL; ++p) run(p, p + 1);
#endif
}
```
